# Optimizing an MI355X kernel written in HIP

```python
import math
import jax
import jax.numpy as jnp
from jax import lax
import numpy as np

D_MODEL = 1024
BATCH = 4
SEQ = 8192
DEPTH = 2

GRID_W = 64
CTX_LEN = 256
POOL_GROUPS = 4
POOL_GROUP_DIM = 128
POOL_WIDTH = POOL_GROUPS * POOL_GROUP_DIM
POOL_WINDOWS = (2, 4, 8, 16)
DIFF_HEADS = 4
DIFF_HEAD_DIM = 64
DIFF_WIDTH = DIFF_HEADS * 2 * DIFF_HEAD_DIM
GQA_HEADS = 8
GQA_KV_HEADS = 2
GQA_HEAD_DIM = 64
GQA_GROUP = GQA_HEADS // GQA_KV_HEADS
GQA_WIDTH = GQA_HEADS * GQA_HEAD_DIM
GQA_KV_WIDTH = GQA_KV_HEADS * GQA_HEAD_DIM
N_BRANCHES = 3
BRANCH_WIDTH = 512
IN_SPLITS = (POOL_WIDTH, POOL_WIDTH, DIFF_WIDTH, DIFF_WIDTH, DIFF_WIDTH, DIFF_WIDTH,
             GQA_WIDTH, GQA_KV_WIDTH, GQA_KV_WIDTH, GQA_WIDTH, N_BRANCHES * D_MODEL)
IN_WIDTH = 2 * POOL_WIDTH + 4 * DIFF_WIDTH + 2 * GQA_WIDTH + 2 * GQA_KV_WIDTH + N_BRANCHES * D_MODEL
ROPE_AXIS_DIM = 32
ROPE_BASE = 10000.0
Q_BLOCK = 128
NORM_EPS = 1e-6

kernel_name = "hybrid_pool_diffattn_gqa_diffusion_block"


def _rmsnorm(x, g):
    x32 = x.astype(jnp.float32)
    y = x32 * lax.rsqrt(jnp.mean(x32 * x32, axis=-1, keepdims=True) + NORM_EPS)
    return (y * g.astype(jnp.float32)).astype(x.dtype)


def _rope_tables(n):
    rows = n // GRID_W
    row = jnp.repeat(jnp.arange(rows, dtype=jnp.float32), GRID_W)
    col = jnp.tile(jnp.arange(GRID_W, dtype=jnp.float32), rows)
    inv = jnp.power(ROPE_BASE, -jnp.arange(0, ROPE_AXIS_DIM, 2, dtype=jnp.float32) / ROPE_AXIS_DIM)
    ang_r = row[:, None] * inv[None, :]
    ang_c = col[:, None] * inv[None, :]
    return (jnp.cos(ang_r), jnp.sin(ang_r), jnp.cos(ang_c), jnp.sin(ang_c))


def _rotate(x, cos, sin):
    m = x.shape[-1] // 2
    x1 = x[..., :m].astype(jnp.float32)
    x2 = x[..., m:].astype(jnp.float32)
    cos = cos[:, None, :]
    sin = sin[:, None, :]
    return jnp.concatenate([x1 * cos - x2 * sin, x1 * sin + x2 * cos], axis=-1).astype(x.dtype)


def _rope_2d(x, tables):
    cr, sr, cc, sc = tables
    return jnp.concatenate([_rotate(x[..., :ROPE_AXIS_DIM], cr, sr),
                            _rotate(x[..., ROPE_AXIS_DIM:], cc, sc)], axis=-1)


def _split_proj(p):
    out = []
    o = 0
    for w in IN_SPLITS:
        out.append(p[..., o:o + w])
        o += w
    return out


def _centred_mean_minus_self(u, window):
    n = u.shape[1]
    left = window // 2
    right = window - 1 - left
    u32 = u.astype(jnp.float32)
    cs = jnp.pad(jnp.cumsum(u32, axis=1), ((0, 0), (1, 0), (0, 0)))
    t = jnp.arange(n)
    hi = jnp.minimum(t + right + 1, n)
    lo = jnp.maximum(t - left, 0)
    s = jnp.take(cs, hi, axis=1) - jnp.take(cs, lo, axis=1)
    cnt = (hi - lo).astype(jnp.float32)[None, :, None]
    return (s / cnt - u32).astype(u.dtype)


def _pool_mixer(u, pool_w, pool_scale):
    b, n, _ = u.shape
    ug = u.reshape(b, n, POOL_GROUPS, POOL_GROUP_DIM)
    pooled = jnp.stack([_centred_mean_minus_self(ug[:, :, g], w) for g, w in enumerate(POOL_WINDOWS)], axis=2)
    mixed = jnp.einsum('bngc,gcd->bngd', pooled, pool_w).reshape(b, n, POOL_WIDTH)
    return mixed * pool_scale


def _heads(pieces, diff_q_norm, diff_k_norm, gqa_q_norm, gqa_k_norm, tables):
    b, n, _ = pieces[0].shape

    def prep(t, nh, g):
        t = _rmsnorm(t.reshape(b, n, nh, -1), g)
        return t if tables is None else _rope_2d(t, tables)

    dq = prep(pieces[2], 2 * DIFF_HEADS, diff_q_norm).reshape(b, n, DIFF_HEADS, 2, DIFF_HEAD_DIM)
    dk = prep(pieces[3], 2 * DIFF_HEADS, diff_k_norm).reshape(b, n, DIFF_HEADS, 2, DIFF_HEAD_DIM)
    dv = pieces[4].reshape(b, n, DIFF_HEADS, 2 * DIFF_HEAD_DIM)
    gq = prep(pieces[6], GQA_HEADS, gqa_q_norm).reshape(b, n, GQA_KV_HEADS, GQA_GROUP, GQA_HEAD_DIM)
    gk = prep(pieces[7], GQA_KV_HEADS, gqa_k_norm)
    gv = pieces[8].reshape(b, n, GQA_KV_HEADS, GQA_HEAD_DIM)
    return dq, dk, dv, gq, gk, gv


def _diff_core(q, k, v, lam):
    s = jnp.einsum('bqhcd,bkhcd->bhcqk', q, k).astype(jnp.float32) * (DIFF_HEAD_DIM ** -0.5)
    p = jax.nn.softmax(s, axis=-1)
    a = (p[:, :, 0] - lam * p[:, :, 1]).astype(v.dtype)
    return jnp.einsum('bhqk,bkhe->bqhe', a, v)


def _diff_post(o, diff_subln, lam_init):
    o = _rmsnorm(o, diff_subln) * (1.0 - lam_init)
    return o.reshape(o.shape[:2] + (DIFF_WIDTH,))


def _gqa_core(q, k, v):
    s = jnp.einsum('bqgrd,bkgd->bgrqk', q, k).astype(jnp.float32) * (GQA_HEAD_DIM ** -0.5)
    p = jax.nn.softmax(s, axis=-1).astype(v.dtype)
    return jnp.einsum('bgrqk,bkgd->bqgrd', p, v)


def _query_blocks(q):
    b, n = q.shape[:2]
    q = q.reshape((b, n // Q_BLOCK, Q_BLOCK) + q.shape[2:])
    return jnp.moveaxis(q, 1, 0)


def _merge_blocks(o):
    o = jnp.moveaxis(o, 0, 1)
    return o.reshape((o.shape[0], o.shape[1] * o.shape[2]) + o.shape[3:])


def _merge(pieces, pool_o, diff_o, gqa_o, w_branch, w_out):
    gqa_o = gqa_o.reshape(gqa_o.shape[:2] + (GQA_WIDTH,))
    b0 = pool_o * jax.nn.silu(pieces[1])
    b1 = diff_o * jax.nn.silu(pieces[5])
    b2 = gqa_o * jax.nn.silu(pieces[9])
    g0, g1, g2 = jnp.split(jax.nn.sigmoid(pieces[10]), N_BRANCHES, axis=-1)
    y = g0 * (b0 @ w_branch[0]) + g1 * (b1 @ w_branch[1]) + g2 * (b2 @ w_branch[2])
    return y @ w_out


def _layer(x, xc, c_act, cc_act, rope, lam_init, ctx_out,
           ada_w, ada_b, norm_g, w_in, pool_w, pool_scale,
           diff_q_norm, diff_k_norm, diff_lambda, diff_subln,
           gqa_q_norm, gqa_k_norm, w_branch, w_out):
    shift, scale, gate = jnp.split(c_act @ ada_w + ada_b, 3, axis=-1)
    shift_c, scale_c, gate_c = jnp.split(cc_act @ ada_w + ada_b, 3, axis=-1)
    h = _rmsnorm(x, norm_g) * (1.0 + scale[:, None, :]) + shift[:, None, :]
    hc = _rmsnorm(xc, norm_g) * (1.0 + scale_c) + shift_c
    p = _split_proj(h @ w_in)
    pc = _split_proj(hc @ w_in)
    dq, dk, dv, gq, gk, gv = _heads(p, diff_q_norm, diff_k_norm, gqa_q_norm, gqa_k_norm, rope)
    dqc, dkc, dvc, gqc, gkc, gvc = _heads(pc, diff_q_norm, diff_k_norm, gqa_q_norm, gqa_k_norm, None)
    lam_p = diff_lambda.astype(jnp.float32)
    lam = jnp.exp(jnp.sum(lam_p[0] * lam_p[1])) - jnp.exp(jnp.sum(lam_p[2] * lam_p[3])) + lam_init

    dk_all = jnp.concatenate([dkc, dk], axis=1)
    dv_all = jnp.concatenate([dvc, dv], axis=1)
    gk_all = jnp.concatenate([gkc, gk], axis=1)
    gv_all = jnp.concatenate([gvc, gv], axis=1)
    diff_o = _merge_blocks(lax.map(lambda qb: _diff_core(qb, dk_all, dv_all, lam), _query_blocks(dq)))
    gqa_o = _merge_blocks(lax.map(lambda qb: _gqa_core(qb, gk_all, gv_all), _query_blocks(gq)))
    pool_o = _pool_mixer(p[0], pool_w, pool_scale)
    out = _merge(p, pool_o, _diff_post(diff_o, diff_subln, lam_init), gqa_o, w_branch, w_out)
    x_new = x + gate[:, None, :] * out

    if ctx_out:
        diff_oc = _diff_core(dqc, dkc, dvc, lam)
        gqa_oc = _gqa_core(gqc, gkc, gvc)
        pool_oc = _pool_mixer(pc[0], pool_w, pool_scale)
        out_c = _merge(pc, pool_oc, _diff_post(diff_oc, diff_subln, lam_init), gqa_oc, w_branch, w_out)
        xc = xc + gate_c * out_c
    return x_new, xc


def setup_inputs(seed: int = 0) -> dict:
    key = jax.random.key(seed)
    ks = jax.random.split(key, 18)
    f32 = jnp.float32

    def nrm(k, shape, s):
        return jax.random.normal(k, shape, f32) * s

    def gain(k, shape):
        return 1.0 + 0.02 * jax.random.normal(k, shape, f32)

    return {
        "x": nrm(ks[0], (BATCH, SEQ, D_MODEL), 1.0),
        "c": nrm(ks[1], (BATCH, D_MODEL), 1.0),
        "ctx": nrm(ks[2], (BATCH, CTX_LEN, D_MODEL), 1.0),
        "c_ctx": nrm(ks[3], (D_MODEL,), 1.0),
        "ada_w": nrm(ks[4], (DEPTH, D_MODEL, 3 * D_MODEL), D_MODEL ** -0.5),
        "ada_b": nrm(ks[5], (DEPTH, 3 * D_MODEL), 0.01),
        "norm_g": gain(ks[6], (DEPTH, D_MODEL)),
        "w_in": nrm(ks[7], (DEPTH, D_MODEL, IN_WIDTH), D_MODEL ** -0.5),
        "pool_w": nrm(ks[8], (DEPTH, POOL_GROUPS, POOL_GROUP_DIM, POOL_GROUP_DIM), POOL_GROUP_DIM ** -0.5),
        "pool_scale": gain(ks[9], (DEPTH, POOL_WIDTH)),
        "diff_q_norm": gain(ks[10], (DEPTH, DIFF_HEAD_DIM)),
        "diff_k_norm": gain(ks[11], (DEPTH, DIFF_HEAD_DIM)),
        "diff_lambda": nrm(ks[12], (DEPTH, 4, DIFF_HEAD_DIM), 0.1),
        "diff_subln": gain(ks[13], (DEPTH, 2 * DIFF_HEAD_DIM)),
        "gqa_q_norm": gain(ks[14], (DEPTH, GQA_HEAD_DIM)),
        "gqa_k_norm": gain(ks[15], (DEPTH, GQA_HEAD_DIM)),
        "w_branch": nrm(ks[16], (DEPTH, N_BRANCHES, BRANCH_WIDTH, D_MODEL), BRANCH_WIDTH ** -0.5),
        "w_out": nrm(ks[17], (DEPTH, D_MODEL, D_MODEL), D_MODEL ** -0.5),
    }


def reference(x, c, ctx, c_ctx, ada_w, ada_b, norm_g, w_in, pool_w, pool_scale,
              diff_q_norm, diff_k_norm, diff_lambda, diff_subln, gqa_q_norm, gqa_k_norm,
              w_branch, w_out):
    rope = _rope_tables(x.shape[1])
    c_act = jax.nn.silu(c)
    cc_act = jax.nn.silu(c_ctx)
    xc = ctx
    for l in range(DEPTH):
        lam_init = 0.8 - 0.6 * math.exp(-0.3 * l)
        x, xc = _layer(x, xc, c_act, cc_act, rope, lam_init, l < DEPTH - 1,
                       ada_w[l], ada_b[l], norm_g[l], w_in[l], pool_w[l], pool_scale[l],
                       diff_q_norm[l], diff_k_norm[l], diff_lambda[l], diff_subln[l],
                       gqa_q_norm[l], gqa_k_norm[l], w_branch[l], w_out[l])
    return x
```

```cpp
#include <hip/hip_runtime.h>
#include <hip/hip_cooperative_groups.h>
#include <cstdio>
namespace cg = cooperative_groups;

typedef unsigned short bf16_t;
typedef short bf16x8 __attribute__((ext_vector_type(8)));
typedef float f32x16 __attribute__((ext_vector_type(16)));
typedef float f32x4 __attribute__((ext_vector_type(4)));
typedef float f32x2 __attribute__((ext_vector_type(2)));
typedef unsigned u32x4 __attribute__((ext_vector_type(4)));
typedef unsigned u32x2 __attribute__((ext_vector_type(2)));
typedef __bf16 bf16v2 __attribute__((ext_vector_type(2)));

#define DI __device__ __forceinline__
#define MFMA(a, b, c) __builtin_amdgcn_mfma_f32_32x32x16_bf16((a), (b), (c), 0, 0, 0)

#ifndef MULTI_LAUNCH
#define MULTI_LAUNCH 0
#endif

constexpr int NLAT = 32768, NTOK = 33792, NKEY = 8448;
constexpr int PMW = 3072;
constexpr int C_U = 0, C_ZP = 512, C_DQ = 1024, C_ZD = 1536, C_GQ = 2048, C_ZG = 2560;
constexpr int TROW = 144;
constexpr int TILEB = 128 * TROW;
constexpr int SMEM_BYTES = 4 * TILEB;
constexpr int ABUF = 64 * TROW + 128 * TROW;
constexpr float LOG2E = 1.4426950408889634f;

struct Params {
  const float *x, *c, *ctx, *c_ctx, *ada_w, *ada_b, *norm_g, *w_in, *pool_w, *pool_scale, *dqn, *dkn, *dlam, *dsub, *gqn, *gkn, *w_branch, *w_out;
  float* out;
  float* mod;
  float* consts;
  bf16_t *WinT, *WbT, *WoT, *WpT, *h, *y, *Pm, *DK, *DVt, *GK, *GVt;
  float* xc1;
  float* stash;
  unsigned* gsc;
};

DI unsigned pack2(float a, float b) { f32x2 v = {a, b}; bf16v2 r = __builtin_convertvector(v, bf16v2); return __builtin_bit_cast(unsigned, r); }
DI bf16_t f2bf(float a) { return (bf16_t)(pack2(a, a) & 0xffffu); }
DI float bf2f(unsigned v) { return __uint_as_float(v << 16); }
DI float bflo(unsigned v) { return __uint_as_float(v << 16); }
DI float bfhi(unsigned v) { return __uint_as_float(v & 0xffff0000u); }
DI float fast_sigmoid(float v) { return __builtin_amdgcn_rcpf(1.f + __expf(-v)); }
DI float fast_silu(float v) { return v * fast_sigmoid(v); }
DI float wave_sum(float v) {
#pragma unroll
  for (int o = 32; o >= 1; o >>= 1) v += __shfl_xor(v, o);
  return v;
}
DI float wave_max(float v) {
#pragma unroll
  for (int o = 32; o >= 1; o >>= 1) v = fmaxf(v, __shfl_xor(v, o));
  return v;
}
DI int get_tid() { int t = threadIdx.x; asm volatile("" : "+v"(t)); return t; }
template <typename T> DI const T* opaque(const T* q) { asm volatile("" : "+s"(q)); return q; }
DI int crow(int reg, int h) { return (reg & 3) + 8 * (reg >> 2) + 4 * h; }

template <bool SWAP>
DI void gemm_kloop(f32x16 (&acc)[2][2], const bf16_t* __restrict__ A, int lda, const bf16_t* __restrict__ Bt, int ldb, int K, char* smem) {
  const int tid = get_tid(), lane = tid & 63, w = tid >> 6, wm = w >> 1, wn = w & 1, r = lane & 31, h = lane >> 5;
  const int srow = tid >> 3, sch = tid & 7;
  const unsigned ago = (unsigned)(srow * lda + sch * 8) * 2u, bgo = (unsigned)(srow * ldb + sch * 8) * 2u;
  const unsigned astep = (unsigned)lda * 64u, bstep = (unsigned)ldb * 64u;
  const char* Ab = (const char*)A; const char* Bb = (const char*)Bt;
  const int soff = srow * TROW + sch * 16;
  u32x4 ra[4], rb[4];
#pragma unroll
  for (int q = 0; q < 4; ++q) {
    ra[q] = *(const u32x4*)(Ab + (ago + q * astep));
    rb[q] = *(const u32x4*)(Bb + (bgo + q * bstep));
  }
#pragma unroll
  for (int q = 0; q < 4; ++q) {
    *(u32x4*)(smem + soff + q * 32 * TROW) = ra[q];
    *(u32x4*)(smem + TILEB + soff + q * 32 * TROW) = rb[q];
  }
  __syncthreads();
  const int nk = K >> 6;
  const int aoff = (64 * wm + r) * TROW + 16 * h;
  const int boff = TILEB + (64 * wn + r) * TROW + 16 * h;
  for (int kt = 0; kt < nk; ++kt) {
    const char* cur = smem + (kt & 1) * (2 * TILEB);
    if (kt + 1 < nk) {
#pragma unroll
      for (int q = 0; q < 4; ++q) {
        ra[q] = *(const u32x4*)(Ab + (ago + q * astep + (unsigned)(kt + 1) * 128u));
        rb[q] = *(const u32x4*)(Bb + (bgo + q * bstep + (unsigned)(kt + 1) * 128u));
      }
    }
#pragma unroll
    for (int t = 0; t < 4; ++t) {
      const bf16x8 a0 = *(const bf16x8*)(cur + aoff + 32 * t);
      const bf16x8 a1 = *(const bf16x8*)(cur + aoff + 32 * TROW + 32 * t);
      const bf16x8 b0 = *(const bf16x8*)(cur + boff + 32 * t);
      const bf16x8 b1 = *(const bf16x8*)(cur + boff + 32 * TROW + 32 * t);
      if (!SWAP) {
        acc[0][0] = MFMA(a0, b0, acc[0][0]); acc[0][1] = MFMA(a0, b1, acc[0][1]);
        acc[1][0] = MFMA(a1, b0, acc[1][0]); acc[1][1] = MFMA(a1, b1, acc[1][1]);
      } else {
        acc[0][0] = MFMA(b0, a0, acc[0][0]); acc[0][1] = MFMA(b1, a0, acc[0][1]);
        acc[1][0] = MFMA(b0, a1, acc[1][0]); acc[1][1] = MFMA(b1, a1, acc[1][1]);
      }
    }
    if (kt + 1 < nk) {
      char* nxt = smem + ((kt + 1) & 1) * (2 * TILEB);
#pragma unroll
      for (int q = 0; q < 4; ++q) {
        *(u32x4*)(nxt + soff + q * 32 * TROW) = ra[q];
        *(u32x4*)(nxt + TILEB + soff + q * 32 * TROW) = rb[q];
      }
    }
    __syncthreads();
  }
}

DI void zero_acc(f32x16 (&acc)[2][2]) {
#pragma unroll
  for (int i = 0; i < 2; ++i)
#pragma unroll
    for (int j = 0; j < 2; ++j)
#pragma unroll
      for (int e = 0; e < 16; ++e) acc[i][j][e] = 0.f;
}

struct TileWalk {
  int MP, wlast, kf, ktot, x, j, nbx;
  DI void init(int MT, int NT) {
    x = blockIdx.x & 7; j = blockIdx.x >> 3; nbx = gridDim.x >> 3;
    MP = MT >> 3; const int NP = (NT + 7) >> 3; wlast = NT - 8 * (NP - 1);
    const int nfullp = (NP - 1) * MP, totp = NP * MP;
    kf = (nfullp - x + 7) >> 3; if (kf < 0) kf = 0;
    ktot = (totp - x + 7) >> 3; if (ktot < 0) ktot = 0;
  }
  DI bool next(int& m, int& n) {
    int k, q;
    if (j < 64 * kf) { k = j >> 6; q = j & 63; }
    else { const int j2 = j - 64 * kf, pw = 8 * wlast; k = kf + j2 / pw; q = j2 % pw; }
    if (k >= ktot) return false;
    const int id = x + 8 * k, np = id / MP, mp = id % MP;
    m = mp * 8 + (q & 7); n = np * 8 + (q >> 3);
    j += nbx;
    return true;
  }
};

DI void transpose_tile(const float* __restrict__ src, int N, bf16_t* __restrict__ dst, int K, int kt, int nt, char* smem) {
  float* t = (float*)smem;
  const int tid = get_tid();
#pragma unroll
  for (int q = 0; q < 4; ++q) {
    const int idx = tid + 256 * q, row = idx >> 4, c4 = idx & 15;
    const f32x4 v = *(const f32x4*)(src + (size_t)(kt * 64 + row) * N + nt * 64 + c4 * 4);
    t[row * 65 + c4 * 4 + 0] = v[0]; t[row * 65 + c4 * 4 + 1] = v[1]; t[row * 65 + c4 * 4 + 2] = v[2]; t[row * 65 + c4 * 4 + 3] = v[3];
  }
  __syncthreads();
#pragma unroll
  for (int q = 0; q < 2; ++q) {
    const int idx = tid + 256 * q, jn = idx >> 3, kc = idx & 7;
    u32x4 o;
#pragma unroll
    for (int e = 0; e < 4; ++e) o[e] = pack2(t[(kc * 8 + 2 * e) * 65 + jn], t[(kc * 8 + 2 * e + 1) * 65 + jn]);
    *(u32x4*)(dst + (size_t)(nt * 64 + jn) * K + kt * 64 + kc * 8) = o;
  }
  __syncthreads();
}

DI void phase0(const Params& p, char* smem) {
  const int tid = get_tid(), lane = tid & 63, w = tid >> 6;
  constexpr int PER_L = 1856 + 384 + 256 + 16;
  constexpr int NTR = 2 * PER_L, NADA = 96;
  for (int u = blockIdx.x; u < NTR + NADA + 1; u += gridDim.x) {
    if (u < NTR) {
      const int l = u / PER_L; int r = u % PER_L;
      if (r < 1856) { transpose_tile(p.w_in + (size_t)l * 1024 * 7424, 7424, p.WinT + (size_t)l * 7424 * 1024, 1024, r / 116, r % 116, smem); }
      else if (r < 2240) { r -= 1856; const int i = r >> 7, r2 = r & 127;
        transpose_tile(p.w_branch + (size_t)(l * 3 + i) * 512 * 1024, 1024, p.WbT + (size_t)(l * 3 + i) * 1024 * 512, 512, r2 >> 4, r2 & 15, smem); }
      else if (r < 2496) { r -= 2240; transpose_tile(p.w_out + (size_t)l * 1024 * 1024, 1024, p.WoT + (size_t)l * 1024 * 1024, 1024, r >> 4, r & 15, smem); }
      else { r -= 2496; const int g = r >> 2;
        transpose_tile(p.pool_w + (size_t)(l * 4 + g) * 128 * 128, 128, p.WpT + (size_t)(l * 4 + g) * 128 * 128, 128, (r >> 1) & 1, r & 1, smem); }
    } else if (u < NTR + NADA) {
      const int a = u - NTR, l = a / 48, n0 = (a % 48) * 64;
      float* s = (float*)smem;
      for (int i = tid; i < 5 * 1024; i += 256) {
        const int rr = i >> 10, k = i & 1023;
        const float v = rr < 4 ? p.c[rr * 1024 + k] : p.c_ctx[k];
        s[i] = v / (1.f + __expf(-v));
      }
      __syncthreads();
      float a5[5] = {0.f, 0.f, 0.f, 0.f, 0.f};
      const float* wp = p.ada_w + (size_t)l * 1024 * 3072 + n0 + lane;
      for (int k = w * 256; k < w * 256 + 256; ++k) {
        const float wv = wp[(size_t)k * 3072];
#pragma unroll
        for (int rr = 0; rr < 5; ++rr) a5[rr] += s[rr * 1024 + k] * wv;
      }
      __syncthreads();
      float* part = (float*)smem + 5 * 1024;
#pragma unroll
      for (int rr = 0; rr < 5; ++rr) part[(w * 5 + rr) * 64 + lane] = a5[rr];
      __syncthreads();
      for (int i = tid; i < 5 * 64; i += 256) {
        const int rr = i >> 6, nn = i & 63;
        const float v = part[(0 * 5 + rr) * 64 + nn] + part[(1 * 5 + rr) * 64 + nn] + part[(2 * 5 + rr) * 64 + nn] + part[(3 * 5 + rr) * 64 + nn];
        p.mod[(l * 5 + rr) * 3072 + n0 + nn] = v + p.ada_b[l * 3072 + n0 + nn];
      }
      __syncthreads();
    } else {
      if (w == 0) {
        for (int l = 0; l < 2; ++l) {
          const float* lp = p.dlam + l * 256;
          const float s1 = wave_sum(lp[lane] * lp[64 + lane]);
          const float s2 = wave_sum(lp[128 + lane] * lp[192 + lane]);
          const float lam_init = 0.8f - 0.6f * expf(-0.3f * (float)l);
          const float lam = expf(s1) - expf(s2) + lam_init;
          const float mdq = wave_max(fabsf(p.dqn[l * 64 + lane])), mdk = wave_max(fabsf(p.dkn[l * 64 + lane]));
          const float mgq = wave_max(fabsf(p.gqn[l * 64 + lane])), mgk = wave_max(fabsf(p.gkn[l * 64 + lane]));
          if (lane == 0) {
            p.consts[l * 4 + 0] = lam;
            p.consts[l * 4 + 1] = -(LOG2E * 8.f * mdq * mdk);
            p.consts[l * 4 + 2] = -(LOG2E * 8.f * mgq * mgk);
            p.consts[l * 4 + 3] = lam_init;
          }
        }
      }
    }
  }
}

DI void phase1(const Params& p, int l) {
  const int tid = get_tid(), lane = tid & 63, w = tid >> 6;
  const float* xlat = l == 0 ? p.x : p.out;
  const float* xctx = l == 0 ? p.ctx : p.xc1;
  const float* g = p.norm_g + l * 1024;
  for (int rb = blockIdx.x * 4; rb < NTOK; rb += gridDim.x * 4) {
    const int row = rb + w;
    const float* src; int mr;
    if (row < NLAT) { src = xlat + (size_t)row * 1024; mr = row >> 13; } else { src = xctx + (size_t)(row - NLAT) * 1024; mr = 4; }
    const float* md = p.mod + (l * 5 + mr) * 3072;
    f32x4 v[4]; float ss = 0.f;
#pragma unroll
    for (int q = 0; q < 4; ++q) { v[q] = *(const f32x4*)(src + q * 256 + lane * 4); ss += v[q][0] * v[q][0] + v[q][1] * v[q][1] + v[q][2] * v[q][2] + v[q][3] * v[q][3]; }
    ss = wave_sum(ss);
    const float rstd = __builtin_amdgcn_rsqf(ss * (1.f / 1024.f) + 1e-6f);
#pragma unroll
    for (int q = 0; q < 4; ++q) {
      const int k = q * 256 + lane * 4;
      const f32x4 gg = *(const f32x4*)(g + k), sh = *(const f32x4*)(md + k), sc = *(const f32x4*)(md + 1024 + k);
      float o[4];
#pragma unroll
      for (int e = 0; e < 4; ++e) o[e] = v[q][e] * rstd * gg[e] * (1.f + sc[e]) + sh[e];
      u32x2 pk = {pack2(o[0], o[1]), pack2(o[2], o[3])};
      *(u32x2*)(p.h + (size_t)row * 1024 + k) = pk;
    }
  }
}

DI void p2_plain(const f32x16 (&acc)[2][2], bf16_t* __restrict__ dst  , bool silu) {
  const int tid = get_tid(), lane = tid & 63, w = tid >> 6, wm = w >> 1, wn = w & 1, r = lane & 31, h = lane >> 5;
#pragma unroll
  for (int i = 0; i < 2; ++i)
#pragma unroll
    for (int j = 0; j < 2; ++j)
#pragma unroll
      for (int e = 0; e < 16; ++e) {
        float v = acc[i][j][e];
        if (silu) v = fast_silu(v);
        dst[(size_t)(64 * wm + 32 * i + crow(e, h)) * PMW + 64 * wn + 32 * j + r] = f2bf(v);
      }
}

DI void p2_qk(const f32x16 (&acc)[2][2], bf16_t* __restrict__ dst, int ldd, const float* __restrict__ gn, bool rope, int t0, float oscale) {
  const int tid = get_tid(), lane = tid & 63, w = tid >> 6, wm = w >> 1, r = lane & 31, h = lane >> 5;
#pragma unroll
  for (int i = 0; i < 2; ++i) {
    const int tok = 64 * wm + 32 * i + r;
    float y[2][16]; float ss = 0.f;
#pragma unroll
    for (int j = 0; j < 2; ++j)
#pragma unroll
      for (int e = 0; e < 16; ++e) { y[j][e] = acc[i][j][e]; ss += y[j][e] * y[j][e]; }
    ss += __shfl_xor(ss, 32);
    const float rstd = __builtin_amdgcn_rsqf(ss * (1.f / 64.f) + 1e-6f);
#pragma unroll
    for (int j = 0; j < 2; ++j)
#pragma unroll
      for (int e = 0; e < 16; ++e) y[j][e] *= rstd * gn[32 * j + crow(e, h)];
    if (rope) {
      const int tseq = t0 + tok;
#pragma unroll
      for (int j = 0; j < 2; ++j) {
        const float pos = (float)(j == 0 ? (tseq >> 6) : (tseq & 63));
#pragma unroll
        for (int e = 0; e < 8; ++e) {
          const float m = (float)crow(e, h);
          const float ang = pos * __builtin_amdgcn_exp2f(m * -0.8304820237218406f);
          const float cs = __cosf(ang), sn = __sinf(ang);
          const float x1 = y[j][e], x2 = y[j][e + 8];
          y[j][e] = x1 * cs - x2 * sn; y[j][e + 8] = x1 * sn + x2 * cs;
        }
      }
    }
    bf16_t* drow = dst + (size_t)tok * ldd;
#pragma unroll
    for (int j = 0; j < 2; ++j)
#pragma unroll
      for (int g4 = 0; g4 < 4; ++g4) {
        u32x2 pk = {pack2(y[j][4 * g4] * oscale, y[j][4 * g4 + 1] * oscale), pack2(y[j][4 * g4 + 2] * oscale, y[j][4 * g4 + 3] * oscale)};
        *(u32x2*)(drow + 32 * j + 8 * g4 + 4 * h) = pk;
      }
  }
}

DI void p2_v(const f32x16 (&acc)[2][2], bf16_t* __restrict__ dst) {
  const int tid = get_tid(), lane = tid & 63, w = tid >> 6, wm = w >> 1, wn = w & 1, r = lane & 31, h = lane >> 5;
#pragma unroll
  for (int i = 0; i < 2; ++i)
#pragma unroll
    for (int j = 0; j < 2; ++j)
#pragma unroll
      for (int e = 0; e < 16; ++e)
        dst[(size_t)(64 * wn + 32 * j + crow(e, h)) * NKEY + 64 * wm + 32 * i + r] = f2bf(acc[i][j][e]);
}

DI void phase2(const Params& p, int l, char* smem) {
  const int w = get_tid() >> 6, wn = w & 1;
  const bf16_t* W = p.WinT + (size_t)l * 7424 * 1024;
  TileWalk tw; tw.init(264, 34);
  int mt, pn;
  while (tw.next(mt, pn)) {
    const int row0 = mt * 128;
    const bool isctx = mt >= 256;
    const int b = isctx ? ((mt - 256) >> 1) : (mt >> 6);
    const int t0 = isctx ? ((mt - 256) & 1) * 128 : (mt & 63) * 128;
    const int key0 = isctx ? t0 : 256 + t0;
    const bf16_t* A = p.h + (size_t)row0 * 1024;
    const bf16_t* Bt = W + (size_t)pn * 128 * 1024;
    f32x16 acc[2][2]; zero_acc(acc);
    const bool plain = pn < 8 || (pn >= 20 && pn < 24) || pn >= 30;
    if (plain) {
      gemm_kloop<false>(acc, A, 1024, Bt, 1024, 1024, smem);
      int pcol; bool silu;
      if (pn < 4) { pcol = pn * 128; silu = false; } else if (pn < 8) { pcol = pn * 128; silu = true; }
      else if (pn < 24) { pcol = pn * 128 - 1024; silu = true; } else { pcol = pn * 128 - 1280; silu = true; }
      p2_plain(acc, p.Pm + (size_t)row0 * PMW + pcol, silu);
    } else {
      gemm_kloop<true>(acc, A, 1024, Bt, 1024, 1024, smem);
      if (pn < 12) {
        p2_qk(acc, p.Pm + (size_t)row0 * PMW + pn * 128 + 64 * wn, PMW, p.dqn + l * 64, !isctx, t0, LOG2E * 0.125f);
      } else if (pn < 16) {
        p2_qk(acc, p.DK + ((size_t)b * NKEY + key0) * 512 + (pn - 12) * 128 + 64 * wn, 512, p.dkn + l * 64, !isctx, t0, 1.f);
      } else if (pn < 20) {
        p2_v(acc, p.DVt + ((size_t)b * 512 + (pn - 16) * 128) * NKEY + key0);
      } else if (pn < 28) {
        p2_qk(acc, p.Pm + (size_t)row0 * PMW + pn * 128 - 1024 + 64 * wn, PMW, p.gqn + l * 64, !isctx, t0, LOG2E * 0.125f);
      } else if (pn == 28) {
        p2_qk(acc, p.GK + ((size_t)b * NKEY + key0) * 128 + 64 * wn, 128, p.gkn + l * 64, !isctx, t0, 1.f);
      } else {
        p2_v(acc, p.GVt + ((size_t)b * 128) * NKEY + key0);
      }
    }
  }
}

template <int DV>
DI void attn_pass(f32x16 (&O)[DV / 32], float& lsum, const bf16x8 (&qf)[4], const bf16_t* __restrict__ Kb, int ldk, const bf16_t* __restrict__ Vt, int nkeys, float negC, char* smem) {
  constexpr int NV = DV / 32;
  const int tid = get_tid(), lane = tid & 63, r = lane & 31, h = lane >> 5;
  const int pr = (r & 19) | ((r & 4) << 1) | ((r & 8) >> 1);
  const int srow = tid >> 3, sch = tid & 7;
  const unsigned kgo = (unsigned)(srow * ldk + sch * 8) * 2u, vgo = (unsigned)(srow * NKEY + sch * 8) * 2u;
  const unsigned kstep = (unsigned)ldk * 64u;
  constexpr unsigned vstep = (unsigned)NKEY * 64u;
  const char* Kc = (const char*)Kb; const char* Vc = (const char*)Vt;
  const int soff = srow * TROW + sch * 16;
  u32x4 rk[2], rv[NV];
#pragma unroll
  for (int q = 0; q < 2; ++q) rk[q] = *(const u32x4*)(Kc + (kgo + q * kstep));
#pragma unroll
  for (int q = 0; q < NV; ++q) rv[q] = *(const u32x4*)(Vc + (vgo + q * vstep));
#pragma unroll
  for (int q = 0; q < 2; ++q) *(u32x4*)(smem + soff + q * 32 * TROW) = rk[q];
#pragma unroll
  for (int q = 0; q < NV; ++q) *(u32x4*)(smem + 64 * TROW + soff + q * 32 * TROW) = rv[q];
  __syncthreads();
#pragma unroll
  for (int bk = 0; bk < NV; ++bk)
#pragma unroll
    for (int e = 0; e < 16; ++e) O[bk][e] = 0.f;
  lsum = 0.f;
  const int koff = pr * TROW + 16 * h;
  const int voff = 64 * TROW + r * TROW + 16 * h;
  const int nt = nkeys >> 6;
  for (int kt = 0; kt < nt; ++kt) {
    const char* cur = smem + (kt & 1) * ABUF;
    if (kt + 1 < nt) {
#pragma unroll
      for (int q = 0; q < 2; ++q) rk[q] = *(const u32x4*)(Kc + (kgo + (unsigned)(2 * (kt + 1) + q) * kstep));
#pragma unroll
      for (int q = 0; q < NV; ++q) rv[q] = *(const u32x4*)(Vc + (vgo + q * vstep + (unsigned)(kt + 1) * 128u));
    }
#pragma unroll 1
    for (int sb = 0; sb < 2; ++sb) {
      f32x16 S;
#pragma unroll
      for (int e = 0; e < 16; ++e) S[e] = negC;
#pragma unroll
      for (int t = 0; t < 4; ++t) {
        const bf16x8 kf = *(const bf16x8*)(cur + koff + 32 * sb * TROW + 32 * t);
        S = MFMA(kf, qf[t], S);
      }
#pragma unroll
      for (int e = 0; e < 16; ++e) { S[e] = __builtin_amdgcn_exp2f(S[e]); lsum += S[e]; }
      bf16x8 pf[2];
#pragma unroll
      for (int s = 0; s < 2; ++s) {
        u32x4 pk = {pack2(S[8 * s], S[8 * s + 1]), pack2(S[8 * s + 2], S[8 * s + 3]), pack2(S[8 * s + 4], S[8 * s + 5]), pack2(S[8 * s + 6], S[8 * s + 7])};
        pf[s] = __builtin_bit_cast(bf16x8, pk);
      }
#pragma unroll
      for (int bk = 0; bk < NV; ++bk)
#pragma unroll
        for (int s = 0; s < 2; ++s) {
          const bf16x8 vf = *(const bf16x8*)(cur + voff + 32 * bk * TROW + 64 * sb + 32 * s);
          O[bk] = MFMA(vf, pf[s], O[bk]);
        }
    }
    if (kt + 1 < nt) {
      char* nxt = smem + ((kt + 1) & 1) * ABUF;
#pragma unroll
      for (int q = 0; q < 2; ++q) *(u32x4*)(nxt + soff + q * 32 * TROW) = rk[q];
#pragma unroll
      for (int q = 0; q < NV; ++q) *(u32x4*)(nxt + 64 * TROW + soff + q * 32 * TROW) = rv[q];
    }
    __syncthreads();
  }
}

DI void load_q(bf16x8 (&qf)[4], const bf16_t* __restrict__ qp  , int h) {
#pragma unroll
  for (int t = 0; t < 4; ++t) qf[t] = *(const bf16x8*)(qp + 16 * t + 8 * h);
}

DI void diff_unit(const Params& p, int l, int b, int hh, int qrow0, int nkeys, char* smem) {
  const int tid = get_tid(), lane = tid & 63, w = tid >> 6, r = lane & 31, h = lane >> 5;
  const float lam = p.consts[l * 4 + 0], negC = p.consts[l * 4 + 1], lam_init = p.consts[l * 4 + 3];
  const int qrow = qrow0 + 32 * w + r;
  const bf16_t* Vt = p.DVt + ((size_t)b * 512 + hh * 128) * NKEY;
  float* st = p.stash + (size_t)blockIdx.x * 16384 + w * 4096 + lane * 64;
  f32x16 O[4]; float ls; bf16x8 qf[4];
  float sc1 = 0.f;
#pragma unroll 1
  for (int c = 0; c < 2; ++c) {
    load_q(qf, p.Pm + (size_t)qrow * PMW + C_DQ + (2 * hh + c) * 64, h);
    attn_pass<128>(O, ls, qf, p.DK + (size_t)b * NKEY * 512 + (2 * hh + c) * 64, 512, Vt, nkeys, negC, smem);
    ls += __shfl_xor(ls, 32);
    if (c == 0) {
      const float inv = 1.f / ls;
#pragma unroll
      for (int bk = 0; bk < 4; ++bk)
#pragma unroll
        for (int g4 = 0; g4 < 4; ++g4) {
          const f32x4 v4 = {O[bk][4 * g4] * inv, O[bk][4 * g4 + 1] * inv, O[bk][4 * g4 + 2] * inv, O[bk][4 * g4 + 3] * inv};
          *(f32x4*)(st + bk * 16 + g4 * 4) = v4;
        }
    } else sc1 = -lam / ls;
  }
  float ss = 0.f;
#pragma unroll
  for (int bk = 0; bk < 4; ++bk)
#pragma unroll
    for (int g4 = 0; g4 < 4; ++g4) {
      const f32x4 s4 = *(const f32x4*)(st + bk * 16 + g4 * 4);
#pragma unroll
      for (int e = 0; e < 4; ++e) { const float v = s4[e] + sc1 * O[bk][4 * g4 + e]; O[bk][4 * g4 + e] = v; ss += v * v; }
    }
  ss += __shfl_xor(ss, 32);
  const float rs = __builtin_amdgcn_rsqf(ss * (1.f / 128.f) + 1e-6f) * (1.f - lam_init);
  const float* sub = opaque(p.dsub + l * 128);
  bf16_t* zrow = p.Pm + (size_t)qrow * PMW + C_ZD + hh * 128;
#pragma unroll
  for (int bk = 0; bk < 4; ++bk)
#pragma unroll
    for (int g4 = 0; g4 < 4; ++g4) {
      const int dv0 = 32 * bk + 8 * g4 + 4 * h;
      const u32x2 z = *(const u32x2*)(zrow + dv0);
      const f32x4 sg = *(const f32x4*)(sub + dv0);
      const float o0 = O[bk][4 * g4] * rs * sg[0] * bflo(z[0]), o1 = O[bk][4 * g4 + 1] * rs * sg[1] * bfhi(z[0]);
      const float o2 = O[bk][4 * g4 + 2] * rs * sg[2] * bflo(z[1]), o3 = O[bk][4 * g4 + 3] * rs * sg[3] * bfhi(z[1]);
      u32x2 pk = {pack2(o0, o1), pack2(o2, o3)};
      *(u32x2*)(zrow + dv0) = pk;
      asm volatile("" ::: "memory");
    }
}

DI void gqa_unit(const Params& p, int l, int b, int qh, int qrow0, int nkeys, char* smem) {
  const int tid = get_tid(), lane = tid & 63, w = tid >> 6, r = lane & 31, h = lane >> 5;
  const float negC = p.consts[l * 4 + 2];
  const int qrow = qrow0 + 32 * w + r, kvh = qh >> 2;
  f32x16 O[2]; float ls; bf16x8 qf[4];
  load_q(qf, p.Pm + (size_t)qrow * PMW + C_GQ + qh * 64, h);
  attn_pass<64>(O, ls, qf, p.GK + (size_t)b * NKEY * 128 + kvh * 64, 128, p.GVt + ((size_t)b * 128 + kvh * 64) * NKEY, nkeys, negC, smem);
  ls += __shfl_xor(ls, 32);
  const float inv = 1.f / ls;
  bf16_t* zrow = p.Pm + (size_t)qrow * PMW + C_ZG + qh * 64;
#pragma unroll
  for (int bk = 0; bk < 2; ++bk)
#pragma unroll
    for (int g4 = 0; g4 < 4; ++g4) {
      const int dv0 = 32 * bk + 8 * g4 + 4 * h;
      const u32x2 z = *(const u32x2*)(zrow + dv0);
      const float o0 = O[bk][4 * g4] * inv * bflo(z[0]), o1 = O[bk][4 * g4 + 1] * inv * bfhi(z[0]);
      const float o2 = O[bk][4 * g4 + 2] * inv * bflo(z[1]), o3 = O[bk][4 * g4 + 3] * inv * bfhi(z[1]);
      u32x2 pk = {pack2(o0, o1), pack2(o2, o3)};
      *(u32x2*)(zrow + dv0) = pk;
    }
}

DI void pool_unit(const Params& p, int l, int mt, int g, char* smem) {
  const int tid = get_tid(), lane = tid & 63, w = tid >> 6, wm = w >> 1, wn = w & 1, r = lane & 31, h = lane >> 5;
  const int row0 = mt * 128;
  int seq0, n, t0;
  if (mt < 256) { seq0 = (mt >> 6) * 8192; n = 8192; t0 = (mt & 63) * 128; }
  else { const int c = mt - 256; seq0 = NLAT + (c >> 1) * 256; n = 256; t0 = (c & 1) * 128; }
  const int wnd = 2 << g, left = wnd >> 1, right = wnd - 1 - left;
#pragma unroll 1
  for (int q = 0; q < 8; ++q) {
    const int idx = tid + 256 * q, tok = idx >> 4, ch = idx & 15;
    const int t = t0 + tok;
    const int lo = t - left < 0 ? 0 : t - left, hi = t + right + 1 > n ? n : t + right + 1;
    const bf16_t* up = p.Pm + (size_t)seq0 * PMW + C_U + g * 128 + ch * 8;
    float s[8] = {0.f, 0.f, 0.f, 0.f, 0.f, 0.f, 0.f, 0.f};
    for (int tt = lo; tt < hi; ++tt) {
      const u32x4 v = *(const u32x4*)(up + (size_t)tt * PMW);
#pragma unroll
      for (int e = 0; e < 4; ++e) { s[2 * e] += bflo(v[e]); s[2 * e + 1] += bfhi(v[e]); }
    }
    const u32x4 sv = *(const u32x4*)(up + (size_t)t * PMW);
    const float ic = 1.f / (float)(hi - lo);
    u32x4 o;
#pragma unroll
    for (int e = 0; e < 4; ++e) o[e] = pack2(s[2 * e] * ic - bflo(sv[e]), s[2 * e + 1] * ic - bfhi(sv[e]));
    *(u32x4*)(smem + (ch >> 3) * (2 * TILEB) + tok * TROW + (ch & 7) * 16) = o;
    const u32x4 wv = *(const u32x4*)(p.WpT + (size_t)(l * 4 + g) * 128 * 128 + (size_t)tok * 128 + ch * 8);
    *(u32x4*)(smem + (ch >> 3) * (2 * TILEB) + TILEB + tok * TROW + (ch & 7) * 16) = wv;
  }
  __syncthreads();
  f32x16 acc[2][2]; zero_acc(acc);
  const int aoff = (64 * wm + r) * TROW + 16 * h;
  const int boff = TILEB + (64 * wn + r) * TROW + 16 * h;
#pragma unroll
  for (int kt = 0; kt < 2; ++kt) {
    const char* cur = smem + kt * (2 * TILEB);
#pragma unroll
    for (int t = 0; t < 4; ++t) {
      const bf16x8 a0 = *(const bf16x8*)(cur + aoff + 32 * t);
      const bf16x8 a1 = *(const bf16x8*)(cur + aoff + 32 * TROW + 32 * t);
      const bf16x8 b0 = *(const bf16x8*)(cur + boff + 32 * t);
      const bf16x8 b1 = *(const bf16x8*)(cur + boff + 32 * TROW + 32 * t);
      acc[0][0] = MFMA(a0, b0, acc[0][0]); acc[0][1] = MFMA(a0, b1, acc[0][1]);
      acc[1][0] = MFMA(a1, b0, acc[1][0]); acc[1][1] = MFMA(a1, b1, acc[1][1]);
    }
  }
  __syncthreads();
  bf16_t* zp = p.Pm + (size_t)row0 * PMW + C_ZP + g * 128;
  const float* ps = p.pool_scale + l * 512 + g * 128;
#pragma unroll
  for (int i = 0; i < 2; ++i)
#pragma unroll
    for (int j = 0; j < 2; ++j) {
      const int nn = 64 * wn + 32 * j + r;
      const float sc = ps[nn];
#pragma unroll
      for (int e = 0; e < 16; ++e) {
        bf16_t* a = zp + (size_t)(64 * wm + 32 * i + crow(e, h)) * PMW + nn;
        *a = f2bf(acc[i][j][e] * sc * bf2f(*a));
      }
    }
}

DI void phase3(const Params& p, int l, char* smem) {
  const int nCtxD = l == 0 ? 32 : 0, nCtxG = l == 0 ? 64 : 0, nPool = (l == 0 ? 264 : 256) * 4;
  const int e1 = 1024, e2 = e1 + 2048, e3 = e2 + nCtxD, e4 = e3 + nCtxG, e5 = e4 + nPool;
  for (int i = blockIdx.x; i < e5; i += gridDim.x) {
    if (i < e1) {
      const int x = i & 7, j = i >> 3, bh = x + 8 * (j >> 6), qb = j & 63;
      diff_unit(p, l, bh >> 2, bh & 3, (bh >> 2) * 8192 + qb * 128, NKEY, smem);
    } else if (i < e2) {
      const int i2 = i - e1, x = i2 & 7, j = i2 >> 3, b = x >> 1, qh = (x & 1) * 4 + (j >> 6), qb = j & 63;
      gqa_unit(p, l, b, qh, b * 8192 + qb * 128, NKEY, smem);
    } else if (i < e3) {
      const int i3 = i - e2, b = i3 >> 3, hh = (i3 >> 1) & 3, qb = i3 & 1;
      diff_unit(p, l, b, hh, NLAT + b * 256 + qb * 128, 256, smem);
    } else if (i < e4) {
      const int i4 = i - e3, b = i4 >> 4, qh = (i4 >> 1) & 7, qb = i4 & 1;
      gqa_unit(p, l, b, qh, NLAT + b * 256 + qb * 128, 256, smem);
    } else {
      const int i5 = i - e4;
      pool_unit(p, l, i5 >> 2, i5 & 3, smem);
    }
  }
}

DI void phase4(const Params& p, int l, char* smem) {
  const int tid = get_tid(), lane = tid & 63, w = tid >> 6, wm = w >> 1, wn = w & 1, r = lane & 31, h = lane >> 5;
  const bf16_t* W = p.WinT + (size_t)l * 7424 * 1024;
  TileWalk tw; tw.init(l == 0 ? 264 : 256, 8);
  int mt, pn;
  while (tw.next(mt, pn)) {
    const int row0 = mt * 128, n0 = pn * 128;
    unsigned* gs = p.gsc + ((size_t)blockIdx.x * 256 + tid) * 96;
#pragma unroll 1
    for (int i = 0; i < 3; ++i) {
      f32x16 acc[2][2]; zero_acc(acc);
      gemm_kloop<false>(acc, p.h + (size_t)row0 * 1024, 1024, W + (size_t)(4352 + i * 1024 + n0) * 1024, 1024, 1024, smem);
#pragma unroll
      for (int a = 0; a < 2; ++a)
#pragma unroll
        for (int c = 0; c < 2; ++c)
#pragma unroll
          for (int e4 = 0; e4 < 2; ++e4) {
            u32x4 g4v;
#pragma unroll
            for (int e = 0; e < 4; ++e) g4v[e] = pack2(fast_sigmoid(acc[a][c][8 * e4 + 2 * e]), fast_sigmoid(acc[a][c][8 * e4 + 2 * e + 1]));
            *(u32x4*)(gs + i * 32 + (a * 2 + c) * 8 + e4 * 4) = g4v;
          }
    }
    f32x16 yacc[2][2]; zero_acc(yacc);
#pragma unroll 1
    for (int i = 0; i < 3; ++i) {
      f32x16 acc[2][2]; zero_acc(acc);
      const int zc = i == 0 ? C_ZP : (i == 1 ? C_ZD : C_ZG);
      gemm_kloop<false>(acc, p.Pm + (size_t)row0 * PMW + zc, PMW, p.WbT + ((size_t)(l * 3 + i) * 1024 + n0) * 512, 512, 512, smem);
#pragma unroll
      for (int a = 0; a < 2; ++a)
#pragma unroll
        for (int c = 0; c < 2; ++c) {
#pragma unroll
          for (int e4 = 0; e4 < 2; ++e4) {
            const u32x4 g4v = *(const u32x4*)(gs + i * 32 + (a * 2 + c) * 8 + e4 * 4);
#pragma unroll
            for (int e = 0; e < 4; ++e) {
              yacc[a][c][8 * e4 + 2 * e] += bflo(g4v[e]) * acc[a][c][8 * e4 + 2 * e];
              yacc[a][c][8 * e4 + 2 * e + 1] += bfhi(g4v[e]) * acc[a][c][8 * e4 + 2 * e + 1];
            }
          }
          asm volatile("" ::: "memory");
        }
    }
    bf16_t* dst = p.y + (size_t)row0 * 1024 + n0;
#pragma unroll
    for (int a = 0; a < 2; ++a)
#pragma unroll
      for (int c = 0; c < 2; ++c)
#pragma unroll
        for (int e = 0; e < 16; ++e)
          dst[(size_t)(64 * wm + 32 * a + crow(e, h)) * 1024 + 64 * wn + 32 * c + r] = f2bf(yacc[a][c][e]);
  }
}

DI void phase5(const Params& p, int l, char* smem) {
  const int tid = get_tid(), lane = tid & 63, w = tid >> 6, wm = w >> 1, wn = w & 1, r = lane & 31, h = lane >> 5;
  const float* xlat = l == 0 ? p.x : p.out;
  TileWalk tw; tw.init(l == 0 ? 264 : 256, 8);
  int mt, pn;
  while (tw.next(mt, pn)) {
    const int row0 = mt * 128, n0 = pn * 128;
    f32x16 acc[2][2]; zero_acc(acc);
    gemm_kloop<false>(acc, p.y + (size_t)row0 * 1024, 1024, p.WoT + ((size_t)l * 1024 + n0) * 1024, 1024, 1024, smem);
    const bool isctx = mt >= 256;
    const float* src = isctx ? p.ctx + (size_t)(row0 - NLAT) * 1024 : xlat + (size_t)row0 * 1024;
    float* dst = isctx ? p.xc1 + (size_t)(row0 - NLAT) * 1024 : p.out + (size_t)row0 * 1024;
    const float* gate = p.mod + (l * 5 + (isctx ? 4 : (mt >> 6))) * 3072 + 2048 + n0;
#pragma unroll
    for (int a = 0; a < 2; ++a)
#pragma unroll
      for (int c = 0; c < 2; ++c) {
        const int nn = 64 * wn + 32 * c + r;
        const float gt = gate[nn];
#pragma unroll
        for (int e = 0; e < 16; ++e) {
          const size_t o = (size_t)(64 * wm + 32 * a + crow(e, h)) * 1024 + n0 + nn;
          dst[o] = src[o] + gt * acc[a][c][e];
        }
      }
  }
}

__global__ void __launch_bounds__(256, 2) fwd_kernel(Params p, int ph0, int ph1) {
  __shared__ __attribute__((aligned(16))) char smem[SMEM_BYTES];
  cg::grid_group grid = cg::this_grid();
  for (int ph = ph0; ph < ph1; ++ph) {
#ifndef PHMASK
#define PHMASK 63
#endif
    if (ph == 0) { if (PHMASK & 1) phase0(p, smem); }
    else {
      const int l = (ph - 1) / 5, s = (ph - 1) % 5;
      if (s == 0) { if (PHMASK & 2) phase1(p, l); }
      else if (s == 1) { if (PHMASK & 4) phase2(p, l, smem); }
      else if (s == 2) { if (PHMASK & 8) phase3(p, l, smem); }
      else if (s == 3) { if (PHMASK & 16) phase4(p, l, smem); }
      else { if (PHMASK & 32) phase5(p, l, smem); }
    }
    if (ph + 1 < ph1) grid.sync();
  }
}

extern "C" void kernel_launch(void* const* d_in, const int* in_sizes, int n_in, void* d_out, int out_size,
                              void* d_ws, size_t ws_size, hipStream_t stream) {
  static int grid_blocks = 0;
  if (!grid_blocks) {
    int dev = 0, cus = 0, per_cu = 0;
    (void)hipGetDevice(&dev);
    (void)hipDeviceGetAttribute(&cus, hipDeviceAttributeMultiprocessorCount, dev);
    (void)hipOccupancyMaxActiveBlocksPerMultiprocessor(&per_cu, fwd_kernel, 256, 0);
    if (per_cu > 2) per_cu = 2;
    if (per_cu < 1) per_cu = 1;
    grid_blocks = (cus * per_cu) & ~7;
  }
  Params p{};
  p.x = (const float*)d_in[0]; p.c = (const float*)d_in[1]; p.ctx = (const float*)d_in[2]; p.c_ctx = (const float*)d_in[3];
  p.ada_w = (const float*)d_in[4]; p.ada_b = (const float*)d_in[5]; p.norm_g = (const float*)d_in[6]; p.w_in = (const float*)d_in[7];
  p.pool_w = (const float*)d_in[8]; p.pool_scale = (const float*)d_in[9]; p.dqn = (const float*)d_in[10]; p.dkn = (const float*)d_in[11];
  p.dlam = (const float*)d_in[12]; p.dsub = (const float*)d_in[13]; p.gqn = (const float*)d_in[14]; p.gkn = (const float*)d_in[15];
  p.w_branch = (const float*)d_in[16]; p.w_out = (const float*)d_in[17];
  p.out = (float*)d_out;
  char* ws = (char*)d_ws; size_t off = 0;
  auto take = [&](size_t bytes) { char* q = ws + off; off += (bytes + 255) & ~(size_t)255; return q; };
  p.mod = (float*)take(2 * 5 * 3072 * 4);
  p.consts = (float*)take(256);
  p.WinT = (bf16_t*)take((size_t)2 * 7424 * 1024 * 2);
  p.WbT = (bf16_t*)take((size_t)2 * 3 * 1024 * 512 * 2);
  p.WoT = (bf16_t*)take((size_t)2 * 1024 * 1024 * 2);
  p.WpT = (bf16_t*)take((size_t)2 * 4 * 128 * 128 * 2);
  p.h = (bf16_t*)take((size_t)NTOK * 1024 * 2);
  p.y = (bf16_t*)take((size_t)NTOK * 1024 * 2);
  p.Pm = (bf16_t*)take((size_t)NTOK * PMW * 2);
  p.DK = (bf16_t*)take((size_t)4 * NKEY * 512 * 2);
  p.DVt = (bf16_t*)take((size_t)4 * NKEY * 512 * 2);
  p.GK = (bf16_t*)take((size_t)4 * NKEY * 128 * 2);
  p.GVt = (bf16_t*)take((size_t)4 * NKEY * 128 * 2);
  p.xc1 = (float*)take((size_t)1024 * 1024 * 4);
  p.gsc = (unsigned*)p.DK;
  p.stash = (float*)p.y;
  if (off > ws_size) { fprintf(stderr, "workspace too small: need %zu have %zu\n", off, ws_size); return; }
#if MULTI_LAUNCH
  for (int ph = 0; ph < 11; ++ph) hipLaunchKernelGGL(fwd_kernel, dim3(grid_blocks), dim3(256), 0, stream, p, ph, ph + 1);
#else
  int ph0 = 0, ph1 = 11;
  void* args[] = {&p, &ph0, &ph1};
  hipError_t e = hipLaunchCooperativeKernel((void*)fwd_kernel, dim3(grid_blocks), dim3(256), args, 0, stream);
  if (e != hipSuccess) fprintf(stderr, "cooperative launch failed: %s (grid %d)\n", hipGetErrorString(e), grid_blocks);
#endif
}
```

```cpp
#include <hip/hip_runtime.h>
#include <hip/hip_cooperative_groups.h>
#include <cstdio>
namespace cg = cooperative_groups;

typedef unsigned short bf16_t;
typedef short bf16x8 __attribute__((ext_vector_type(8)));
typedef float f32x16 __attribute__((ext_vector_type(16)));
typedef float f32x4 __attribute__((ext_vector_type(4)));
typedef float f32x2 __attribute__((ext_vector_type(2)));
typedef unsigned u32x4 __attribute__((ext_vector_type(4)));
typedef unsigned u32x2 __attribute__((ext_vector_type(2)));
typedef __bf16 bf16v2 __attribute__((ext_vector_type(2)));

#define DI __device__ __forceinline__
#define MFMA(a, b, c) __builtin_amdgcn_mfma_f32_32x32x16_bf16((a), (b), (c), 0, 0, 0)

#ifndef MULTI_LAUNCH
#define MULTI_LAUNCH 0
#endif

constexpr int NLAT = 32768, NTOK = 33792, NKEY = 8448;
constexpr int PMW = 3072;
constexpr int C_U = 0, C_ZP = 512, C_DQ = 1024, C_ZD = 1536, C_GQ = 2048, C_ZG = 2560;
constexpr int TROW = 144;
constexpr int TILEB = 128 * TROW;
constexpr int SMEM_BYTES = 4 * TILEB;
constexpr int ABUF = 64 * TROW + 128 * TROW;
constexpr float LOG2E = 1.4426950408889634f;

struct Params {
  const float *x, *c, *ctx, *c_ctx, *ada_w, *ada_b, *norm_g, *w_in, *pool_w, *pool_scale, *dqn, *dkn, *dlam, *dsub, *gqn, *gkn, *w_branch, *w_out;
  float* out;
  float* mod;
  float* consts;
  bf16_t *WinT, *WbT, *WoT, *WpT, *h, *y, *Pm, *DK, *DVt, *GK, *GVt;
  float* xc1;
  float* stash;
  unsigned* gsc;
  unsigned* bar;
};

DI unsigned pack2(float a, float b) { f32x2 v = {a, b}; bf16v2 r = __builtin_convertvector(v, bf16v2); return __builtin_bit_cast(unsigned, r); }
DI bf16_t f2bf(float a) { return (bf16_t)(pack2(a, a) & 0xffffu); }
DI float bf2f(unsigned v) { return __uint_as_float(v << 16); }
DI float bflo(unsigned v) { return __uint_as_float(v << 16); }
DI float bfhi(unsigned v) { return __uint_as_float(v & 0xffff0000u); }
DI float fast_sigmoid(float v) { return __builtin_amdgcn_rcpf(1.f + __expf(-v)); }
DI float fast_silu(float v) { return v * fast_sigmoid(v); }
DI float wave_sum(float v) {
#pragma unroll
  for (int o = 32; o >= 1; o >>= 1) v += __shfl_xor(v, o);
  return v;
}
DI float wave_max(float v) {
#pragma unroll
  for (int o = 32; o >= 1; o >>= 1) v = fmaxf(v, __shfl_xor(v, o));
  return v;
}
DI int get_tid() { int t = threadIdx.x; asm volatile("" : "+v"(t)); return t; }
template <typename T> DI const T* opaque(const T* q) { asm volatile("" : "+s"(q)); return q; }
DI int crow(int reg, int h) { return (reg & 3) + 8 * (reg >> 2) + 4 * h; }

template <bool SWAP>
DI void gemm_kloop(f32x16 (&acc)[2][2], const bf16_t* __restrict__ A, int lda, const bf16_t* __restrict__ Bt, int ldb, int K, char* smem) {
  const int tid = get_tid(), lane = tid & 63, w = tid >> 6, wm = w >> 1, wn = w & 1, r = lane & 31, h = lane >> 5;
  const int srow = tid >> 3, sch = tid & 7;
  const unsigned ago = (unsigned)(srow * lda + sch * 8) * 2u, bgo = (unsigned)(srow * ldb + sch * 8) * 2u;
  const unsigned astep = (unsigned)lda * 64u, bstep = (unsigned)ldb * 64u;
  const char* Ab = (const char*)A; const char* Bb = (const char*)Bt;
  const int soff = srow * TROW + sch * 16;
  u32x4 ra[4], rb[4];
#pragma unroll
  for (int q = 0; q < 4; ++q) {
    ra[q] = *(const u32x4*)(Ab + (ago + q * astep));
    rb[q] = *(const u32x4*)(Bb + (bgo + q * bstep));
  }
#pragma unroll
  for (int q = 0; q < 4; ++q) {
    *(u32x4*)(smem + soff + q * 32 * TROW) = ra[q];
    *(u32x4*)(smem + TILEB + soff + q * 32 * TROW) = rb[q];
  }
  __syncthreads();
  const int nk = K >> 6;
  const int aoff = (64 * wm + r) * TROW + 16 * h;
  const int boff = TILEB + (64 * wn + r) * TROW + 16 * h;
  for (int kt = 0; kt < nk; ++kt) {
    const char* cur = smem + (kt & 1) * (2 * TILEB);
    if (kt + 1 < nk) {
#pragma unroll
      for (int q = 0; q < 4; ++q) {
        ra[q] = *(const u32x4*)(Ab + (ago + q * astep + (unsigned)(kt + 1) * 128u));
        rb[q] = *(const u32x4*)(Bb + (bgo + q * bstep + (unsigned)(kt + 1) * 128u));
      }
    }
#pragma unroll
    for (int t = 0; t < 4; ++t) {
      const bf16x8 a0 = *(const bf16x8*)(cur + aoff + 32 * t);
      const bf16x8 a1 = *(const bf16x8*)(cur + aoff + 32 * TROW + 32 * t);
      const bf16x8 b0 = *(const bf16x8*)(cur + boff + 32 * t);
      const bf16x8 b1 = *(const bf16x8*)(cur + boff + 32 * TROW + 32 * t);
      if (!SWAP) {
        acc[0][0] = MFMA(a0, b0, acc[0][0]); acc[0][1] = MFMA(a0, b1, acc[0][1]);
        acc[1][0] = MFMA(a1, b0, acc[1][0]); acc[1][1] = MFMA(a1, b1, acc[1][1]);
      } else {
        acc[0][0] = MFMA(b0, a0, acc[0][0]); acc[0][1] = MFMA(b1, a0, acc[0][1]);
        acc[1][0] = MFMA(b0, a1, acc[1][0]); acc[1][1] = MFMA(b1, a1, acc[1][1]);
      }
    }
    if (kt + 1 < nk) {
      char* nxt = smem + ((kt + 1) & 1) * (2 * TILEB);
#pragma unroll
      for (int q = 0; q < 4; ++q) {
        *(u32x4*)(nxt + soff + q * 32 * TROW) = ra[q];
        *(u32x4*)(nxt + TILEB + soff + q * 32 * TROW) = rb[q];
      }
    }
    __syncthreads();
  }
}

DI void zero_acc(f32x16 (&acc)[2][2]) {
#pragma unroll
  for (int i = 0; i < 2; ++i)
#pragma unroll
    for (int j = 0; j < 2; ++j)
#pragma unroll
      for (int e = 0; e < 16; ++e) acc[i][j][e] = 0.f;
}

struct TileWalk {
  int MP, wlast, kf, ktot, x, j, nbx;
  DI void init(int MT, int NT) {
    x = blockIdx.x & 7; j = blockIdx.x >> 3; nbx = gridDim.x >> 3;
    MP = MT >> 3; const int NP = (NT + 7) >> 3; wlast = NT - 8 * (NP - 1);
    const int nfullp = (NP - 1) * MP, totp = NP * MP;
    kf = (nfullp - x + 7) >> 3; if (kf < 0) kf = 0;
    ktot = (totp - x + 7) >> 3; if (ktot < 0) ktot = 0;
  }
  DI bool next(int& m, int& n) {
    int k, q;
    if (j < 64 * kf) { k = j >> 6; q = j & 63; }
    else { const int j2 = j - 64 * kf, pw = 8 * wlast; k = kf + j2 / pw; q = j2 % pw; }
    if (k >= ktot) return false;
    const int id = x + 8 * k, np = id / MP, mp = id % MP;
    m = mp * 8 + (q & 7); n = np * 8 + (q >> 3);
    j += nbx;
    return true;
  }
};

DI void transpose_tile(const float* __restrict__ src, int N, bf16_t* __restrict__ dst, int K, int kt, int nt, char* smem) {
  float* t = (float*)smem;
  const int tid = get_tid();
#pragma unroll
  for (int q = 0; q < 4; ++q) {
    const int idx = tid + 256 * q, row = idx >> 4, c4 = idx & 15;
    const f32x4 v = *(const f32x4*)(src + (size_t)(kt * 64 + row) * N + nt * 64 + c4 * 4);
    t[row * 65 + c4 * 4 + 0] = v[0]; t[row * 65 + c4 * 4 + 1] = v[1]; t[row * 65 + c4 * 4 + 2] = v[2]; t[row * 65 + c4 * 4 + 3] = v[3];
  }
  __syncthreads();
#pragma unroll
  for (int q = 0; q < 2; ++q) {
    const int idx = tid + 256 * q, jn = idx >> 3, kc = idx & 7;
    u32x4 o;
#pragma unroll
    for (int e = 0; e < 4; ++e) o[e] = pack2(t[(kc * 8 + 2 * e) * 65 + jn], t[(kc * 8 + 2 * e + 1) * 65 + jn]);
    *(u32x4*)(dst + (size_t)(nt * 64 + jn) * K + kt * 64 + kc * 8) = o;
  }
  __syncthreads();
}

DI void phase0(const Params& p, char* smem) {
  const int tid = get_tid(), lane = tid & 63, w = tid >> 6;
  constexpr int PER_L = 1856 + 384 + 256 + 16;
  constexpr int NTR = 2 * PER_L, NADA = 96;
  for (int u = blockIdx.x; u < NTR + NADA + 1; u += gridDim.x) {
    if (u < NTR) {
      const int l = u / PER_L; int r = u % PER_L;
      if (r < 1856) { transpose_tile(p.w_in + (size_t)l * 1024 * 7424, 7424, p.WinT + (size_t)l * 7424 * 1024, 1024, r / 116, r % 116, smem); }
      else if (r < 2240) { r -= 1856; const int i = r >> 7, r2 = r & 127;
        transpose_tile(p.w_branch + (size_t)(l * 3 + i) * 512 * 1024, 1024, p.WbT + (size_t)(l * 3 + i) * 1024 * 512, 512, r2 >> 4, r2 & 15, smem); }
      else if (r < 2496) { r -= 2240; transpose_tile(p.w_out + (size_t)l * 1024 * 1024, 1024, p.WoT + (size_t)l * 1024 * 1024, 1024, r >> 4, r & 15, smem); }
      else { r -= 2496; const int g = r >> 2;
        transpose_tile(p.pool_w + (size_t)(l * 4 + g) * 128 * 128, 128, p.WpT + (size_t)(l * 4 + g) * 128 * 128, 128, (r >> 1) & 1, r & 1, smem); }
    } else if (u < NTR + NADA) {
      const int a = u - NTR, l = a / 48, n0 = (a % 48) * 64;
      float* s = (float*)smem;
      for (int i = tid; i < 5 * 1024; i += 256) {
        const int rr = i >> 10, k = i & 1023;
        const float v = rr < 4 ? p.c[rr * 1024 + k] : p.c_ctx[k];
        s[i] = v / (1.f + __expf(-v));
      }
      __syncthreads();
      float a5[5] = {0.f, 0.f, 0.f, 0.f, 0.f};
      const float* wp = p.ada_w + (size_t)l * 1024 * 3072 + n0 + lane;
      for (int k = w * 256; k < w * 256 + 256; ++k) {
        const float wv = wp[(size_t)k * 3072];
#pragma unroll
        for (int rr = 0; rr < 5; ++rr) a5[rr] += s[rr * 1024 + k] * wv;
      }
      __syncthreads();
      float* part = (float*)smem + 5 * 1024;
#pragma unroll
      for (int rr = 0; rr < 5; ++rr) part[(w * 5 + rr) * 64 + lane] = a5[rr];
      __syncthreads();
      for (int i = tid; i < 5 * 64; i += 256) {
        const int rr = i >> 6, nn = i & 63;
        const float v = part[(0 * 5 + rr) * 64 + nn] + part[(1 * 5 + rr) * 64 + nn] + part[(2 * 5 + rr) * 64 + nn] + part[(3 * 5 + rr) * 64 + nn];
        p.mod[(l * 5 + rr) * 3072 + n0 + nn] = v + p.ada_b[l * 3072 + n0 + nn];
      }
      __syncthreads();
    } else {
      if (w == 0) {
        for (int l = 0; l < 2; ++l) {
          const float* lp = p.dlam + l * 256;
          const float s1 = wave_sum(lp[lane] * lp[64 + lane]);
          const float s2 = wave_sum(lp[128 + lane] * lp[192 + lane]);
          const float lam_init = 0.8f - 0.6f * expf(-0.3f * (float)l);
          const float lam = expf(s1) - expf(s2) + lam_init;
          const float mdq = wave_max(fabsf(p.dqn[l * 64 + lane])), mdk = wave_max(fabsf(p.dkn[l * 64 + lane]));
          const float mgq = wave_max(fabsf(p.gqn[l * 64 + lane])), mgk = wave_max(fabsf(p.gkn[l * 64 + lane]));
          if (lane == 0) {
            p.consts[l * 4 + 0] = lam;
            p.consts[l * 4 + 1] = -(LOG2E * 8.f * mdq * mdk);
            p.consts[l * 4 + 2] = -(LOG2E * 8.f * mgq * mgk);
            p.consts[l * 4 + 3] = lam_init;
          }
        }
      }
    }
  }
}

DI void phase1(const Params& p, int l) {
  const int tid = get_tid(), lane = tid & 63, w = tid >> 6;
  const float* xlat = l == 0 ? p.x : p.out;
  const float* xctx = l == 0 ? p.ctx : p.xc1;
  const float* g = p.norm_g + l * 1024;
  for (int rb = blockIdx.x * 4; rb < NTOK; rb += gridDim.x * 4) {
    const int row = rb + w;
    const float* src; int mr;
    if (row < NLAT) { src = xlat + (size_t)row * 1024; mr = row >> 13; } else { src = xctx + (size_t)(row - NLAT) * 1024; mr = 4; }
    const float* md = p.mod + (l * 5 + mr) * 3072;
    f32x4 v[4]; float ss = 0.f;
#pragma unroll
    for (int q = 0; q < 4; ++q) { v[q] = *(const f32x4*)(src + q * 256 + lane * 4); ss += v[q][0] * v[q][0] + v[q][1] * v[q][1] + v[q][2] * v[q][2] + v[q][3] * v[q][3]; }
    ss = wave_sum(ss);
    const float rstd = __builtin_amdgcn_rsqf(ss * (1.f / 1024.f) + 1e-6f);
#pragma unroll
    for (int q = 0; q < 4; ++q) {
      const int k = q * 256 + lane * 4;
      const f32x4 gg = *(const f32x4*)(g + k), sh = *(const f32x4*)(md + k), sc = *(const f32x4*)(md + 1024 + k);
      float o[4];
#pragma unroll
      for (int e = 0; e < 4; ++e) o[e] = v[q][e] * rstd * gg[e] * (1.f + sc[e]) + sh[e];
      u32x2 pk = {pack2(o[0], o[1]), pack2(o[2], o[3])};
      *(u32x2*)(p.h + (size_t)row * 1024 + k) = pk;
    }
  }
}

DI void p2_plain(const f32x16 (&acc)[2][2], bf16_t* __restrict__ dst  , bool silu) {
  const int tid = get_tid(), lane = tid & 63, w = tid >> 6, wm = w >> 1, wn = w & 1, r = lane & 31, h = lane >> 5;
#pragma unroll
  for (int i = 0; i < 2; ++i)
#pragma unroll
    for (int j = 0; j < 2; ++j)
#pragma unroll
      for (int e = 0; e < 16; ++e) {
        float v = acc[i][j][e];
        if (silu) v = fast_silu(v);
        dst[(size_t)(64 * wm + 32 * i + crow(e, h)) * PMW + 64 * wn + 32 * j + r] = f2bf(v);
      }
}

DI void p2_qk(const f32x16 (&acc)[2][2], bf16_t* __restrict__ dst, int ldd, const float* __restrict__ gn, bool rope, int t0, float oscale) {
  const int tid = get_tid(), lane = tid & 63, w = tid >> 6, wm = w >> 1, r = lane & 31, h = lane >> 5;
#pragma unroll
  for (int i = 0; i < 2; ++i) {
    const int tok = 64 * wm + 32 * i + r;
    float y[2][16]; float ss = 0.f;
#pragma unroll
    for (int j = 0; j < 2; ++j)
#pragma unroll
      for (int e = 0; e < 16; ++e) { y[j][e] = acc[i][j][e]; ss += y[j][e] * y[j][e]; }
    ss += __shfl_xor(ss, 32);
    const float rstd = __builtin_amdgcn_rsqf(ss * (1.f / 64.f) + 1e-6f);
#pragma unroll
    for (int j = 0; j < 2; ++j)
#pragma unroll
      for (int e = 0; e < 16; ++e) y[j][e] *= rstd * gn[32 * j + crow(e, h)];
    if (rope) {
      const int tseq = t0 + tok;
#pragma unroll
      for (int j = 0; j < 2; ++j) {
        const float pos = (float)(j == 0 ? (tseq >> 6) : (tseq & 63));
#pragma unroll
        for (int e = 0; e < 8; ++e) {
          const float m = (float)crow(e, h);
          const float ang = pos * __builtin_amdgcn_exp2f(m * -0.8304820237218406f);
          const float cs = __cosf(ang), sn = __sinf(ang);
          const float x1 = y[j][e], x2 = y[j][e + 8];
          y[j][e] = x1 * cs - x2 * sn; y[j][e + 8] = x1 * sn + x2 * cs;
        }
      }
    }
    bf16_t* drow = dst + (size_t)tok * ldd;
#pragma unroll
    for (int j = 0; j < 2; ++j)
#pragma unroll
      for (int g4 = 0; g4 < 4; ++g4) {
        u32x2 pk = {pack2(y[j][4 * g4] * oscale, y[j][4 * g4 + 1] * oscale), pack2(y[j][4 * g4 + 2] * oscale, y[j][4 * g4 + 3] * oscale)};
        *(u32x2*)(drow + 32 * j + 8 * g4 + 4 * h) = pk;
      }
  }
}

DI void p2_v(const f32x16 (&acc)[2][2], bf16_t* __restrict__ dst) {
  const int tid = get_tid(), lane = tid & 63, w = tid >> 6, wm = w >> 1, wn = w & 1, r = lane & 31, h = lane >> 5;
#pragma unroll
  for (int i = 0; i < 2; ++i)
#pragma unroll
    for (int j = 0; j < 2; ++j)
#pragma unroll
      for (int e = 0; e < 16; ++e)
        dst[(size_t)(64 * wn + 32 * j + crow(e, h)) * NKEY + 64 * wm + 32 * i + r] = f2bf(acc[i][j][e]);
}

DI void phase2(const Params& p, int l, char* smem) {
  const int w = get_tid() >> 6, wn = w & 1;
  const bf16_t* W = p.WinT + (size_t)l * 7424 * 1024;
  TileWalk tw; tw.init(264, 34);
  int mt, pn;
  while (tw.next(mt, pn)) {
    const int row0 = mt * 128;
    const bool isctx = mt >= 256;
    const int b = isctx ? ((mt - 256) >> 1) : (mt >> 6);
    const int t0 = isctx ? ((mt - 256) & 1) * 128 : (mt & 63) * 128;
    const int key0 = isctx ? t0 : 256 + t0;
    const bf16_t* A = p.h + (size_t)row0 * 1024;
    const bf16_t* Bt = W + (size_t)pn * 128 * 1024;
    f32x16 acc[2][2]; zero_acc(acc);
    const bool plain = pn < 8 || (pn >= 20 && pn < 24) || pn >= 30;
    if (plain) {
      gemm_kloop<false>(acc, A, 1024, Bt, 1024, 1024, smem);
      int pcol; bool silu;
      if (pn < 4) { pcol = pn * 128; silu = false; } else if (pn < 8) { pcol = pn * 128; silu = true; }
      else if (pn < 24) { pcol = pn * 128 - 1024; silu = true; } else { pcol = pn * 128 - 1280; silu = true; }
      p2_plain(acc, p.Pm + (size_t)row0 * PMW + pcol, silu);
    } else {
      gemm_kloop<true>(acc, A, 1024, Bt, 1024, 1024, smem);
      if (pn < 12) {
        p2_qk(acc, p.Pm + (size_t)row0 * PMW + pn * 128 + 64 * wn, PMW, p.dqn + l * 64, !isctx, t0, LOG2E * 0.125f);
      } else if (pn < 16) {
        p2_qk(acc, p.DK + ((size_t)b * NKEY + key0) * 512 + (pn - 12) * 128 + 64 * wn, 512, p.dkn + l * 64, !isctx, t0, 1.f);
      } else if (pn < 20) {
        p2_v(acc, p.DVt + ((size_t)b * 512 + (pn - 16) * 128) * NKEY + key0);
      } else if (pn < 28) {
        p2_qk(acc, p.Pm + (size_t)row0 * PMW + pn * 128 - 1024 + 64 * wn, PMW, p.gqn + l * 64, !isctx, t0, LOG2E * 0.125f);
      } else if (pn == 28) {
        p2_qk(acc, p.GK + ((size_t)b * NKEY + key0) * 128 + 64 * wn, 128, p.gkn + l * 64, !isctx, t0, 1.f);
      } else {
        p2_v(acc, p.GVt + ((size_t)b * 128) * NKEY + key0);
      }
    }
  }
}

template <int DV>
DI void attn_pass(f32x16 (&O)[DV / 32], float& lsum, const bf16x8 (&qf)[4], const bf16_t* __restrict__ Kb, int ldk, const bf16_t* __restrict__ Vt, int nkeys, float negC, char* smem) {
  constexpr int NV = DV / 32;
  const int tid = get_tid(), lane = tid & 63, r = lane & 31, h = lane >> 5;
  const int pr = (r & 19) | ((r & 4) << 1) | ((r & 8) >> 1);
  const int srow = tid >> 3, sch = tid & 7;
  const unsigned kgo = (unsigned)(srow * ldk + sch * 8) * 2u, vgo = (unsigned)(srow * NKEY + sch * 8) * 2u;
  const unsigned kstep = (unsigned)ldk * 64u;
  constexpr unsigned vstep = (unsigned)NKEY * 64u;
  const char* Kc = (const char*)Kb; const char* Vc = (const char*)Vt;
  const int soff = srow * TROW + sch * 16;
  u32x4 rk[2], rv[NV];
#pragma unroll
  for (int q = 0; q < 2; ++q) rk[q] = *(const u32x4*)(Kc + (kgo + q * kstep));
#pragma unroll
  for (int q = 0; q < NV; ++q) rv[q] = *(const u32x4*)(Vc + (vgo + q * vstep));
#pragma unroll
  for (int q = 0; q < 2; ++q) *(u32x4*)(smem + soff + q * 32 * TROW) = rk[q];
#pragma unroll
  for (int q = 0; q < NV; ++q) *(u32x4*)(smem + 64 * TROW + soff + q * 32 * TROW) = rv[q];
  __syncthreads();
#pragma unroll
  for (int bk = 0; bk < NV; ++bk)
#pragma unroll
    for (int e = 0; e < 16; ++e) O[bk][e] = 0.f;
  lsum = 0.f;
  const int koff = pr * TROW + 16 * h;
  const int voff = 64 * TROW + r * TROW + 16 * h;
  const int nt = nkeys >> 6;
  for (int kt = 0; kt < nt; ++kt) {
    const char* cur = smem + (kt & 1) * ABUF;
    if (kt + 1 < nt) {
#pragma unroll
      for (int q = 0; q < 2; ++q) rk[q] = *(const u32x4*)(Kc + (kgo + (unsigned)(2 * (kt + 1) + q) * kstep));
#pragma unroll
      for (int q = 0; q < NV; ++q) rv[q] = *(const u32x4*)(Vc + (vgo + q * vstep + (unsigned)(kt + 1) * 128u));
    }
#pragma unroll 1
    for (int sb = 0; sb < 2; ++sb) {
      f32x16 S;
#pragma unroll
      for (int e = 0; e < 16; ++e) S[e] = negC;
#pragma unroll
      for (int t = 0; t < 4; ++t) {
        const bf16x8 kf = *(const bf16x8*)(cur + koff + 32 * sb * TROW + 32 * t);
        S = MFMA(kf, qf[t], S);
      }
#pragma unroll
      for (int e = 0; e < 16; ++e) { S[e] = __builtin_amdgcn_exp2f(S[e]); lsum += S[e]; }
      bf16x8 pf[2];
#pragma unroll
      for (int s = 0; s < 2; ++s) {
        u32x4 pk = {pack2(S[8 * s], S[8 * s + 1]), pack2(S[8 * s + 2], S[8 * s + 3]), pack2(S[8 * s + 4], S[8 * s + 5]), pack2(S[8 * s + 6], S[8 * s + 7])};
        pf[s] = __builtin_bit_cast(bf16x8, pk);
      }
#pragma unroll
      for (int bk = 0; bk < NV; ++bk)
#pragma unroll
        for (int s = 0; s < 2; ++s) {
          const bf16x8 vf = *(const bf16x8*)(cur + voff + 32 * bk * TROW + 64 * sb + 32 * s);
          O[bk] = MFMA(vf, pf[s], O[bk]);
        }
    }
    if (kt + 1 < nt) {
      char* nxt = smem + ((kt + 1) & 1) * ABUF;
#pragma unroll
      for (int q = 0; q < 2; ++q) *(u32x4*)(nxt + soff + q * 32 * TROW) = rk[q];
#pragma unroll
      for (int q = 0; q < NV; ++q) *(u32x4*)(nxt + 64 * TROW + soff + q * 32 * TROW) = rv[q];
    }
    __syncthreads();
  }
}

DI void load_q(bf16x8 (&qf)[4], const bf16_t* __restrict__ qp  , int h) {
#pragma unroll
  for (int t = 0; t < 4; ++t) qf[t] = *(const bf16x8*)(qp + 16 * t + 8 * h);
}

DI void diff_unit(const Params& p, int l, int b, int hh, int qrow0, int nkeys, char* smem) {
  const int tid = get_tid(), lane = tid & 63, w = tid >> 6, r = lane & 31, h = lane >> 5;
  const float lam = p.consts[l * 4 + 0], negC = p.consts[l * 4 + 1], lam_init = p.consts[l * 4 + 3];
  const int qrow = qrow0 + 32 * w + r;
  const bf16_t* Vt = p.DVt + ((size_t)b * 512 + hh * 128) * NKEY;
  float* st = p.stash + (size_t)blockIdx.x * 16384 + w * 4096 + lane * 64;
  f32x16 O[4]; float ls; bf16x8 qf[4];
  float sc1 = 0.f;
#pragma unroll 1
  for (int c = 0; c < 2; ++c) {
    load_q(qf, p.Pm + (size_t)qrow * PMW + C_DQ + (2 * hh + c) * 64, h);
    attn_pass<128>(O, ls, qf, p.DK + (size_t)b * NKEY * 512 + (2 * hh + c) * 64, 512, Vt, nkeys, negC, smem);
    ls += __shfl_xor(ls, 32);
    if (c == 0) {
      const float inv = 1.f / ls;
#pragma unroll
      for (int bk = 0; bk < 4; ++bk)
#pragma unroll
        for (int g4 = 0; g4 < 4; ++g4) {
          const f32x4 v4 = {O[bk][4 * g4] * inv, O[bk][4 * g4 + 1] * inv, O[bk][4 * g4 + 2] * inv, O[bk][4 * g4 + 3] * inv};
          *(f32x4*)(st + bk * 16 + g4 * 4) = v4;
        }
    } else sc1 = -lam / ls;
  }
  float ss = 0.f;
#pragma unroll
  for (int bk = 0; bk < 4; ++bk)
#pragma unroll
    for (int g4 = 0; g4 < 4; ++g4) {
      const f32x4 s4 = *(const f32x4*)(st + bk * 16 + g4 * 4);
#pragma unroll
      for (int e = 0; e < 4; ++e) { const float v = s4[e] + sc1 * O[bk][4 * g4 + e]; O[bk][4 * g4 + e] = v; ss += v * v; }
    }
  ss += __shfl_xor(ss, 32);
  const float rs = __builtin_amdgcn_rsqf(ss * (1.f / 128.f) + 1e-6f) * (1.f - lam_init);
  const float* sub = opaque(p.dsub + l * 128);
  bf16_t* zrow = p.Pm + (size_t)qrow * PMW + C_ZD + hh * 128;
#pragma unroll
  for (int bk = 0; bk < 4; ++bk)
#pragma unroll
    for (int g4 = 0; g4 < 4; ++g4) {
      const int dv0 = 32 * bk + 8 * g4 + 4 * h;
      const u32x2 z = *(const u32x2*)(zrow + dv0);
      const f32x4 sg = *(const f32x4*)(sub + dv0);
      const float o0 = O[bk][4 * g4] * rs * sg[0] * bflo(z[0]), o1 = O[bk][4 * g4 + 1] * rs * sg[1] * bfhi(z[0]);
      const float o2 = O[bk][4 * g4 + 2] * rs * sg[2] * bflo(z[1]), o3 = O[bk][4 * g4 + 3] * rs * sg[3] * bfhi(z[1]);
      u32x2 pk = {pack2(o0, o1), pack2(o2, o3)};
      *(u32x2*)(zrow + dv0) = pk;
      asm volatile("" ::: "memory");
    }
}

DI void gqa_unit(const Params& p, int l, int b, int qh, int qrow0, int nkeys, char* smem) {
  const int tid = get_tid(), lane = tid & 63, w = tid >> 6, r = lane & 31, h = lane >> 5;
  const float negC = p.consts[l * 4 + 2];
  const int qrow = qrow0 + 32 * w + r, kvh = qh >> 2;
  f32x16 O[2]; float ls; bf16x8 qf[4];
  load_q(qf, p.Pm + (size_t)qrow * PMW + C_GQ + qh * 64, h);
  attn_pass<64>(O, ls, qf, p.GK + (size_t)b * NKEY * 128 + kvh * 64, 128, p.GVt + ((size_t)b * 128 + kvh * 64) * NKEY, nkeys, negC, smem);
  ls += __shfl_xor(ls, 32);
  const float inv = 1.f / ls;
  bf16_t* zrow = p.Pm + (size_t)qrow * PMW + C_ZG + qh * 64;
#pragma unroll
  for (int bk = 0; bk < 2; ++bk)
#pragma unroll
    for (int g4 = 0; g4 < 4; ++g4) {
      const int dv0 = 32 * bk + 8 * g4 + 4 * h;
      const u32x2 z = *(const u32x2*)(zrow + dv0);
      const float o0 = O[bk][4 * g4] * inv * bflo(z[0]), o1 = O[bk][4 * g4 + 1] * inv * bfhi(z[0]);
      const float o2 = O[bk][4 * g4 + 2] * inv * bflo(z[1]), o3 = O[bk][4 * g4 + 3] * inv * bfhi(z[1]);
      u32x2 pk = {pack2(o0, o1), pack2(o2, o3)};
      *(u32x2*)(zrow + dv0) = pk;
    }
}

DI void pool_unit(const Params& p, int l, int mt, int g, char* smem) {
  const int tid = get_tid(), lane = tid & 63, w = tid >> 6, wm = w >> 1, wn = w & 1, r = lane & 31, h = lane >> 5;
  const int row0 = mt * 128;
  int seq0, n, t0;
  if (mt < 256) { seq0 = (mt >> 6) * 8192; n = 8192; t0 = (mt & 63) * 128; }
  else { const int c = mt - 256; seq0 = NLAT + (c >> 1) * 256; n = 256; t0 = (c & 1) * 128; }
  const int wnd = 2 << g, left = wnd >> 1, right = wnd - 1 - left;
#pragma unroll 1
  for (int q = 0; q < 8; ++q) {
    const int idx = tid + 256 * q, tok = idx >> 4, ch = idx & 15;
    const int t = t0 + tok;
    const int lo = t - left < 0 ? 0 : t - left, hi = t + right + 1 > n ? n : t + right + 1;
    const bf16_t* up = p.Pm + (size_t)seq0 * PMW + C_U + g * 128 + ch * 8;
    float s[8] = {0.f, 0.f, 0.f, 0.f, 0.f, 0.f, 0.f, 0.f};
    for (int tt = lo; tt < hi; ++tt) {
      const u32x4 v = *(const u32x4*)(up + (size_t)tt * PMW);
#pragma unroll
      for (int e = 0; e < 4; ++e) { s[2 * e] += bflo(v[e]); s[2 * e + 1] += bfhi(v[e]); }
    }
    const u32x4 sv = *(const u32x4*)(up + (size_t)t * PMW);
    const float ic = 1.f / (float)(hi - lo);
    u32x4 o;
#pragma unroll
    for (int e = 0; e < 4; ++e) o[e] = pack2(s[2 * e] * ic - bflo(sv[e]), s[2 * e + 1] * ic - bfhi(sv[e]));
    *(u32x4*)(smem + (ch >> 3) * (2 * TILEB) + tok * TROW + (ch & 7) * 16) = o;
    const u32x4 wv = *(const u32x4*)(p.WpT + (size_t)(l * 4 + g) * 128 * 128 + (size_t)tok * 128 + ch * 8);
    *(u32x4*)(smem + (ch >> 3) * (2 * TILEB) + TILEB + tok * TROW + (ch & 7) * 16) = wv;
  }
  __syncthreads();
  f32x16 acc[2][2]; zero_acc(acc);
  const int aoff = (64 * wm + r) * TROW + 16 * h;
  const int boff = TILEB + (64 * wn + r) * TROW + 16 * h;
#pragma unroll
  for (int kt = 0; kt < 2; ++kt) {
    const char* cur = smem + kt * (2 * TILEB);
#pragma unroll
    for (int t = 0; t < 4; ++t) {
      const bf16x8 a0 = *(const bf16x8*)(cur + aoff + 32 * t);
      const bf16x8 a1 = *(const bf16x8*)(cur + aoff + 32 * TROW + 32 * t);
      const bf16x8 b0 = *(const bf16x8*)(cur + boff + 32 * t);
      const bf16x8 b1 = *(const bf16x8*)(cur + boff + 32 * TROW + 32 * t);
      acc[0][0] = MFMA(a0, b0, acc[0][0]); acc[0][1] = MFMA(a0, b1, acc[0][1]);
      acc[1][0] = MFMA(a1, b0, acc[1][0]); acc[1][1] = MFMA(a1, b1, acc[1][1]);
    }
  }
  __syncthreads();
  bf16_t* zp = p.Pm + (size_t)row0 * PMW + C_ZP + g * 128;
  const float* ps = p.pool_scale + l * 512 + g * 128;
#pragma unroll
  for (int i = 0; i < 2; ++i)
#pragma unroll
    for (int j = 0; j < 2; ++j) {
      const int nn = 64 * wn + 32 * j + r;
      const float sc = ps[nn];
#pragma unroll
      for (int e = 0; e < 16; ++e) {
        bf16_t* a = zp + (size_t)(64 * wm + 32 * i + crow(e, h)) * PMW + nn;
        *a = f2bf(acc[i][j][e] * sc * bf2f(*a));
      }
    }
}

DI void phase3(const Params& p, int l, char* smem) {
  const int nCtxD = l == 0 ? 32 : 0, nCtxG = l == 0 ? 64 : 0, nPool = (l == 0 ? 264 : 256) * 4;
  const int e1 = 1024, e2 = e1 + 2048, e3 = e2 + nCtxD, e4 = e3 + nCtxG, e5 = e4 + nPool;
  for (int i = blockIdx.x; i < e5; i += gridDim.x) {
    if (i < e1) {
      const int x = i & 7, j = i >> 3, bh = x + 8 * (j >> 6), qb = j & 63;
      diff_unit(p, l, bh >> 2, bh & 3, (bh >> 2) * 8192 + qb * 128, NKEY, smem);
    } else if (i < e2) {
      const int i2 = i - e1, x = i2 & 7, j = i2 >> 3, b = x >> 1, qh = (x & 1) * 4 + (j >> 6), qb = j & 63;
      gqa_unit(p, l, b, qh, b * 8192 + qb * 128, NKEY, smem);
    } else if (i < e3) {
      const int i3 = i - e2, b = i3 >> 3, hh = (i3 >> 1) & 3, qb = i3 & 1;
      diff_unit(p, l, b, hh, NLAT + b * 256 + qb * 128, 256, smem);
    } else if (i < e4) {
      const int i4 = i - e3, b = i4 >> 4, qh = (i4 >> 1) & 7, qb = i4 & 1;
      gqa_unit(p, l, b, qh, NLAT + b * 256 + qb * 128, 256, smem);
    } else {
      const int i5 = i - e4;
      pool_unit(p, l, i5 >> 2, i5 & 3, smem);
    }
  }
}

DI void phase4(const Params& p, int l, char* smem) {
  const int tid = get_tid(), lane = tid & 63, w = tid >> 6, wm = w >> 1, wn = w & 1, r = lane & 31, h = lane >> 5;
  const bf16_t* W = p.WinT + (size_t)l * 7424 * 1024;
  TileWalk tw; tw.init(l == 0 ? 264 : 256, 8);
  int mt, pn;
  while (tw.next(mt, pn)) {
    const int row0 = mt * 128, n0 = pn * 128;
    unsigned* gs = p.gsc + ((size_t)blockIdx.x * 256 + tid) * 96;
#pragma unroll 1
    for (int i = 0; i < 3; ++i) {
      f32x16 acc[2][2]; zero_acc(acc);
      gemm_kloop<false>(acc, p.h + (size_t)row0 * 1024, 1024, W + (size_t)(4352 + i * 1024 + n0) * 1024, 1024, 1024, smem);
#pragma unroll
      for (int a = 0; a < 2; ++a)
#pragma unroll
        for (int c = 0; c < 2; ++c)
#pragma unroll
          for (int e4 = 0; e4 < 2; ++e4) {
            u32x4 g4v;
#pragma unroll
            for (int e = 0; e < 4; ++e) g4v[e] = pack2(fast_sigmoid(acc[a][c][8 * e4 + 2 * e]), fast_sigmoid(acc[a][c][8 * e4 + 2 * e + 1]));
            *(u32x4*)(gs + i * 32 + (a * 2 + c) * 8 + e4 * 4) = g4v;
          }
    }
    f32x16 yacc[2][2]; zero_acc(yacc);
#pragma unroll 1
    for (int i = 0; i < 3; ++i) {
      f32x16 acc[2][2]; zero_acc(acc);
      const int zc = i == 0 ? C_ZP : (i == 1 ? C_ZD : C_ZG);
      gemm_kloop<false>(acc, p.Pm + (size_t)row0 * PMW + zc, PMW, p.WbT + ((size_t)(l * 3 + i) * 1024 + n0) * 512, 512, 512, smem);
#pragma unroll
      for (int a = 0; a < 2; ++a)
#pragma unroll
        for (int c = 0; c < 2; ++c) {
#pragma unroll
          for (int e4 = 0; e4 < 2; ++e4) {
            const u32x4 g4v = *(const u32x4*)(gs + i * 32 + (a * 2 + c) * 8 + e4 * 4);
#pragma unroll
            for (int e = 0; e < 4; ++e) {
              yacc[a][c][8 * e4 + 2 * e] += bflo(g4v[e]) * acc[a][c][8 * e4 + 2 * e];
              yacc[a][c][8 * e4 + 2 * e + 1] += bfhi(g4v[e]) * acc[a][c][8 * e4 + 2 * e + 1];
            }
          }
          asm volatile("" ::: "memory");
        }
    }
    bf16_t* dst = p.y + (size_t)row0 * 1024 + n0;
#pragma unroll
    for (int a = 0; a < 2; ++a)
#pragma unroll
      for (int c = 0; c < 2; ++c)
#pragma unroll
        for (int e = 0; e < 16; ++e)
          dst[(size_t)(64 * wm + 32 * a + crow(e, h)) * 1024 + 64 * wn + 32 * c + r] = f2bf(yacc[a][c][e]);
  }
}

DI void phase5(const Params& p, int l, char* smem) {
  const int tid = get_tid(), lane = tid & 63, w = tid >> 6, wm = w >> 1, wn = w & 1, r = lane & 31, h = lane >> 5;
  const float* xlat = l == 0 ? p.x : p.out;
  TileWalk tw; tw.init(l == 0 ? 264 : 256, 8);
  int mt, pn;
  while (tw.next(mt, pn)) {
    const int row0 = mt * 128, n0 = pn * 128;
    f32x16 acc[2][2]; zero_acc(acc);
    gemm_kloop<false>(acc, p.y + (size_t)row0 * 1024, 1024, p.WoT + ((size_t)l * 1024 + n0) * 1024, 1024, 1024, smem);
    const bool isctx = mt >= 256;
    const float* src = isctx ? p.ctx + (size_t)(row0 - NLAT) * 1024 : xlat + (size_t)row0 * 1024;
    float* dst = isctx ? p.xc1 + (size_t)(row0 - NLAT) * 1024 : p.out + (size_t)row0 * 1024;
    const float* gate = p.mod + (l * 5 + (isctx ? 4 : (mt >> 6))) * 3072 + 2048 + n0;
#pragma unroll
    for (int a = 0; a < 2; ++a)
#pragma unroll
      for (int c = 0; c < 2; ++c) {
        const int nn = 64 * wn + 32 * c + r;
        const float gt = gate[nn];
#pragma unroll
        for (int e = 0; e < 16; ++e) {
          const size_t o = (size_t)(64 * wm + 32 * a + crow(e, h)) * 1024 + n0 + nn;
          dst[o] = src[o] + gt * acc[a][c][e];
        }
      }
  }
}

DI void grid_barrier(unsigned* ctr, unsigned& target) {
  __syncthreads();
  if (threadIdx.x == 0) {
    target += gridDim.x;
    __builtin_amdgcn_fence(__ATOMIC_RELEASE, "agent");
    asm volatile("s_waitcnt vmcnt(0)" ::: "memory");
    __hip_atomic_fetch_add(ctr, 1u, __ATOMIC_RELAXED, __HIP_MEMORY_SCOPE_AGENT);
    while (__hip_atomic_load(ctr, __ATOMIC_RELAXED, __HIP_MEMORY_SCOPE_AGENT) < target) __builtin_amdgcn_s_sleep(2);
    __builtin_amdgcn_fence(__ATOMIC_ACQUIRE, "agent");
    asm volatile("s_waitcnt vmcnt(0)" ::: "memory");
  }
  __syncthreads();
}

__global__ void __launch_bounds__(256, 2) fwd_kernel(Params p, int ph0, int ph1) {
  __shared__ __attribute__((aligned(16))) char smem[SMEM_BYTES];
  cg::grid_group grid = cg::this_grid();
  unsigned bar_target = 0;
  for (int ph = ph0; ph < ph1; ++ph) {
#ifndef PHMASK
#define PHMASK 63
#endif
    if (ph == 0) { if (PHMASK & 1) phase0(p, smem); }
    else {
      const int l = (ph - 1) / 5, s = (ph - 1) % 5;
      if (s == 0) { if (PHMASK & 2) phase1(p, l); }
      else if (s == 1) { if (PHMASK & 4) phase2(p, l, smem); }
      else if (s == 2) { if (PHMASK & 8) phase3(p, l, smem); }
      else if (s == 3) { if (PHMASK & 16) phase4(p, l, smem); }
      else { if (PHMASK & 32) phase5(p, l, smem); }
    }
    if (ph + 1 < ph1) {
      if (ph1 > 64) grid.sync();
      else grid_barrier(p.bar, bar_target);
    }
  }
}

extern "C" void kernel_launch(void* const* d_in, const int* in_sizes, int n_in, void* d_out, int out_size,
                              void* d_ws, size_t ws_size, hipStream_t stream) {
  static int grid_blocks = 0;
  if (!grid_blocks) {
    int dev = 0, cus = 0, per_cu = 0;
    (void)hipGetDevice(&dev);
    (void)hipDeviceGetAttribute(&cus, hipDeviceAttributeMultiprocessorCount, dev);
    (void)hipOccupancyMaxActiveBlocksPerMultiprocessor(&per_cu, fwd_kernel, 256, 0);
    if (per_cu > 2) per_cu = 2;
    if (per_cu < 1) per_cu = 1;
    grid_blocks = (cus * per_cu) & ~7;
  }
  Params p{};
  p.x = (const float*)d_in[0]; p.c = (const float*)d_in[1]; p.ctx = (const float*)d_in[2]; p.c_ctx = (const float*)d_in[3];
  p.ada_w = (const float*)d_in[4]; p.ada_b = (const float*)d_in[5]; p.norm_g = (const float*)d_in[6]; p.w_in = (const float*)d_in[7];
  p.pool_w = (const float*)d_in[8]; p.pool_scale = (const float*)d_in[9]; p.dqn = (const float*)d_in[10]; p.dkn = (const float*)d_in[11];
  p.dlam = (const float*)d_in[12]; p.dsub = (const float*)d_in[13]; p.gqn = (const float*)d_in[14]; p.gkn = (const float*)d_in[15];
  p.w_branch = (const float*)d_in[16]; p.w_out = (const float*)d_in[17];
  p.out = (float*)d_out;
  char* ws = (char*)d_ws; size_t off = 0;
  auto take = [&](size_t bytes) { char* q = ws + off; off += (bytes + 255) & ~(size_t)255; return q; };
  p.mod = (float*)take(2 * 5 * 3072 * 4);
  p.consts = (float*)take(256);
  p.bar = (unsigned*)take(256);
  p.WinT = (bf16_t*)take((size_t)2 * 7424 * 1024 * 2);
  p.WbT = (bf16_t*)take((size_t)2 * 3 * 1024 * 512 * 2);
  p.WoT = (bf16_t*)take((size_t)2 * 1024 * 1024 * 2);
  p.WpT = (bf16_t*)take((size_t)2 * 4 * 128 * 128 * 2);
  p.h = (bf16_t*)take((size_t)NTOK * 1024 * 2);
  p.y = (bf16_t*)take((size_t)NTOK * 1024 * 2);
  p.Pm = (bf16_t*)take((size_t)NTOK * PMW * 2);
  p.DK = (bf16_t*)take((size_t)4 * NKEY * 512 * 2);
  p.DVt = (bf16_t*)take((size_t)4 * NKEY * 512 * 2);
  p.GK = (bf16_t*)take((size_t)4 * NKEY * 128 * 2);
  p.GVt = (bf16_t*)take((size_t)4 * NKEY * 128 * 2);
  p.xc1 = (float*)take((size_t)1024 * 1024 * 4);
  p.gsc = (unsigned*)p.DK;
  p.stash = (float*)p.y;
  if (off > ws_size) { fprintf(stderr, "workspace too small: need %zu have %zu\n", off, ws_size); return; }
#if MULTI_LAUNCH
  for (int ph = 0; ph < 11; ++ph) hipLaunchKernelGGL(fwd_kernel, dim3(grid_blocks), dim3(256), 0, stream, p, ph, ph + 1);
#else
  (void)hipMemsetAsync(p.bar, 0, 256, stream);
  int ph0 = 0, ph1 = 11;
  void* args[] = {&p, &ph0, &ph1};
  hipError_t e = hipLaunchCooperativeKernel((void*)fwd_kernel, dim3(grid_blocks), dim3(256), args, 0, stream);
  if (e != hipSuccess) fprintf(stderr, "cooperative launch failed: %s (grid %d)\n", hipGetErrorString(e), grid_blocks);
#endif
}
```

```cpp
#include <hip/hip_runtime.h>
#include <hip/hip_cooperative_groups.h>
#include <cstdio>
namespace cg = cooperative_groups;

typedef unsigned short bf16_t;
typedef short bf16x8 __attribute__((ext_vector_type(8)));
typedef float f32x16 __attribute__((ext_vector_type(16)));
typedef float f32x4 __attribute__((ext_vector_type(4)));
typedef float f32x2 __attribute__((ext_vector_type(2)));
typedef unsigned u32x4 __attribute__((ext_vector_type(4)));
typedef unsigned u32x2 __attribute__((ext_vector_type(2)));
typedef __bf16 bf16v2 __attribute__((ext_vector_type(2)));

#define DI __device__ __forceinline__
#define MFMA(a, b, c) __builtin_amdgcn_mfma_f32_32x32x16_bf16((a), (b), (c), 0, 0, 0)

#ifndef MULTI_LAUNCH
#define MULTI_LAUNCH 0
#endif

constexpr int NLAT = 32768, NTOK = 33792, NKEY = 8448;
constexpr int PMW = 3072;
constexpr int C_U = 0, C_ZP = 512, C_DQ = 1024, C_ZD = 1536, C_GQ = 2048, C_ZG = 2560;
constexpr int TROW = 144;
constexpr int TILEB = 128 * TROW;
constexpr int TILE256 = 256 * TROW;
constexpr int STAGE8 = 2 * TILE256;
constexpr int SMEM_BYTES = 2 * STAGE8;
constexpr int GRP_SMEM = STAGE8;
constexpr int ABUF = 64 * TROW + 128 * TROW;
constexpr float LOG2E = 1.4426950408889634f;

struct Params {
  const float *x, *c, *ctx, *c_ctx, *ada_w, *ada_b, *norm_g, *w_in, *pool_w, *pool_scale, *dqn, *dkn, *dlam, *dsub, *gqn, *gkn, *w_branch, *w_out;
  float* out;
  float* mod;
  float* consts;
  bf16_t *WinT, *WbT, *WoT, *WpT, *h, *y, *Pm, *DK, *DVt, *GK, *GVt;
  float* xc1;
  float* stash;
  unsigned* gsc;
  unsigned* bar;
};

DI unsigned pack2(float a, float b) { f32x2 v = {a, b}; bf16v2 r = __builtin_convertvector(v, bf16v2); return __builtin_bit_cast(unsigned, r); }
DI bf16_t f2bf(float a) { return (bf16_t)(pack2(a, a) & 0xffffu); }
DI float bf2f(unsigned v) { return __uint_as_float(v << 16); }
DI float bflo(unsigned v) { return __uint_as_float(v << 16); }
DI float bfhi(unsigned v) { return __uint_as_float(v & 0xffff0000u); }
DI float fast_sigmoid(float v) { return __builtin_amdgcn_rcpf(1.f + __expf(-v)); }
DI float fast_silu(float v) { return v * fast_sigmoid(v); }
DI float wave_sum(float v) {
#pragma unroll
  for (int o = 32; o >= 1; o >>= 1) v += __shfl_xor(v, o);
  return v;
}
DI float wave_max(float v) {
#pragma unroll
  for (int o = 32; o >= 1; o >>= 1) v = fmaxf(v, __shfl_xor(v, o));
  return v;
}
DI int get_tid() { int t = threadIdx.x; asm volatile("" : "+v"(t)); return t; }
template <typename T> DI const T* opaque(const T* q) { asm volatile("" : "+s"(q)); return q; }
DI int crow(int reg, int h) { return (reg & 3) + 8 * (reg >> 2) + 4 * h; }

namespace g8 {
#define G8_LAS __attribute__((address_space(3)))
constexpr int BK = 64, HALF = 128, HTB = HALF * BK * 2, STAGE_BYTES = 8 * HTB;
DI int lds_byte(int r, int c) { const int st = (r >> 4) * 2 + (c >> 5), rr = r & 15, cc = c & 31, ob = rr * 64 + cc * 2; return st * 1024 + (ob ^ (((ob >> 9) & 1) << 5)); }
DI void stage_rc(int b, int& R, int& C) { const int st = b / 1024, sb = b % 1024, swz = sb ^ (((sb >> 9) & 1) << 5); R = (st >> 1) * 16 + swz / 64; C = (st & 1) * 32 + (swz % 64) / 2; }

struct Unit {
  const char* A; const char* B;
  int lda2, ldb2;
  int nt;
  int kind, i0, i1, i2;
};

template <bool SIGMA, class Sched, class Epi>
DI void gemm_phase(char* smem, const Sched& S, const Epi& E) {
  G8_LAS unsigned char* lds = (G8_LAS unsigned char*)smem;
  const int tid = get_tid(), wid = __builtin_amdgcn_readfirstlane(tid >> 6), lane = tid & 63, wr = wid >> 2, wc = wid & 3, fr = lane & 15, fq = lane >> 4;
  int Rn[2], Rb[2], C2[2];
#pragma unroll
  for (int i = 0; i < 2; ++i) { int R, C; stage_rc(tid * 16 + i * 8192, R, C); Rn[i] = R; Rb[i] = SIGMA ? 64 * (R >> 5) + (R & 31) : R; C2[i] = C * 2; }
  const unsigned ldsw = (unsigned)wid * 1024u;
  const int aoff = lds_byte(wr * 64 + fr, fq * 8), boff = lds_byte(wc * 32 + fr, fq * 8);
#define G8_SA(b, h) (((b) * 2 + (h)) * HTB)
#define G8_SB(b, h) ((4 + (b) * 2 + (h)) * HTB)
#define G8_STAGE(bufoff, gbase, RR, ld2) do { \
    __builtin_amdgcn_global_load_lds((const unsigned*)((const char*)(gbase) + (unsigned)((RR)[0] * (ld2) + C2[0])), (G8_LAS unsigned*)(lds + (bufoff) + ldsw), 16, 0, 0); \
    __builtin_amdgcn_global_load_lds((const unsigned*)((const char*)(gbase) + (unsigned)((RR)[1] * (ld2) + C2[1])), (G8_LAS unsigned*)(lds + (bufoff) + ldsw + 8192), 16, 0, 0); } while (0)
#define G8_LDA(dst, b, h) do { _Pragma("unroll") for (int m = 0; m < 4; ++m) _Pragma("unroll") for (int k = 0; k < 2; ++k) dst[m][k] = *(const G8_LAS bf16x8*)(lds + G8_SA(b, h) + aoff + m * 2048 + k * 1024); } while (0)
#define G8_LDB(dst, b, h) do { _Pragma("unroll") for (int n = 0; n < 2; ++n) _Pragma("unroll") for (int k = 0; k < 2; ++k) dst[n][k] = *(const G8_LAS bf16x8*)(lds + G8_SB(b, h) + boff + n * 2048 + k * 1024); } while (0)
#define G8_MMA(ai, bj, At, Bt) do { __builtin_amdgcn_s_setprio(1); _Pragma("unroll") for (int m = 0; m < 4; ++m) _Pragma("unroll") for (int n = 0; n < 2; ++n) _Pragma("unroll") for (int k = 0; k < 2; ++k) \
    acc[ai][bj][m][n] = __builtin_amdgcn_mfma_f32_16x16x32_bf16(Bt[n][k], At[m][k], acc[ai][bj][m][n], 0, 0, 0); __builtin_amdgcn_s_setprio(0); } while (0)
#define G8_WAIT_V(n) asm volatile("s_waitcnt vmcnt(" #n ")" ::: "memory")
#define G8_WAIT_L(n) asm volatile("s_waitcnt lgkmcnt(" #n ")" ::: "memory")
#define G8_BAR __builtin_amdgcn_s_barrier()
#define G8_SCHED __builtin_amdgcn_sched_barrier(0)
  Unit cur, nxt; int ui = 0;
  if (!S.next(0, cur)) return;
  f32x4 acc[2][2][4][2];
#pragma unroll
  for (int a = 0; a < 2; ++a)
#pragma unroll
    for (int b = 0; b < 2; ++b)
#pragma unroll
      for (int m = 0; m < 4; ++m)
#pragma unroll
        for (int n = 0; n < 2; ++n) acc[a][b][m][n] = (f32x4){0.f, 0.f, 0.f, 0.f};
  bf16x8 At[4][2], B0[2][2], B1[2][2];
  int lA = cur.lda2, lB = cur.ldb2;
  unsigned hA = (unsigned)(HALF * lA), hB = (unsigned)((SIGMA ? 32 : HALF) * lB);
  const size_t kstep = (size_t)(BK * 2);
  const char* cA = cur.A; const char* cB = cur.B;
  G8_STAGE(G8_SB(0, 0), cB, Rb, lB); G8_STAGE(G8_SA(0, 0), cA, Rn, lA); G8_STAGE(G8_SB(0, 1), cB + hB, Rb, lB); G8_STAGE(G8_SA(0, 1), cA + hA, Rn, lA);
  if (wr == 1) G8_BAR;
  G8_WAIT_V(4); G8_BAR;
  G8_STAGE(G8_SB(1, 0), cB + kstep, Rb, lB); G8_STAGE(G8_SA(1, 0), cA + kstep, Rn, lA); G8_STAGE(G8_SB(1, 1), cB + hB + kstep, Rb, lB);
  G8_WAIT_V(6); G8_BAR;
  for (;;) {
    const bool has_next = S.next(ui + 1, nxt);
    const char* nA = has_next ? nxt.A : cA; const char* nB = has_next ? nxt.B : cB;
    const int nlA = has_next ? nxt.lda2 : lA, nlB = has_next ? nxt.ldb2 : lB;
    const unsigned nhA = (unsigned)(HALF * nlA), nhB = (unsigned)((SIGMA ? 32 : HALF) * nlB);
    const int nt = cur.nt;
    for (int t = 0; t < nt; t += 2) {
      const bool last = (t == nt - 2);
      const char* a1 = cA + (size_t)(t + 1) * kstep;
      const char* a2 = last ? nA : cA + (size_t)(t + 2) * kstep; const char* b2 = last ? nB : cB + (size_t)(t + 2) * kstep;
      const char* a3 = a2 + kstep; const char* b3 = b2 + kstep;
      const int xlA = last ? nlA : lA, xlB = last ? nlB : lB;
      const unsigned xhA = last ? nhA : hA, xhB = last ? nhB : hB;
      G8_LDB(B0, 0, 0); G8_SCHED; G8_LDA(At, 0, 0); G8_STAGE(G8_SA(1, 1), a1 + hA, Rn, lA);
      G8_WAIT_L(8); G8_BAR; G8_WAIT_L(0); G8_MMA(0, 0, At, B0); G8_BAR; G8_SCHED;
      G8_LDB(B1, 0, 1); G8_STAGE(G8_SB(0, 0), b2, Rb, xlB);
      G8_BAR; G8_WAIT_L(0); G8_MMA(0, 1, At, B1); G8_BAR;
      G8_LDA(At, 0, 1); G8_STAGE(G8_SA(0, 0), a2, Rn, xlA);
      G8_BAR; G8_WAIT_L(0); G8_MMA(1, 0, At, B0); G8_BAR; G8_SCHED;
      G8_STAGE(G8_SB(0, 1), b2 + xhB, Rb, xlB);
      G8_WAIT_V(6); G8_BAR; G8_MMA(1, 1, At, B1); G8_BAR;
      G8_LDB(B0, 1, 0); G8_SCHED; G8_LDA(At, 1, 0); G8_STAGE(G8_SA(0, 1), a2 + xhA, Rn, xlA);
      G8_WAIT_L(8); G8_BAR; G8_WAIT_L(0); G8_MMA(0, 0, At, B0); G8_BAR; G8_SCHED;
      G8_LDB(B1, 1, 1); G8_STAGE(G8_SB(1, 0), b3, Rb, xlB);
      G8_BAR; G8_WAIT_L(0); G8_MMA(0, 1, At, B1); G8_BAR;
      G8_LDA(At, 1, 1); G8_STAGE(G8_SA(1, 0), a3, Rn, xlA);
      G8_BAR; G8_WAIT_L(0); G8_MMA(1, 0, At, B0); G8_BAR; G8_SCHED;
      G8_STAGE(G8_SB(1, 1), b3 + xhB, Rb, xlB);
      G8_WAIT_V(6); G8_BAR; G8_MMA(1, 1, At, B1); G8_BAR;
    }
    E(acc, cur, wr, wc, fr, fq);
    if (!has_next) break;
#pragma unroll
    for (int a = 0; a < 2; ++a)
#pragma unroll
      for (int b = 0; b < 2; ++b)
#pragma unroll
        for (int m = 0; m < 4; ++m)
#pragma unroll
          for (int n = 0; n < 2; ++n) acc[a][b][m][n] = (f32x4){0.f, 0.f, 0.f, 0.f};
    cur = nxt; cA = nA; cB = nB; lA = nlA; lB = nlB; hA = nhA; hB = nhB; ++ui;
  }
  G8_WAIT_V(0);
  if (wr == 0) G8_BAR;
  G8_BAR;
#undef G8_SA
#undef G8_SB
#undef G8_STAGE
#undef G8_LDA
#undef G8_LDB
#undef G8_MMA
#undef G8_WAIT_V
#undef G8_WAIT_L
#undef G8_BAR
#undef G8_SCHED
}
}

DI void zero_acc22(f32x16 (&acc)[2][2]) {
#pragma unroll
  for (int i = 0; i < 2; ++i)
#pragma unroll
    for (int j = 0; j < 2; ++j)
#pragma unroll
      for (int e = 0; e < 16; ++e) acc[i][j][e] = 0.f;
}

struct TileWalk {
  int MP, pwf, wlast, nfull, npart, extra, NPf, x, lb, nbx;
  DI void init(int MT, int NT) {
    x = blockIdx.x & 7; lb = blockIdx.x >> 3; nbx = gridDim.x >> 3;
    MP = MT >> 2;
    if (NT <= 8) { pwf = NT; NPf = 1; wlast = 0; nfull = MP; npart = 0; }
    else { pwf = 8; NPf = NT >> 3; wlast = NT - 8 * NPf; nfull = NPf * MP; npart = wlast ? MP : 0; }
    extra = nfull & 7;
  }
  DI bool at(int it, int& m, int& n) const {
    const int j = lb + it * nbx;
    const int kf = x < nfull ? (nfull - x + 7) >> 3 : 0, tf = 4 * pwf;
    if (j < kf * tf) {
      const int k = j / tf, q = j % tf, id = x + 8 * k, np = id / MP, mp = id % MP;
      m = mp * 4 + (q & 3); n = np * 8 + (q >> 2);
    } else {
      if (npart == 0 || x < extra) return false;
      const int j2 = j - kf * tf, tp = 4 * wlast, pj = (x - extra) + (8 - extra) * (j2 / tp), q = j2 % tp;
      if (pj >= npart) return false;
      m = pj * 4 + (q & 3); n = NPf * 8 + (q >> 2);
    }
    return true;
  }
};

DI void transpose_tile(const float* __restrict__ src, int N, bf16_t* __restrict__ dst, int K, int kt, int nt, char* smem) {
  float* t = (float*)smem;
  const int tid = get_tid();
#pragma unroll
  for (int q = 0; q < 2; ++q) {
    const int idx = tid + 512 * q, row = idx >> 4, c4 = idx & 15;
    const f32x4 v = *(const f32x4*)(src + (size_t)(kt * 64 + row) * N + nt * 64 + c4 * 4);
    t[row * 65 + c4 * 4 + 0] = v[0]; t[row * 65 + c4 * 4 + 1] = v[1]; t[row * 65 + c4 * 4 + 2] = v[2]; t[row * 65 + c4 * 4 + 3] = v[3];
  }
  __syncthreads();
  {
    const int jn = tid >> 3, kc = tid & 7;
    u32x4 o;
#pragma unroll
    for (int e = 0; e < 4; ++e) o[e] = pack2(t[(kc * 8 + 2 * e) * 65 + jn], t[(kc * 8 + 2 * e + 1) * 65 + jn]);
    *(u32x4*)(dst + (size_t)(nt * 64 + jn) * K + kt * 64 + kc * 8) = o;
  }
  __syncthreads();
}

DI void phase0(const Params& p, char* smem) {
  const int tid = get_tid(), lane = tid & 63, w = tid >> 6;
  constexpr int PER_L = 1856 + 384 + 256 + 16;
  constexpr int NTR = 2 * PER_L, NADA = 96;
  for (int u = blockIdx.x; u < NTR + NADA + 1; u += gridDim.x) {
    if (u < NTR) {
      const int l = u / PER_L; int r = u % PER_L;
      if (r < 1856) { transpose_tile(p.w_in + (size_t)l * 1024 * 7424, 7424, p.WinT + (size_t)l * 7424 * 1024, 1024, r / 116, r % 116, smem); }
      else if (r < 2240) { r -= 1856; const int i = r >> 7, r2 = r & 127;
        transpose_tile(p.w_branch + (size_t)(l * 3 + i) * 512 * 1024, 1024, p.WbT + (size_t)(l * 3 + i) * 1024 * 512, 512, r2 >> 4, r2 & 15, smem); }
      else if (r < 2496) { r -= 2240; transpose_tile(p.w_out + (size_t)l * 1024 * 1024, 1024, p.WoT + (size_t)l * 1024 * 1024, 1024, r >> 4, r & 15, smem); }
      else { r -= 2496; const int g = r >> 2;
        transpose_tile(p.pool_w + (size_t)(l * 4 + g) * 128 * 128, 128, p.WpT + (size_t)(l * 4 + g) * 128 * 128, 128, (r >> 1) & 1, r & 1, smem); }
    } else if (u < NTR + NADA) {
      const int a = u - NTR, l = a / 48, n0 = (a % 48) * 64;
      float* s = (float*)smem;
      for (int i = tid; i < 5 * 1024; i += 512) {
        const int rr = i >> 10, k = i & 1023;
        const float v = rr < 4 ? p.c[rr * 1024 + k] : p.c_ctx[k];
        s[i] = v / (1.f + __expf(-v));
      }
      __syncthreads();
      float a5[5] = {0.f, 0.f, 0.f, 0.f, 0.f};
      const float* wp = p.ada_w + (size_t)l * 1024 * 3072 + n0 + lane;
      for (int k = w * 128; k < w * 128 + 128; ++k) {
        const float wv = wp[(size_t)k * 3072];
#pragma unroll
        for (int rr = 0; rr < 5; ++rr) a5[rr] += s[rr * 1024 + k] * wv;
      }
      __syncthreads();
      float* part = (float*)smem + 5 * 1024;
#pragma unroll
      for (int rr = 0; rr < 5; ++rr) part[(w * 5 + rr) * 64 + lane] = a5[rr];
      __syncthreads();
      for (int i = tid; i < 5 * 64; i += 512) {
        const int rr = i >> 6, nn = i & 63;
        float v = 0.f;
#pragma unroll
        for (int ww = 0; ww < 8; ++ww) v += part[(ww * 5 + rr) * 64 + nn];
        p.mod[(l * 5 + rr) * 3072 + n0 + nn] = v + p.ada_b[l * 3072 + n0 + nn];
      }
      __syncthreads();
    } else {
      if (w == 0) {
        for (int l = 0; l < 2; ++l) {
          const float* lp = p.dlam + l * 256;
          const float s1 = wave_sum(lp[lane] * lp[64 + lane]);
          const float s2 = wave_sum(lp[128 + lane] * lp[192 + lane]);
          const float lam_init = 0.8f - 0.6f * expf(-0.3f * (float)l);
          const float lam = expf(s1) - expf(s2) + lam_init;
          const float mdq = wave_max(fabsf(p.dqn[l * 64 + lane])), mdk = wave_max(fabsf(p.dkn[l * 64 + lane]));
          const float mgq = wave_max(fabsf(p.gqn[l * 64 + lane])), mgk = wave_max(fabsf(p.gkn[l * 64 + lane]));
          if (lane == 0) {
            p.consts[l * 4 + 0] = lam;
            p.consts[l * 4 + 1] = -(LOG2E * 8.f * mdq * mdk);
            p.consts[l * 4 + 2] = -(LOG2E * 8.f * mgq * mgk);
            p.consts[l * 4 + 3] = lam_init;
          }
        }
      }
    }
  }
}

DI void phase1(const Params& p, int l) {
  const int tid = get_tid(), lane = tid & 63, w = tid >> 6;
  const float* xlat = l == 0 ? p.x : p.out;
  const float* xctx = l == 0 ? p.ctx : p.xc1;
  const float* g = p.norm_g + l * 1024;
  for (int rb = blockIdx.x * 8; rb < NTOK; rb += gridDim.x * 8) {
    const int row = rb + w;
    const float* src; int mr;
    if (row < NLAT) { src = xlat + (size_t)row * 1024; mr = row >> 13; } else { src = xctx + (size_t)(row - NLAT) * 1024; mr = 4; }
    const float* md = p.mod + (l * 5 + mr) * 3072;
    f32x4 v[4]; float ss = 0.f;
#pragma unroll
    for (int q = 0; q < 4; ++q) { v[q] = *(const f32x4*)(src + q * 256 + lane * 4); ss += v[q][0] * v[q][0] + v[q][1] * v[q][1] + v[q][2] * v[q][2] + v[q][3] * v[q][3]; }
    ss = wave_sum(ss);
    const float rstd = __builtin_amdgcn_rsqf(ss * (1.f / 1024.f) + 1e-6f);
#pragma unroll
    for (int q = 0; q < 4; ++q) {
      const int k = q * 256 + lane * 4;
      const f32x4 gg = *(const f32x4*)(g + k), sh = *(const f32x4*)(md + k), sc = *(const f32x4*)(md + 1024 + k);
      float o[4];
#pragma unroll
      for (int e = 0; e < 4; ++e) o[e] = v[q][e] * rstd * gg[e] * (1.f + sc[e]) + sh[e];
      u32x2 pk = {pack2(o[0], o[1]), pack2(o[2], o[3])};
      *(u32x2*)(p.h + (size_t)row * 1024 + k) = pk;
    }
  }
}

struct Sched2 {
  TileWalk tw; const char* h; const char* W;
  DI bool next(int i, g8::Unit& u) const {
    int mt, pn2;
    if (!tw.at(i, mt, pn2)) return false;
    u.A = h + (size_t)mt * 256 * 2048; u.B = W + (size_t)pn2 * 256 * 2048; u.lda2 = 2048; u.ldb2 = 2048; u.nt = 16;
    u.kind = 0; u.i0 = mt; u.i1 = pn2; u.i2 = 0;
    return true;
  }
};
struct Epi2 {
  const Params& p; int l;
  DI void operator()(const f32x4 (&acc)[2][2][4][2], const g8::Unit& u, int wr, int wc, int fr, int fq) const {
    const int mt = u.i0, pn2 = u.i1, row0 = mt * 256;
    const bool isctx = mt >= 128;
    const int b = isctx ? (mt - 128) : (mt >> 5);
    const int t0 = isctx ? 0 : (mt & 31) * 256;
    const int key0 = isctx ? 0 : 256 + t0;
    const int pn = 2 * pn2 + (wc >> 1), hc = (wc & 1) * 64;
    const bool plain = pn < 8 || (pn >= 20 && pn < 24) || pn >= 30;
    if (plain) {
      int pcol; bool silu;
      if (pn < 4) { pcol = pn * 128; silu = false; } else if (pn < 8) { pcol = pn * 128; silu = true; }
      else if (pn < 24) { pcol = pn * 128 - 1024; silu = true; } else { pcol = pn * 128 - 1280; silu = true; }
      char* dstb = (char*)(p.Pm + (size_t)row0 * PMW + pcol + hc);
      unsigned lo = (unsigned)((64 * wr + fr) * PMW + 4 * fq) * 2u;
      asm volatile("" : "+v"(lo));
#pragma unroll
      for (int ai = 0; ai < 2; ++ai)
#pragma unroll
        for (int m = 0; m < 4; ++m) {
#pragma unroll
          for (int bj = 0; bj < 2; ++bj)
#pragma unroll
            for (int n = 0; n < 2; ++n) {
              f32x4 v = acc[ai][bj][m][n];
              if (silu) { v[0] = fast_silu(v[0]); v[1] = fast_silu(v[1]); v[2] = fast_silu(v[2]); v[3] = fast_silu(v[3]); }
              u32x2 pk = {pack2(v[0], v[1]), pack2(v[2], v[3])};
              *(u32x2*)(dstb + (lo + (unsigned)(((128 * ai + 16 * m) * PMW + 32 * bj + 16 * n) * 2))) = pk;
            }
          asm volatile("" ::: "memory");
        }
    } else if ((pn >= 16 && pn < 20) || pn == 29) {
      char* dstb = (char*)(pn == 29 ? p.GVt + ((size_t)b * 128 + hc) * NKEY + key0 : p.DVt + ((size_t)b * 512 + (pn - 16) * 128 + hc) * NKEY + key0);
      unsigned lo = (unsigned)((4 * fq) * NKEY + 64 * wr + fr) * 2u;
      asm volatile("" : "+v"(lo));
#pragma unroll
      for (int ai = 0; ai < 2; ++ai)
#pragma unroll
        for (int m = 0; m < 4; ++m) {
#pragma unroll
          for (int bj = 0; bj < 2; ++bj)
#pragma unroll
            for (int n = 0; n < 2; ++n)
#pragma unroll
              for (int j = 0; j < 4; ++j)
                *(bf16_t*)(dstb + (lo + (unsigned)(((32 * bj + 16 * n + j) * NKEY + 128 * ai + 16 * m) * 2))) = f2bf(acc[ai][bj][m][n][j]);
          asm volatile("" ::: "memory");
        }
    } else {
      const float* gn; bf16_t* dst; int ldd; float oscale;
      if (pn < 12) { gn = p.dqn + l * 64; dst = p.Pm + (size_t)row0 * PMW + pn * 128 + hc; ldd = PMW; oscale = LOG2E * 0.125f; }
      else if (pn < 16) { gn = p.dkn + l * 64; dst = p.DK + ((size_t)b * NKEY + key0) * 512 + (pn - 12) * 128 + hc; ldd = 512; oscale = 1.f; }
      else if (pn < 28) { gn = p.gqn + l * 64; dst = p.Pm + (size_t)row0 * PMW + pn * 128 - 1024 + hc; ldd = PMW; oscale = LOG2E * 0.125f; }
      else { gn = p.gkn + l * 64; dst = p.GK + ((size_t)b * NKEY + key0) * 128 + hc; ldd = 128; oscale = 1.f; }
      gn = opaque(gn);
      int fro = fr; asm volatile("" : "+v"(fro));
      float inv[4];
#pragma unroll
      for (int j = 0; j < 4; ++j) inv[j] = __builtin_amdgcn_exp2f((float)(4 * (fro >> 30) + 4 * fq + j) * -0.8304820237218406f);
#pragma unroll
      for (int ai = 0; ai < 2; ++ai)
#pragma unroll
        for (int m = 0; m < 4; ++m) {
          const int tok = 128 * ai + 64 * wr + 16 * m + fro;
          f32x4 y[2][2]; float ss = 0.f;
#pragma unroll
          for (int bj = 0; bj < 2; ++bj)
#pragma unroll
            for (int n = 0; n < 2; ++n) { y[bj][n] = acc[ai][bj][m][n]; ss += y[bj][n][0] * y[bj][n][0] + y[bj][n][1] * y[bj][n][1] + y[bj][n][2] * y[bj][n][2] + y[bj][n][3] * y[bj][n][3]; }
          ss += __shfl_xor(ss, 16); ss += __shfl_xor(ss, 32);
          const float rstd = __builtin_amdgcn_rsqf(ss * (1.f / 64.f) + 1e-6f) ;
#pragma unroll
          for (int bj = 0; bj < 2; ++bj)
#pragma unroll
            for (int n = 0; n < 2; ++n) {
              const f32x4 g4 = *(const f32x4*)(gn + 32 * bj + 16 * n + 4 * fq);
#pragma unroll
              for (int j = 0; j < 4; ++j) y[bj][n][j] *= rstd * g4[j];
            }
          if (!isctx) {
            const int tseq = t0 + tok;
#pragma unroll
            for (int bj = 0; bj < 2; ++bj) {
              const float pos = (float)(bj == 0 ? (tseq >> 6) : (tseq & 63));
#pragma unroll
              for (int j = 0; j < 4; ++j) {
                const float ang = pos * inv[j];
                const float cs = __cosf(ang), sn = __sinf(ang);
                const float x1 = y[bj][0][j], x2 = y[bj][1][j];
                y[bj][0][j] = x1 * cs - x2 * sn; y[bj][1][j] = x1 * sn + x2 * cs;
              }
            }
          }
          const unsigned ro = (unsigned)(tok * ldd + 4 * fq) * 2u;
#pragma unroll
          for (int bj = 0; bj < 2; ++bj)
#pragma unroll
            for (int n = 0; n < 2; ++n) {
              u32x2 pk = {pack2(y[bj][n][0] * oscale, y[bj][n][1] * oscale), pack2(y[bj][n][2] * oscale, y[bj][n][3] * oscale)};
              *(u32x2*)((char*)dst + (ro + (unsigned)((32 * bj + 16 * n) * 2))) = pk;
            }
          asm volatile("" ::: "memory");
          __builtin_amdgcn_sched_barrier(0);
        }
    }
  }
};

DI void phase2(const Params& p, int l, char* smem) {
  Sched2 S; S.tw.init(132, 17); S.h = (const char*)p.h; S.W = (const char*)(p.WinT + (size_t)l * 7424 * 1024);
  Epi2 E{p, l};
  g8::gemm_phase<true>(smem, S, E);
}

DI void softmax_step(f32x16& S, float& l0, float& l1, bf16x8 (&pf)[2]) {
#pragma unroll
  for (int e = 0; e < 16; ++e) S[e] = __builtin_amdgcn_exp2f(S[e]);
#pragma unroll
  for (int e = 0; e < 8; ++e) { l0 += S[2 * e]; l1 += S[2 * e + 1]; }
#pragma unroll
  for (int s = 0; s < 2; ++s) {
    u32x4 pk = {pack2(S[8 * s], S[8 * s + 1]), pack2(S[8 * s + 2], S[8 * s + 3]), pack2(S[8 * s + 4], S[8 * s + 5]), pack2(S[8 * s + 6], S[8 * s + 7])};
    pf[s] = __builtin_bit_cast(bf16x8, pk);
  }
}

template <int DV>
DI void attn_pass(f32x16 (&O)[DV / 32], float& lsum, const bf16x8 (&qf)[4], const bf16_t* __restrict__ Kb, int ldk, const bf16_t* __restrict__ Vt, int nkeys, char* smem) {
  constexpr int NV = DV / 32;
  const int tid = (get_tid() & 255), lane = tid & 63, r = lane & 31, h = lane >> 5;
  const int pr = (r & 19) | ((r & 4) << 1) | ((r & 8) >> 1);
  const int srow = tid >> 3, sch = tid & 7;
  const unsigned kgo = (unsigned)(srow * ldk + sch * 8) * 2u, vgo = (unsigned)(srow * NKEY + sch * 8) * 2u;
  const unsigned kstep = (unsigned)ldk * 64u;
  constexpr unsigned vstep = (unsigned)NKEY * 64u;
  const char* Kc = (const char*)Kb; const char* Vc = (const char*)Vt;
  const int soff = srow * TROW + sch * 16;
  const int nt = nkeys >> 6;
  u32x4 rk[2], rv[NV];
#pragma unroll
  for (int q = 0; q < 2; ++q) rk[q] = *(const u32x4*)(Kc + (kgo + q * kstep));
#pragma unroll
  for (int q = 0; q < NV; ++q) rv[q] = *(const u32x4*)(Vc + (vgo + q * vstep));
#pragma unroll
  for (int q = 0; q < 2; ++q) *(u32x4*)(smem + soff + q * 32 * TROW) = rk[q];
#pragma unroll
  for (int q = 0; q < NV; ++q) *(u32x4*)(smem + 64 * TROW + soff + q * 32 * TROW) = rv[q];
  if (nt > 1) {
#pragma unroll
    for (int q = 0; q < 2; ++q) rk[q] = *(const u32x4*)(Kc + (kgo + (unsigned)(2 + q) * kstep));
#pragma unroll
    for (int q = 0; q < NV; ++q) rv[q] = *(const u32x4*)(Vc + (vgo + q * vstep + 128u));
  }
  __syncthreads();
#pragma unroll
  for (int bk = 0; bk < NV; ++bk)
#pragma unroll
    for (int e = 0; e < 16; ++e) O[bk][e] = 0.f;
  float l0 = 0.f, l1 = 0.f;
  const int koff = pr * TROW + 16 * h;
  const int voff = 64 * TROW + r * TROW + 16 * h;
  f32x16 S0, S1;
  {
#pragma unroll
    for (int e = 0; e < 16; ++e) S0[e] = 0.f;
#pragma unroll
    for (int t = 0; t < 4; ++t) { const bf16x8 kf = *(const bf16x8*)(smem + koff + 32 * t); S0 = MFMA(kf, qf[t], S0); }
  }
  for (int kt = 0; kt < nt; ++kt) {
    const char* cur = smem + (kt & 1) * ABUF;
    char* nxt = smem + ((kt + 1) & 1) * ABUF;
    bf16x8 pf[2];
    {
      bf16x8 kf[4];
#pragma unroll
      for (int t = 0; t < 4; ++t) kf[t] = *(const bf16x8*)(cur + koff + 32 * TROW + 32 * t);
#pragma unroll
      for (int e = 0; e < 16; ++e) S1[e] = 0.f;
#pragma unroll
      for (int t = 0; t < 4; ++t) S1 = MFMA(kf[t], qf[t], S1);
    }
    softmax_step(S0, l0, l1, pf);
#pragma unroll
    for (int bk = 0; bk < NV; ++bk)
#pragma unroll
      for (int s = 0; s < 2; ++s) {
        const bf16x8 vf = *(const bf16x8*)(cur + voff + 32 * bk * TROW + 32 * s);
        O[bk] = MFMA(vf, pf[s], O[bk]);
      }
    bf16x8 vf1[NV][2];
#pragma unroll
    for (int bk = 0; bk < NV; ++bk)
#pragma unroll
      for (int s = 0; s < 2; ++s) vf1[bk][s] = *(const bf16x8*)(cur + voff + 32 * bk * TROW + 64 + 32 * s);
    if (kt + 1 < nt) {
#pragma unroll
      for (int q = 0; q < 2; ++q) *(u32x4*)(nxt + soff + q * 32 * TROW) = rk[q];
#pragma unroll
      for (int q = 0; q < NV; ++q) *(u32x4*)(nxt + 64 * TROW + soff + q * 32 * TROW) = rv[q];
      if (kt + 2 < nt) {
#pragma unroll
        for (int q = 0; q < 2; ++q) rk[q] = *(const u32x4*)(Kc + (kgo + (unsigned)(2 * (kt + 2) + q) * kstep));
#pragma unroll
        for (int q = 0; q < NV; ++q) rv[q] = *(const u32x4*)(Vc + (vgo + q * vstep + (unsigned)(kt + 2) * 128u));
      }
    }
    __syncthreads();
    if (kt + 1 < nt) {
      bf16x8 kf[4];
#pragma unroll
      for (int t = 0; t < 4; ++t) kf[t] = *(const bf16x8*)(nxt + koff + 32 * t);
#pragma unroll
      for (int e = 0; e < 16; ++e) S0[e] = 0.f;
#pragma unroll
      for (int t = 0; t < 4; ++t) S0 = MFMA(kf[t], qf[t], S0);
    }
    softmax_step(S1, l0, l1, pf);
#pragma unroll
    for (int bk = 0; bk < NV; ++bk)
#pragma unroll
      for (int s = 0; s < 2; ++s) O[bk] = MFMA(vf1[bk][s], pf[s], O[bk]);
  }
  lsum = l0 + l1;
  __syncthreads();
}

DI void load_q(bf16x8 (&qf)[4], const bf16_t* __restrict__ qp  , int h) {
#pragma unroll
  for (int t = 0; t < 4; ++t) qf[t] = *(const bf16x8*)(qp + 16 * t + 8 * h);
}

DI void diff_unit(const Params& p, int l, int b, int hh, int qrow0, int nkeys, int vb, char* smem) {
  f32x16 O[4]; float ls;
  float sc1 = 0.f;
#pragma unroll 1
  for (int c = 0; c < 2; ++c) {
    {
      const int tid = (get_tid() & 255), lane = tid & 63, w = tid >> 6, r = lane & 31, h = lane >> 5;
      bf16x8 qf[4];
      load_q(qf, p.Pm + (size_t)(qrow0 + 32 * w + r) * PMW + C_DQ + (2 * hh + c) * 64, h);
      attn_pass<128>(O, ls, qf, p.DK + (size_t)b * NKEY * 512 + (2 * hh + c) * 64, 512, p.DVt + ((size_t)b * 512 + hh * 128) * NKEY, nkeys, smem);
    }
    ls += __shfl_xor(ls, 32);
    if (c == 0) {
      const int tid = (get_tid() & 255);
      float* st = p.stash + (size_t)vb * 16384 + tid * 64;
      const float inv = 1.f / ls;
#pragma unroll
      for (int bk = 0; bk < 4; ++bk)
#pragma unroll
        for (int g4 = 0; g4 < 4; ++g4) {
          const f32x4 v4 = {O[bk][4 * g4] * inv, O[bk][4 * g4 + 1] * inv, O[bk][4 * g4 + 2] * inv, O[bk][4 * g4 + 3] * inv};
          *(f32x4*)(st + bk * 16 + g4 * 4) = v4;
        }
    } else sc1 = -p.consts[l * 4 + 0] / ls;
  }
  const int tid = (get_tid() & 255), lane = tid & 63, w = tid >> 6, r = lane & 31, h = lane >> 5;
  const float* st = p.stash + (size_t)vb * 16384 + tid * 64;
  float ss = 0.f;
#pragma unroll
  for (int bk = 0; bk < 4; ++bk)
#pragma unroll
    for (int g4 = 0; g4 < 4; ++g4) {
      const f32x4 s4 = *(const f32x4*)(st + bk * 16 + g4 * 4);
#pragma unroll
      for (int e = 0; e < 4; ++e) { const float v = s4[e] + sc1 * O[bk][4 * g4 + e]; O[bk][4 * g4 + e] = v; ss += v * v; }
    }
  ss += __shfl_xor(ss, 32);
  const float rs = __builtin_amdgcn_rsqf(ss * (1.f / 128.f) + 1e-6f) * (1.f - p.consts[l * 4 + 3]);
  const float* sub = opaque(p.dsub + l * 128);
  bf16_t* zrow = p.Pm + (size_t)(qrow0 + 32 * w + r) * PMW + C_ZD + hh * 128;
#pragma unroll
  for (int bk = 0; bk < 4; ++bk)
#pragma unroll
    for (int g4 = 0; g4 < 4; ++g4) {
      const int dv0 = 32 * bk + 8 * g4 + 4 * h;
      const u32x2 z = *(const u32x2*)(zrow + dv0);
      const f32x4 sg = *(const f32x4*)(sub + dv0);
      const float o0 = O[bk][4 * g4] * rs * sg[0] * bflo(z[0]), o1 = O[bk][4 * g4 + 1] * rs * sg[1] * bfhi(z[0]);
      const float o2 = O[bk][4 * g4 + 2] * rs * sg[2] * bflo(z[1]), o3 = O[bk][4 * g4 + 3] * rs * sg[3] * bfhi(z[1]);
      u32x2 pk = {pack2(o0, o1), pack2(o2, o3)};
      *(u32x2*)(zrow + dv0) = pk;
      asm volatile("" ::: "memory");
    }
}

DI void gqa_unit(const Params& p, int l, int b, int qh, int qrow0, int nkeys, char* smem) {
  const int tid = (get_tid() & 255), lane = tid & 63, w = tid >> 6, r = lane & 31, h = lane >> 5;
  const int qrow = qrow0 + 32 * w + r, kvh = qh >> 2;
  f32x16 O[2]; float ls; bf16x8 qf[4];
  load_q(qf, p.Pm + (size_t)qrow * PMW + C_GQ + qh * 64, h);
  attn_pass<64>(O, ls, qf, p.GK + (size_t)b * NKEY * 128 + kvh * 64, 128, p.GVt + ((size_t)b * 128 + kvh * 64) * NKEY, nkeys, smem);
  ls += __shfl_xor(ls, 32);
  const float inv = 1.f / ls;
  bf16_t* zrow = p.Pm + (size_t)qrow * PMW + C_ZG + qh * 64;
#pragma unroll
  for (int bk = 0; bk < 2; ++bk)
#pragma unroll
    for (int g4 = 0; g4 < 4; ++g4) {
      const int dv0 = 32 * bk + 8 * g4 + 4 * h;
      const u32x2 z = *(const u32x2*)(zrow + dv0);
      const float o0 = O[bk][4 * g4] * inv * bflo(z[0]), o1 = O[bk][4 * g4 + 1] * inv * bfhi(z[0]);
      const float o2 = O[bk][4 * g4 + 2] * inv * bflo(z[1]), o3 = O[bk][4 * g4 + 3] * inv * bfhi(z[1]);
      u32x2 pk = {pack2(o0, o1), pack2(o2, o3)};
      *(u32x2*)(zrow + dv0) = pk;
    }
}

DI void pool_unit(const Params& p, int l, int mt, int g, char* smem) {
  const int tid = (get_tid() & 255), lane = tid & 63, w = tid >> 6, wm = w >> 1, wn = w & 1, r = lane & 31, h = lane >> 5;
  const int row0 = mt * 128;
  int seq0, n, t0;
  if (mt < 256) { seq0 = (mt >> 6) * 8192; n = 8192; t0 = (mt & 63) * 128; }
  else { const int c = mt - 256; seq0 = NLAT + (c >> 1) * 256; n = 256; t0 = (c & 1) * 128; }
  const int wnd = 2 << g, left = wnd >> 1, right = wnd - 1 - left;
#pragma unroll 1
  for (int q = 0; q < 8; ++q) {
    const int idx = tid + 256 * q, tok = idx >> 4, ch = idx & 15;
    const int t = t0 + tok;
    const int lo = t - left < 0 ? 0 : t - left, hi = t + right + 1 > n ? n : t + right + 1;
    const bf16_t* up = p.Pm + (size_t)seq0 * PMW + C_U + g * 128 + ch * 8;
    float s[8] = {0.f, 0.f, 0.f, 0.f, 0.f, 0.f, 0.f, 0.f};
    for (int tt = lo; tt < hi; ++tt) {
      const u32x4 v = *(const u32x4*)(up + (size_t)tt * PMW);
#pragma unroll
      for (int e = 0; e < 4; ++e) { s[2 * e] += bflo(v[e]); s[2 * e + 1] += bfhi(v[e]); }
    }
    const u32x4 sv = *(const u32x4*)(up + (size_t)t * PMW);
    const float ic = 1.f / (float)(hi - lo);
    u32x4 o;
#pragma unroll
    for (int e = 0; e < 4; ++e) o[e] = pack2(s[2 * e] * ic - bflo(sv[e]), s[2 * e + 1] * ic - bfhi(sv[e]));
    *(u32x4*)(smem + (ch >> 3) * (2 * TILEB) + tok * TROW + (ch & 7) * 16) = o;
    const u32x4 wv = *(const u32x4*)(p.WpT + (size_t)(l * 4 + g) * 128 * 128 + (size_t)tok * 128 + ch * 8);
    *(u32x4*)(smem + (ch >> 3) * (2 * TILEB) + TILEB + tok * TROW + (ch & 7) * 16) = wv;
  }
  __syncthreads();
  f32x16 acc[2][2]; zero_acc22(acc);
  const int aoff = (64 * wm + r) * TROW + 16 * h;
  const int boff = TILEB + (64 * wn + r) * TROW + 16 * h;
#pragma unroll
  for (int kt = 0; kt < 2; ++kt) {
    const char* cur = smem + kt * (2 * TILEB);
#pragma unroll
    for (int t = 0; t < 4; ++t) {
      const bf16x8 a0 = *(const bf16x8*)(cur + aoff + 32 * t);
      const bf16x8 a1 = *(const bf16x8*)(cur + aoff + 32 * TROW + 32 * t);
      const bf16x8 b0 = *(const bf16x8*)(cur + boff + 32 * t);
      const bf16x8 b1 = *(const bf16x8*)(cur + boff + 32 * TROW + 32 * t);
      acc[0][0] = MFMA(a0, b0, acc[0][0]); acc[0][1] = MFMA(a0, b1, acc[0][1]);
      acc[1][0] = MFMA(a1, b0, acc[1][0]); acc[1][1] = MFMA(a1, b1, acc[1][1]);
    }
  }
  __syncthreads();
  bf16_t* zp = p.Pm + (size_t)row0 * PMW + C_ZP + g * 128;
  const float* ps = p.pool_scale + l * 512 + g * 128;
#pragma unroll
  for (int i = 0; i < 2; ++i)
#pragma unroll
    for (int j = 0; j < 2; ++j) {
      const int nn = 64 * wn + 32 * j + r;
      const float sc = ps[nn];
#pragma unroll
      for (int e = 0; e < 16; ++e) {
        bf16_t* a = zp + (size_t)(64 * wm + 32 * i + crow(e, h)) * PMW + nn;
        *a = f2bf(acc[i][j][e] * sc * bf2f(*a));
      }
    }
}

DI void phase3(const Params& p, int l, char* smem_all) {
  const int grp = get_tid() >> 8;
  char* smem = smem_all + grp * GRP_SMEM;
  const int nCtxD = l == 0 ? 32 : 0, nCtxG = l == 0 ? 64 : 0, nPool = (l == 0 ? 264 : 256) * 4;
  const int e1 = 1024, e2 = e1 + 2048, e3 = e2 + nCtxD, e4 = e3 + nCtxG, e5 = e4 + nPool;
  for (int k = blockIdx.x; 16 * (k >> 3) < e5; k += gridDim.x) {
    const int i = (k & 7) + 16 * (k >> 3) + 8 * grp;
    if (i < e1 || (i >= e2 && i < e3)) {
      int b, hh, qrow0, nk;
      if (i < e1) { const int x = i & 7, j = i >> 3, bh = x + 8 * (j >> 6), qb = j & 63; b = bh >> 2; hh = bh & 3; qrow0 = b * 8192 + qb * 128; nk = NKEY; }
      else { const int i3 = i - e2; b = i3 >> 3; hh = (i3 >> 1) & 3; qrow0 = NLAT + b * 256 + (i3 & 1) * 128; nk = 256; }
      diff_unit(p, l, b, hh, qrow0, nk, blockIdx.x * 2 + grp, smem);
    } else if (i < e4) {
      int b, qh, qrow0, nk;
      if (i < e2) { const int i2 = i - e1, x = i2 & 7, j = i2 >> 3, qb = j & 63; b = x >> 1; qh = (x & 1) * 4 + (j >> 6); qrow0 = b * 8192 + qb * 128; nk = NKEY; }
      else { const int i4 = i - e3; b = i4 >> 4; qh = (i4 >> 1) & 7; qrow0 = NLAT + b * 256 + (i4 & 1) * 128; nk = 256; }
      gqa_unit(p, l, b, qh, qrow0, nk, smem);
    } else {
      const int i5 = i - e4;
      pool_unit(p, l, i5 >> 2, i5 & 3, smem);
    }
  }
}

struct Sched4 {
  TileWalk tw; const char* h; const char* W; const char* Pm; const char* Wb;
  DI bool next(int i, g8::Unit& u) const {
    const int ti = i / 6, s = i - 6 * ti, i3 = s >> 1;
    int mt, pn2;
    if (!tw.at(ti, mt, pn2)) return false;
    if ((s & 1) == 0) {
      u.A = h + (size_t)mt * 256 * 2048; u.lda2 = 2048; u.B = W + (size_t)(4352 + i3 * 1024 + pn2 * 256) * 2048; u.ldb2 = 2048; u.nt = 16; u.kind = 0;
    } else {
      const int zc = i3 == 0 ? C_ZP : (i3 == 1 ? C_ZD : C_ZG);
      u.A = Pm + ((size_t)mt * 256 * PMW + zc) * 2; u.lda2 = PMW * 2; u.B = Wb + (size_t)(i3 * 1024 + pn2 * 256) * 1024; u.ldb2 = 1024; u.nt = 8; u.kind = 1;
    }
    u.i0 = mt; u.i1 = pn2; u.i2 = i3;
    return true;
  }
};
struct Epi4 {
  const Params& p; unsigned* gs;
  DI void operator()(const f32x4 (&acc)[2][2][4][2], const g8::Unit& u, int wr, int wc, int fr, int fq) const {
    if (u.kind == 0) {
#pragma unroll
      for (int ai = 0; ai < 2; ++ai)
#pragma unroll
        for (int bj = 0; bj < 2; ++bj) {
#pragma unroll
          for (int m = 0; m < 4; ++m) {
            const f32x4 a0 = acc[ai][bj][m][0], a1 = acc[ai][bj][m][1];
            u32x4 g = {pack2(fast_sigmoid(a0[0]), fast_sigmoid(a0[1])), pack2(fast_sigmoid(a0[2]), fast_sigmoid(a0[3])),
                       pack2(fast_sigmoid(a1[0]), fast_sigmoid(a1[1])), pack2(fast_sigmoid(a1[2]), fast_sigmoid(a1[3]))};
            *(u32x4*)(gs + ((ai * 2 + bj) * 4 + m) * 4) = g;
          }
          asm volatile("" ::: "memory");
        }
    } else {
      const int i3 = u.i2;
      bf16_t* dst = p.y + (size_t)(u.i0 * 256 + 64 * wr + fr) * 1024 + u.i1 * 256 + 32 * wc + 4 * fq;
#pragma unroll
      for (int ai = 0; ai < 2; ++ai)
#pragma unroll
        for (int bj = 0; bj < 2; ++bj) {
#pragma unroll
          for (int m = 0; m < 4; ++m) {
            const u32x4 g = *(const u32x4*)(gs + ((ai * 2 + bj) * 4 + m) * 4);
            u32x4 y = {0u, 0u, 0u, 0u};
            if (i3 > 0) y = *(const u32x4*)(gs + 64 + ((ai * 2 + bj) * 4 + m) * 4);
            const f32x4 a0 = acc[ai][bj][m][0], a1 = acc[ai][bj][m][1];
            u32x4 o = {pack2(bflo(y[0]) + bflo(g[0]) * a0[0], bfhi(y[0]) + bfhi(g[0]) * a0[1]), pack2(bflo(y[1]) + bflo(g[1]) * a0[2], bfhi(y[1]) + bfhi(g[1]) * a0[3]),
                       pack2(bflo(y[2]) + bflo(g[2]) * a1[0], bfhi(y[2]) + bfhi(g[2]) * a1[1]), pack2(bflo(y[3]) + bflo(g[3]) * a1[2], bfhi(y[3]) + bfhi(g[3]) * a1[3])};
            if (i3 < 2) *(u32x4*)(gs + 64 + ((ai * 2 + bj) * 4 + m) * 4) = o;
            else {
              bf16_t* d = dst + (size_t)(128 * ai + 16 * m) * 1024 + 128 * bj;
              u32x2 o0 = {o[0], o[1]}, o1 = {o[2], o[3]};
              *(u32x2*)(d) = o0; *(u32x2*)(d + 16) = o1;
            }
          }
          asm volatile("" ::: "memory");
        }
    }
  }
};

DI void phase4(const Params& p, int l, char* smem) {
  Sched4 S; S.tw.init(l == 0 ? 132 : 128, 4); S.h = (const char*)p.h; S.W = (const char*)(p.WinT + (size_t)l * 7424 * 1024);
  S.Pm = (const char*)p.Pm; S.Wb = (const char*)(p.WbT + (size_t)l * 3 * 1024 * 512);
  Epi4 E{p, p.gsc + ((size_t)blockIdx.x * 512 + get_tid()) * 128};
  g8::gemm_phase<false>(smem, S, E);
}

struct Sched5 {
  TileWalk tw; const char* y; const char* Wo;
  DI bool next(int i, g8::Unit& u) const {
    int mt, pn2;
    if (!tw.at(i, mt, pn2)) return false;
    u.A = y + (size_t)mt * 256 * 2048; u.lda2 = 2048; u.B = Wo + (size_t)pn2 * 256 * 2048; u.ldb2 = 2048; u.nt = 16;
    u.kind = 0; u.i0 = mt; u.i1 = pn2; u.i2 = 0;
    return true;
  }
};
struct Epi5 {
  const Params& p; int l;
  DI void operator()(const f32x4 (&acc)[2][2][4][2], const g8::Unit& u, int wr, int wc, int fr, int fq) const {
    const int mt = u.i0, row0 = mt * 256, col0 = u.i1 * 256 + 32 * wc + 4 * fq;
    const bool isctx = mt >= 128;
    const float* xlat = l == 0 ? p.x : p.out;
    const float* src = (isctx ? p.ctx + (size_t)(row0 - NLAT) * 1024 : xlat + (size_t)row0 * 1024) + (size_t)(64 * wr + fr) * 1024 + col0;
    float* dst = (isctx ? p.xc1 + (size_t)(row0 - NLAT) * 1024 : p.out + (size_t)row0 * 1024) + (size_t)(64 * wr + fr) * 1024 + col0;
    const float* gate = p.mod + (l * 5 + (isctx ? 4 : (mt >> 5))) * 3072 + 2048 + col0;
    f32x4 gt[2][2];
#pragma unroll
    for (int bj = 0; bj < 2; ++bj)
#pragma unroll
      for (int n = 0; n < 2; ++n) gt[bj][n] = *(const f32x4*)(gate + 128 * bj + 16 * n);
#pragma unroll
    for (int ai = 0; ai < 2; ++ai)
#pragma unroll
      for (int m = 0; m < 4; ++m) {
#pragma unroll
        for (int bj = 0; bj < 2; ++bj)
#pragma unroll
          for (int n = 0; n < 2; ++n) {
            const size_t o = (size_t)(128 * ai + 16 * m) * 1024 + 128 * bj + 16 * n;
            const f32x4 xv = *(const f32x4*)(src + o);
            *(f32x4*)(dst + o) = xv + gt[bj][n] * acc[ai][bj][m][n];
          }
        asm volatile("" ::: "memory");
      }
  }
};

DI void phase5(const Params& p, int l, char* smem) {
  Sched5 S; S.tw.init(l == 0 ? 132 : 128, 4); S.y = (const char*)p.y; S.Wo = (const char*)(p.WoT + (size_t)l * 1024 * 1024);
  Epi5 E{p, l};
  g8::gemm_phase<false>(smem, S, E);
}

DI void grid_barrier(unsigned* ctr, unsigned& target) {
  __syncthreads();
  if (threadIdx.x == 0) {
    target += gridDim.x;
    __builtin_amdgcn_fence(__ATOMIC_RELEASE, "agent");
    asm volatile("s_waitcnt vmcnt(0)" ::: "memory");
    __hip_atomic_fetch_add(ctr, 1u, __ATOMIC_RELAXED, __HIP_MEMORY_SCOPE_AGENT);
    while (__hip_atomic_load(ctr, __ATOMIC_RELAXED, __HIP_MEMORY_SCOPE_AGENT) < target) __builtin_amdgcn_s_sleep(2);
    __builtin_amdgcn_fence(__ATOMIC_ACQUIRE, "agent");
    asm volatile("s_waitcnt vmcnt(0)" ::: "memory");
  }
  __syncthreads();
}

__global__ void __launch_bounds__(512, 2) fwd_kernel(Params p, int ph0, int ph1) {
  __shared__ __attribute__((aligned(16))) char smem[SMEM_BYTES];
  cg::grid_group grid = cg::this_grid();
  unsigned bar_target = 0;
  for (int ph = ph0; ph < ph1; ++ph) {
#ifndef PHMASK
#define PHMASK 63
#endif
    if (ph == 0) { if (PHMASK & 1) phase0(p, smem); }
    else {
      const int l = (ph - 1) / 5, s = (ph - 1) % 5;
      if (s == 0) { if (PHMASK & 2) phase1(p, l); }
      else if (s == 1) { if (PHMASK & 4) phase2(p, l, smem); }
      else if (s == 2) { if (PHMASK & 8) phase3(p, l, smem); }
      else if (s == 3) { if (PHMASK & 16) phase4(p, l, smem); }
      else { if (PHMASK & 32) phase5(p, l, smem); }
    }
    if (ph + 1 < ph1) {
      if (ph1 > 64) grid.sync();
      else grid_barrier(p.bar, bar_target);
    }
  }
}

extern "C" void kernel_launch(void* const* d_in, const int* in_sizes, int n_in, void* d_out, int out_size,
                              void* d_ws, size_t ws_size, hipStream_t stream) {
  static int grid_blocks = 0;
  if (!grid_blocks) {
    int dev = 0, cus = 0, per_cu = 0;
    (void)hipGetDevice(&dev);
    (void)hipDeviceGetAttribute(&cus, hipDeviceAttributeMultiprocessorCount, dev);
    (void)hipOccupancyMaxActiveBlocksPerMultiprocessor(&per_cu, fwd_kernel, 512, 0);
    if (per_cu > 1) per_cu = 1;
    if (per_cu < 1) per_cu = 1;
    grid_blocks = (cus * per_cu) & ~7;
  }
  Params p{};
  p.x = (const float*)d_in[0]; p.c = (const float*)d_in[1]; p.ctx = (const float*)d_in[2]; p.c_ctx = (const float*)d_in[3];
  p.ada_w = (const float*)d_in[4]; p.ada_b = (const float*)d_in[5]; p.norm_g = (const float*)d_in[6]; p.w_in = (const float*)d_in[7];
  p.pool_w = (const float*)d_in[8]; p.pool_scale = (const float*)d_in[9]; p.dqn = (const float*)d_in[10]; p.dkn = (const float*)d_in[11];
  p.dlam = (const float*)d_in[12]; p.dsub = (const float*)d_in[13]; p.gqn = (const float*)d_in[14]; p.gkn = (const float*)d_in[15];
  p.w_branch = (const float*)d_in[16]; p.w_out = (const float*)d_in[17];
  p.out = (float*)d_out;
  char* ws = (char*)d_ws; size_t off = 0;
  auto take = [&](size_t bytes) { char* q = ws + off; off += (bytes + 255) & ~(size_t)255; return q; };
  p.mod = (float*)take(2 * 5 * 3072 * 4);
  p.consts = (float*)take(256);
  p.bar = (unsigned*)take(256);
  p.WinT = (bf16_t*)take((size_t)2 * 7424 * 1024 * 2);
  p.WbT = (bf16_t*)take((size_t)2 * 3 * 1024 * 512 * 2);
  p.WoT = (bf16_t*)take((size_t)2 * 1024 * 1024 * 2);
  p.WpT = (bf16_t*)take((size_t)2 * 4 * 128 * 128 * 2);
  p.h = (bf16_t*)take((size_t)NTOK * 1024 * 2);
  p.y = (bf16_t*)take((size_t)NTOK * 1024 * 2);
  p.Pm = (bf16_t*)take((size_t)NTOK * PMW * 2);
  p.DK = (bf16_t*)take((size_t)4 * NKEY * 512 * 2);
  p.DVt = (bf16_t*)take((size_t)4 * NKEY * 512 * 2);
  p.GK = (bf16_t*)take((size_t)4 * NKEY * 128 * 2);
  p.GVt = (bf16_t*)take((size_t)4 * NKEY * 128 * 2);
  p.xc1 = (float*)take((size_t)1024 * 1024 * 4);
  p.gsc = (unsigned*)p.DK;
  p.stash = (float*)p.y;
  if (off > ws_size) { fprintf(stderr, "workspace too small: need %zu have %zu\n", off, ws_size); return; }
#if MULTI_LAUNCH
  for (int ph = 0; ph < 11; ++ph) hipLaunchKernelGGL(fwd_kernel, dim3(grid_blocks), dim3(512), 0, stream, p, ph, ph + 1);
#else
  (void)hipMemsetAsync(p.bar, 0, 256, stream);
  int ph0 = 0, ph1 = 11;
  void* args[] = {&p, &ph0, &ph1};
  hipError_t e = hipLaunchCooperativeKernel((void*)fwd_kernel, dim3(grid_blocks), dim3(512), args, 0, stream);
  if (e != hipSuccess) fprintf(stderr, "cooperative launch failed: %s (grid %d)\n", hipGetErrorString(e), grid_blocks);
#endif
}
```

```cpp
#include <hip/hip_runtime.h>
#include <hip/hip_cooperative_groups.h>
#include <cstdio>
namespace cg = cooperative_groups;

typedef unsigned short bf16_t;
typedef short bf16x8 __attribute__((ext_vector_type(8)));
typedef float f32x16 __attribute__((ext_vector_type(16)));
typedef float f32x4 __attribute__((ext_vector_type(4)));
typedef float f32x2 __attribute__((ext_vector_type(2)));
typedef unsigned u32x4 __attribute__((ext_vector_type(4)));
typedef unsigned u32x2 __attribute__((ext_vector_type(2)));
typedef __bf16 bf16v2 __attribute__((ext_vector_type(2)));

#define DI __device__ __forceinline__
#define MFMA(a, b, c) __builtin_amdgcn_mfma_f32_32x32x16_bf16((a), (b), (c), 0, 0, 0)

#ifndef MULTI_LAUNCH
#define MULTI_LAUNCH 0
#endif

constexpr int NLAT = 32768, NTOK = 33792, NKEY = 8448;
constexpr int PMW = 3072;
constexpr int C_U = 0, C_ZP = 512, C_DQ = 1024, C_ZD = 1536, C_GQ = 2048, C_ZG = 2560;
constexpr int TROW = 144;
constexpr int TILEB = 128 * TROW;
constexpr int TILE256 = 256 * TROW;
constexpr int STAGE8 = 2 * TILE256;
constexpr int SMEM_BYTES = 2 * STAGE8;
constexpr int GRP_SMEM = STAGE8;
constexpr int ABUF = 64 * TROW + 128 * TROW;
constexpr float LOG2E = 1.4426950408889634f;

struct Params {
  const float *x, *c, *ctx, *c_ctx, *ada_w, *ada_b, *norm_g, *w_in, *pool_w, *pool_scale, *dqn, *dkn, *dlam, *dsub, *gqn, *gkn, *w_branch, *w_out;
  float* out;
  float* mod;
  float* consts;
  bf16_t *WinT, *WbT, *WoT, *WpT, *h, *y, *Pm, *DK, *DVt, *GK, *GVt;
  float* xc1;
  float* stash;
  unsigned* gsc;
  unsigned* bar;
};

DI unsigned pack2(float a, float b) { f32x2 v = {a, b}; bf16v2 r = __builtin_convertvector(v, bf16v2); return __builtin_bit_cast(unsigned, r); }
DI bf16_t f2bf(float a) { return (bf16_t)(pack2(a, a) & 0xffffu); }
DI float bf2f(unsigned v) { return __uint_as_float(v << 16); }
DI float bflo(unsigned v) { return __uint_as_float(v << 16); }
DI float bfhi(unsigned v) { return __uint_as_float(v & 0xffff0000u); }
DI float fast_sigmoid(float v) { return __builtin_amdgcn_rcpf(1.f + __expf(-v)); }
DI float fast_silu(float v) { return v * fast_sigmoid(v); }
DI float wave_sum(float v) {
#pragma unroll
  for (int o = 32; o >= 1; o >>= 1) v += __shfl_xor(v, o);
  return v;
}
DI float wave_max(float v) {
#pragma unroll
  for (int o = 32; o >= 1; o >>= 1) v = fmaxf(v, __shfl_xor(v, o));
  return v;
}
DI int get_tid() { int t = threadIdx.x; asm volatile("" : "+v"(t)); return t; }
template <typename T> DI const T* opaque(const T* q) { asm volatile("" : "+s"(q)); return q; }
DI int get_bid() { int b = blockIdx.x; asm volatile("" : "+s"(b)); return b; }
DI int crow(int reg, int h) { return (reg & 3) + 8 * (reg >> 2) + 4 * h; }

namespace g8 {
#define G8_LAS __attribute__((address_space(3)))
constexpr int BK = 64, HALF = 128, HTB = HALF * BK * 2, STAGE_BYTES = 8 * HTB;
DI int lds_byte(int r, int c) { const int st = (r >> 4) * 2 + (c >> 5), rr = r & 15, cc = c & 31, ob = rr * 64 + cc * 2; return st * 1024 + (ob ^ (((ob >> 9) & 1) << 5)); }
DI void stage_rc(int b, int& R, int& C) { const int st = b / 1024, sb = b % 1024, swz = sb ^ (((sb >> 9) & 1) << 5); R = (st >> 1) * 16 + swz / 64; C = (st & 1) * 32 + (swz % 64) / 2; }

struct Unit {
  const char* A; const char* B;
  int lda2, ldb2;
  int nt;
  int kind, i0, i1, i2;
};

template <bool SIGMA, class Sched, class Epi>
DI void gemm_phase(char* smem, const Sched& S, const Epi& E) {
  G8_LAS unsigned char* lds = (G8_LAS unsigned char*)smem;
  const int tid = get_tid(), wid = __builtin_amdgcn_readfirstlane(tid >> 6), lane = tid & 63, wr = wid >> 2, wc = wid & 3, fr = lane & 15, fq = lane >> 4;
  int Rn[2], Rb[2], C2[2];
#pragma unroll
  for (int i = 0; i < 2; ++i) { int R, C; stage_rc(tid * 16 + i * 8192, R, C); Rn[i] = R; Rb[i] = SIGMA ? 64 * (R >> 5) + (R & 31) : R; C2[i] = C * 2; }
  const unsigned ldsw = (unsigned)wid * 1024u;
  const int aoff = lds_byte(wr * 64 + fr, fq * 8), boff = lds_byte(wc * 32 + fr, fq * 8);
#define G8_SA(b, h) (((b) * 2 + (h)) * HTB)
#define G8_SB(b, h) ((4 + (b) * 2 + (h)) * HTB)
#define G8_STAGE(bufoff, gbase, RR, ld2) do { \
    __builtin_amdgcn_global_load_lds((const unsigned*)((const char*)(gbase) + (unsigned)((RR)[0] * (ld2) + C2[0])), (G8_LAS unsigned*)(lds + (bufoff) + ldsw), 16, 0, 0); \
    __builtin_amdgcn_global_load_lds((const unsigned*)((const char*)(gbase) + (unsigned)((RR)[1] * (ld2) + C2[1])), (G8_LAS unsigned*)(lds + (bufoff) + ldsw + 8192), 16, 0, 0); } while (0)
#define G8_LDA(dst, b, h) do { _Pragma("unroll") for (int m = 0; m < 4; ++m) _Pragma("unroll") for (int k = 0; k < 2; ++k) dst[m][k] = *(const G8_LAS bf16x8*)(lds + G8_SA(b, h) + aoff + m * 2048 + k * 1024); } while (0)
#define G8_LDB(dst, b, h) do { _Pragma("unroll") for (int n = 0; n < 2; ++n) _Pragma("unroll") for (int k = 0; k < 2; ++k) dst[n][k] = *(const G8_LAS bf16x8*)(lds + G8_SB(b, h) + boff + n * 2048 + k * 1024); } while (0)
#define G8_MMA(ai, bj, At, Bt) do { __builtin_amdgcn_s_setprio(1); _Pragma("unroll") for (int m = 0; m < 4; ++m) _Pragma("unroll") for (int n = 0; n < 2; ++n) _Pragma("unroll") for (int k = 0; k < 2; ++k) \
    acc[ai][bj][m][n] = __builtin_amdgcn_mfma_f32_16x16x32_bf16(Bt[n][k], At[m][k], acc[ai][bj][m][n], 0, 0, 0); __builtin_amdgcn_s_setprio(0); } while (0)
#define G8_WAIT_V(n) asm volatile("s_waitcnt vmcnt(" #n ")" ::: "memory")
#define G8_WAIT_L(n) asm volatile("s_waitcnt lgkmcnt(" #n ")" ::: "memory")
#define G8_BAR __builtin_amdgcn_s_barrier()
#define G8_SCHED __builtin_amdgcn_sched_barrier(0)
  Unit cur, nxt; int ui = 0;
  if (!S.next(0, cur)) return;
  f32x4 acc[2][2][4][2];
#pragma unroll
  for (int a = 0; a < 2; ++a)
#pragma unroll
    for (int b = 0; b < 2; ++b)
#pragma unroll
      for (int m = 0; m < 4; ++m)
#pragma unroll
        for (int n = 0; n < 2; ++n) acc[a][b][m][n] = (f32x4){0.f, 0.f, 0.f, 0.f};
  bf16x8 At[4][2], B0[2][2], B1[2][2];
  int lA = cur.lda2, lB = cur.ldb2;
  unsigned hA = (unsigned)(HALF * lA), hB = (unsigned)((SIGMA ? 32 : HALF) * lB);
  const size_t kstep = (size_t)(BK * 2);
  const char* cA = cur.A; const char* cB = cur.B;
  G8_STAGE(G8_SB(0, 0), cB, Rb, lB); G8_STAGE(G8_SA(0, 0), cA, Rn, lA); G8_STAGE(G8_SB(0, 1), cB + hB, Rb, lB); G8_STAGE(G8_SA(0, 1), cA + hA, Rn, lA);
  if (wr == 1) G8_BAR;
  G8_WAIT_V(4); G8_BAR;
  G8_STAGE(G8_SB(1, 0), cB + kstep, Rb, lB); G8_STAGE(G8_SA(1, 0), cA + kstep, Rn, lA); G8_STAGE(G8_SB(1, 1), cB + hB + kstep, Rb, lB);
  G8_WAIT_V(6); G8_BAR;
  for (;;) {
    const bool has_next = S.next(ui + 1, nxt);
    const char* nA = has_next ? nxt.A : cA; const char* nB = has_next ? nxt.B : cB;
    const int nlA = has_next ? nxt.lda2 : lA, nlB = has_next ? nxt.ldb2 : lB;
    const unsigned nhA = (unsigned)(HALF * nlA), nhB = (unsigned)((SIGMA ? 32 : HALF) * nlB);
    const int nt = cur.nt;
    for (int t = 0; t < nt; t += 2) {
      const bool last = (t == nt - 2);
      const char* a1 = cA + (size_t)(t + 1) * kstep;
      const char* a2 = last ? nA : cA + (size_t)(t + 2) * kstep; const char* b2 = last ? nB : cB + (size_t)(t + 2) * kstep;
      const char* a3 = a2 + kstep; const char* b3 = b2 + kstep;
      const int xlA = last ? nlA : lA, xlB = last ? nlB : lB;
      const unsigned xhA = last ? nhA : hA, xhB = last ? nhB : hB;
      G8_LDB(B0, 0, 0); G8_SCHED; G8_LDA(At, 0, 0); G8_STAGE(G8_SA(1, 1), a1 + hA, Rn, lA);
      G8_WAIT_L(8); G8_BAR; G8_WAIT_L(0); G8_MMA(0, 0, At, B0); G8_BAR; G8_SCHED;
      G8_LDB(B1, 0, 1); G8_STAGE(G8_SB(0, 0), b2, Rb, xlB);
      G8_BAR; G8_WAIT_L(0); G8_MMA(0, 1, At, B1); G8_BAR;
      G8_LDA(At, 0, 1); G8_STAGE(G8_SA(0, 0), a2, Rn, xlA);
      G8_BAR; G8_WAIT_L(0); G8_MMA(1, 0, At, B0); G8_BAR; G8_SCHED;
      G8_STAGE(G8_SB(0, 1), b2 + xhB, Rb, xlB);
      G8_WAIT_V(6); G8_BAR; G8_MMA(1, 1, At, B1); G8_BAR;
      G8_LDB(B0, 1, 0); G8_SCHED; G8_LDA(At, 1, 0); G8_STAGE(G8_SA(0, 1), a2 + xhA, Rn, xlA);
      G8_WAIT_L(8); G8_BAR; G8_WAIT_L(0); G8_MMA(0, 0, At, B0); G8_BAR; G8_SCHED;
      G8_LDB(B1, 1, 1); G8_STAGE(G8_SB(1, 0), b3, Rb, xlB);
      G8_BAR; G8_WAIT_L(0); G8_MMA(0, 1, At, B1); G8_BAR;
      G8_LDA(At, 1, 1); G8_STAGE(G8_SA(1, 0), a3, Rn, xlA);
      G8_BAR; G8_WAIT_L(0); G8_MMA(1, 0, At, B0); G8_BAR; G8_SCHED;
      G8_STAGE(G8_SB(1, 1), b3 + xhB, Rb, xlB);
      G8_WAIT_V(6); G8_BAR; G8_MMA(1, 1, At, B1); G8_BAR;
    }
    E(acc, cur, wr, wc, fr, fq);
    if (!has_next) break;
#pragma unroll
    for (int a = 0; a < 2; ++a)
#pragma unroll
      for (int b = 0; b < 2; ++b)
#pragma unroll
        for (int m = 0; m < 4; ++m)
#pragma unroll
          for (int n = 0; n < 2; ++n) acc[a][b][m][n] = (f32x4){0.f, 0.f, 0.f, 0.f};
    cur = nxt; cA = nA; cB = nB; lA = nlA; lB = nlB; hA = nhA; hB = nhB; ++ui;
  }
  G8_WAIT_V(0);
  if (wr == 0) G8_BAR;
  G8_BAR;
#undef G8_SA
#undef G8_SB
#undef G8_STAGE
#undef G8_LDA
#undef G8_LDB
#undef G8_MMA
#undef G8_WAIT_V
#undef G8_WAIT_L
#undef G8_BAR
#undef G8_SCHED
}
}

DI void zero_acc22(f32x16 (&acc)[2][2]) {
#pragma unroll
  for (int i = 0; i < 2; ++i)
#pragma unroll
    for (int j = 0; j < 2; ++j)
#pragma unroll
      for (int e = 0; e < 16; ++e) acc[i][j][e] = 0.f;
}

struct TileWalk {
  int MP, pwf, wlast, nfull, npart, extra, NPf, x, lb, nbx;
  DI void init(int MT, int NT) {
    const int bid = get_bid(); x = bid & 7; lb = bid >> 3; nbx = gridDim.x >> 3;
    MP = MT >> 2;
    if (NT <= 8) { pwf = NT; NPf = 1; wlast = 0; nfull = MP; npart = 0; }
    else { pwf = 8; NPf = NT >> 3; wlast = NT - 8 * NPf; nfull = NPf * MP; npart = wlast ? MP : 0; }
    extra = nfull & 7;
  }
  DI bool at(int it, int& m, int& n) const {
    const int j = lb + it * nbx;
    const int kf = x < nfull ? (nfull - x + 7) >> 3 : 0, tf = 4 * pwf;
    if (j < kf * tf) {
      const int k = j / tf, q = j % tf, id = x + 8 * k, np = id / MP, mp = id % MP;
      m = mp * 4 + (q & 3); n = np * 8 + (q >> 2);
    } else {
      if (npart == 0 || x < extra) return false;
      const int j2 = j - kf * tf, tp = 4 * wlast, pj = (x - extra) + (8 - extra) * (j2 / tp), q = j2 % tp;
      if (pj >= npart) return false;
      m = pj * 4 + (q & 3); n = NPf * 8 + (q >> 2);
    }
    return true;
  }
};

struct TrDesc { const float* src; bf16_t* dst; int N, K; };
DI TrDesc tr_desc(const Params& p, int u) {
  constexpr int PER_L = 1856 + 384 + 256 + 16;
  const int l = u / PER_L; int r = u % PER_L;
  TrDesc d; int kt, nt;
  if (r < 1856) { d.src = p.w_in + (size_t)l * 1024 * 7424; d.N = 7424; d.dst = p.WinT + (size_t)l * 7424 * 1024; d.K = 1024; kt = r / 116; nt = r % 116; }
  else if (r < 2240) { r -= 1856; const int i = r >> 7, r2 = r & 127; d.src = p.w_branch + (size_t)(l * 3 + i) * 512 * 1024; d.N = 1024; d.dst = p.WbT + (size_t)(l * 3 + i) * 1024 * 512; d.K = 512; kt = r2 >> 4; nt = r2 & 15; }
  else if (r < 2496) { r -= 2240; d.src = p.w_out + (size_t)l * 1024 * 1024; d.N = 1024; d.dst = p.WoT + (size_t)l * 1024 * 1024; d.K = 1024; kt = r >> 4; nt = r & 15; }
  else { r -= 2496; const int g = r >> 2; d.src = p.pool_w + (size_t)(l * 4 + g) * 128 * 128; d.N = 128; d.dst = p.WpT + (size_t)(l * 4 + g) * 128 * 128; d.K = 128; kt = (r >> 1) & 1; nt = r & 1; }
  d.src += (size_t)(kt * 64) * d.N + nt * 64;
  d.dst += (size_t)(nt * 64) * d.K + kt * 64;
  return d;
}
DI void tr_load(f32x4 (&v)[2], const TrDesc& d, int tid) {
#pragma unroll
  for (int q = 0; q < 2; ++q) { const int idx = tid + 512 * q, row = idx >> 4, c4 = idx & 15; v[q] = *(const f32x4*)(d.src + (size_t)row * d.N + c4 * 4); }
}
DI void tr_finish(const f32x4 (&v)[2], const TrDesc& d, int tid, char* smem) {
  float* t = (float*)smem;
#pragma unroll
  for (int q = 0; q < 2; ++q) {
    const int idx = tid + 512 * q, row = idx >> 4, c4 = idx & 15;
    t[row * 65 + c4 * 4 + 0] = v[q][0]; t[row * 65 + c4 * 4 + 1] = v[q][1]; t[row * 65 + c4 * 4 + 2] = v[q][2]; t[row * 65 + c4 * 4 + 3] = v[q][3];
  }
  __syncthreads();
  {
    const int jn = tid >> 3, kc = tid & 7;
    u32x4 o;
#pragma unroll
    for (int e = 0; e < 4; ++e) o[e] = pack2(t[(kc * 8 + 2 * e) * 65 + jn], t[(kc * 8 + 2 * e + 1) * 65 + jn]);
    *(u32x4*)(d.dst + (size_t)jn * d.K + kc * 8) = o;
  }
  __syncthreads();
}

DI TrDesc trw_desc(const Params& p, int u) {
  const int l = u / 624; int r = u % 624;
  TrDesc d; int kt, nt;
  if (r < 464) { d.src = p.w_in + (size_t)l * 1024 * 7424; d.N = 7424; d.dst = p.WinT + (size_t)l * 7424 * 1024; d.K = 1024; kt = r / 29; nt = r % 29; }
  else if (r < 560) { r -= 464; const int i = r >> 5, r2 = r & 31; d.src = p.w_branch + (size_t)(l * 3 + i) * 512 * 1024; d.N = 1024; d.dst = p.WbT + (size_t)(l * 3 + i) * 1024 * 512; d.K = 512; kt = r2 >> 2; nt = r2 & 3; }
  else { r -= 560; d.src = p.w_out + (size_t)l * 1024 * 1024; d.N = 1024; d.dst = p.WoT + (size_t)l * 1024 * 1024; d.K = 1024; kt = r >> 2; nt = r & 3; }
  d.src += (size_t)(kt * 64) * d.N + nt * 256;
  d.dst += (size_t)(nt * 256) * d.K + kt * 64;
  return d;
}
DI void trw_load(f32x4 (&v)[8], const TrDesc& d, int tid) {
#pragma unroll
  for (int q = 0; q < 8; ++q) { const int idx = tid + 512 * q, row = idx >> 6, c4 = idx & 63; v[q] = *(const f32x4*)(d.src + (size_t)row * d.N + c4 * 4); }
}
DI void trw_finish(const f32x4 (&v)[8], const TrDesc& d, int tid, char* smem) {
  float* t = (float*)smem;
#pragma unroll
  for (int q = 0; q < 8; ++q) {
    const int idx = tid + 512 * q, row = idx >> 6, c4 = idx & 63;
    t[row * 257 + c4 * 4 + 0] = v[q][0]; t[row * 257 + c4 * 4 + 1] = v[q][1]; t[row * 257 + c4 * 4 + 2] = v[q][2]; t[row * 257 + c4 * 4 + 3] = v[q][3];
  }
  __syncthreads();
#pragma unroll
  for (int q = 0; q < 4; ++q) {
    const int idx = tid + 512 * q, jn = idx >> 3, kc = idx & 7;
    u32x4 o;
#pragma unroll
    for (int e = 0; e < 4; ++e) o[e] = pack2(t[(kc * 8 + 2 * e) * 257 + jn], t[(kc * 8 + 2 * e + 1) * 257 + jn]);
    *(u32x4*)(d.dst + (size_t)jn * d.K + kc * 8) = o;
  }
  __syncthreads();
}

DI void phase0(const Params& p, char* smem) {
  const int tid = get_tid(), lane = tid & 63, w = tid >> 6;
  constexpr int PER_L = 1856 + 384 + 256 + 16;
  constexpr int NWIDE = 2 * 624, NADA = 96, NPOOLW = 32;
  for (int u = blockIdx.x; u < NWIDE; u += gridDim.x) {
    const TrDesc d = trw_desc(p, u);
    f32x4 v[8]; trw_load(v, d, tid); trw_finish(v, d, tid, smem);
  }
  for (int u2 = (int)gridDim.x - 1 - (int)blockIdx.x; u2 < NADA + NPOOLW + 1; u2 += gridDim.x) {
    const int NTR = 0; const int u = u2 < NADA ? NTR + NPOOLW + u2 : (u2 < NADA + NPOOLW ? u2 - NADA : NPOOLW + NADA);
    if (u < NPOOLW) {
      const int l = u >> 4, r16 = u & 15;
      const TrDesc d = tr_desc(p, l * PER_L + 2496 + r16);
      f32x4 v[2]; tr_load(v, d, tid); tr_finish(v, d, tid, smem);
    } else if (u < NPOOLW + NADA) {
      const int a = u - NPOOLW, l = a / 48, n0 = (a % 48) * 64;
      float* s = (float*)smem;
      for (int i = tid; i < 5 * 1024; i += 512) {
        const int rr = i >> 10, k = i & 1023;
        const float v = rr < 4 ? p.c[rr * 1024 + k] : p.c_ctx[k];
        s[i] = v / (1.f + __expf(-v));
      }
      __syncthreads();
      float a5[5] = {0.f, 0.f, 0.f, 0.f, 0.f};
      const float* wp = p.ada_w + (size_t)l * 1024 * 3072 + n0 + lane;
      for (int k0 = w * 128; k0 < w * 128 + 128; k0 += 16) {
        float wv[16];
#pragma unroll
        for (int u = 0; u < 16; ++u) wv[u] = wp[(size_t)(k0 + u) * 3072];
#pragma unroll
        for (int u = 0; u < 16; ++u)
#pragma unroll
          for (int rr = 0; rr < 5; ++rr) a5[rr] += s[rr * 1024 + k0 + u] * wv[u];
      }
      __syncthreads();
      float* part = (float*)smem + 5 * 1024;
#pragma unroll
      for (int rr = 0; rr < 5; ++rr) part[(w * 5 + rr) * 64 + lane] = a5[rr];
      __syncthreads();
      for (int i = tid; i < 5 * 64; i += 512) {
        const int rr = i >> 6, nn = i & 63;
        float v = 0.f;
#pragma unroll
        for (int ww = 0; ww < 8; ++ww) v += part[(ww * 5 + rr) * 64 + nn];
        p.mod[(l * 5 + rr) * 3072 + n0 + nn] = v + p.ada_b[l * 3072 + n0 + nn];
      }
      __syncthreads();
    } else {
      if (w == 0) {
#pragma unroll 1
        for (int l = 0; l < 2; ++l) {
          const float* lp = opaque(p.dlam + l * 256);
          const float s1 = wave_sum(lp[lane] * lp[64 + lane]);
          const float s2 = wave_sum(lp[128 + lane] * lp[192 + lane]);
          const float lam_init = 0.8f - 0.6f * expf(-0.3f * (float)l);
          const float lam = expf(s1) - expf(s2) + lam_init;
          const float mdq = wave_max(fabsf(p.dqn[l * 64 + lane])), mdk = wave_max(fabsf(p.dkn[l * 64 + lane]));
          const float mgq = wave_max(fabsf(p.gqn[l * 64 + lane])), mgk = wave_max(fabsf(p.gkn[l * 64 + lane]));
          if (lane == 0) {
            p.consts[l * 4 + 0] = lam;
            p.consts[l * 4 + 1] = -(LOG2E * 8.f * mdq * mdk);
            p.consts[l * 4 + 2] = -(LOG2E * 8.f * mgq * mgk);
            p.consts[l * 4 + 3] = lam_init;
          }
        }
      }
    }
  }
}

DI void phase1(const Params& p, int l) {
  const int tid = get_tid(), lane = tid & 63, w = tid >> 6;
  const float* xlat = l == 0 ? p.x : p.out;
  const float* xctx = l == 0 ? p.ctx : p.xc1;
  const float* g = p.norm_g + l * 1024;
  f32x4 ma[4], mb[4]; int cur_mr = -1;
  for (int rb = blockIdx.x * 16; rb < NTOK; rb += gridDim.x * 16) {
    const int mr = rb < NLAT ? (rb >> 13) : 4;
    f32x4 v[2][4];
#pragma unroll
    for (int u = 0; u < 2; ++u) {
      const int row = rb + 2 * w + u;
      const float* sp = row < NLAT ? xlat + (size_t)row * 1024 : xctx + (size_t)(row - NLAT) * 1024;
#pragma unroll
      for (int q = 0; q < 4; ++q) v[u][q] = *(const f32x4*)(sp + q * 256 + lane * 4);
    }
    if (mr != cur_mr) {
      cur_mr = mr;
      const float* md = p.mod + (l * 5 + mr) * 3072;
#pragma unroll
      for (int q = 0; q < 4; ++q) {
        const int k = q * 256 + lane * 4;
        const f32x4 gg = *(const f32x4*)(g + k), sc = *(const f32x4*)(md + 1024 + k);
        mb[q] = *(const f32x4*)(md + k);
        ma[q] = gg * (1.f + sc);
      }
    }
    float ss[2];
#pragma unroll
    for (int u = 0; u < 2; ++u) {
      float s2 = 0.f;
#pragma unroll
      for (int q = 0; q < 4; ++q) s2 += v[u][q][0] * v[u][q][0] + v[u][q][1] * v[u][q][1] + v[u][q][2] * v[u][q][2] + v[u][q][3] * v[u][q][3];
      ss[u] = wave_sum(s2);
    }
#pragma unroll
    for (int u = 0; u < 2; ++u) {
      const int row = rb + 2 * w + u;
      const float rstd = __builtin_amdgcn_rsqf(ss[u] * (1.f / 1024.f) + 1e-6f);
#pragma unroll
      for (int q = 0; q < 4; ++q) {
        const int k = q * 256 + lane * 4;
        float o[4];
#pragma unroll
        for (int e = 0; e < 4; ++e) o[e] = v[u][q][e] * rstd * ma[q][e] + mb[q][e];
        u32x2 pk = {pack2(o[0], o[1]), pack2(o[2], o[3])};
        *(u32x2*)(p.h + (size_t)row * 1024 + k) = pk;
      }
    }
  }
}

struct Sched2 {
  TileWalk tw; const char* h; const char* W;
  DI bool next(int i, g8::Unit& u) const {
    int mt, pn2;
    if (!tw.at(i, mt, pn2)) return false;
    u.A = h + (size_t)mt * 256 * 2048; u.B = W + (size_t)pn2 * 256 * 2048; u.lda2 = 2048; u.ldb2 = 2048; u.nt = 16;
    u.kind = 0; u.i0 = mt; u.i1 = pn2; u.i2 = 0;
    return true;
  }
};
struct Epi2 {
  const Params& p; int l;
  DI void operator()(const f32x4 (&acc)[2][2][4][2], const g8::Unit& u, int wr, int wc, int fr, int fq) const {
    const int mt = u.i0, pn2 = u.i1, row0 = mt * 256;
    const bool isctx = mt >= 128;
    const int b = isctx ? (mt - 128) : (mt >> 5);
    const int t0 = isctx ? 0 : (mt & 31) * 256;
    const int key0 = isctx ? 0 : 256 + t0;
    const int pn = 2 * pn2 + (wc >> 1), hc = (wc & 1) * 64;
    const bool plain = pn < 8 || (pn >= 20 && pn < 24) || pn >= 30;
    if (plain) {
      int pcol; bool silu;
      if (pn < 4) { pcol = pn * 128; silu = false; } else if (pn < 8) { pcol = pn * 128; silu = true; }
      else if (pn < 24) { pcol = pn * 128 - 1024; silu = true; } else { pcol = pn * 128 - 1280; silu = true; }
      char* dstb = (char*)(p.Pm + (size_t)row0 * PMW + pcol + hc);
      unsigned lo = (unsigned)((64 * wr + fr) * PMW + 4 * fq) * 2u;
      asm volatile("" : "+v"(lo));
#pragma unroll
      for (int ai = 0; ai < 2; ++ai)
#pragma unroll
        for (int m = 0; m < 4; ++m) {
#pragma unroll
          for (int bj = 0; bj < 2; ++bj)
#pragma unroll
            for (int n = 0; n < 2; ++n) {
              f32x4 v = acc[ai][bj][m][n];
              if (silu) { v[0] = fast_silu(v[0]); v[1] = fast_silu(v[1]); v[2] = fast_silu(v[2]); v[3] = fast_silu(v[3]); }
              u32x2 pk = {pack2(v[0], v[1]), pack2(v[2], v[3])};
              *(u32x2*)(dstb + (lo + (unsigned)(((128 * ai + 16 * m) * PMW + 32 * bj + 16 * n) * 2))) = pk;
            }
          asm volatile("" ::: "memory"); __builtin_amdgcn_sched_barrier(0);
        }
    } else if ((pn >= 16 && pn < 20) || pn == 29) {
      char* dstb = (char*)(pn == 29 ? p.GVt + ((size_t)b * 128 + hc) * NKEY + key0 : p.DVt + ((size_t)b * 512 + (pn - 16) * 128 + hc) * NKEY + key0);
      unsigned lo = (unsigned)((4 * fq) * NKEY + 64 * wr + fr) * 2u;
      asm volatile("" : "+v"(lo));
#pragma unroll
      for (int ai = 0; ai < 2; ++ai)
#pragma unroll
        for (int m = 0; m < 4; ++m) {
#pragma unroll
          for (int bj = 0; bj < 2; ++bj)
#pragma unroll
            for (int n = 0; n < 2; ++n)
#pragma unroll
              for (int j = 0; j < 4; ++j)
                *(bf16_t*)(dstb + (lo + (unsigned)(((32 * bj + 16 * n + j) * NKEY + 128 * ai + 16 * m) * 2))) = f2bf(acc[ai][bj][m][n][j]);
          asm volatile("" ::: "memory"); __builtin_amdgcn_sched_barrier(0);
        }
    } else {
      const float* gn; bf16_t* dst; int ldd; float oscale;
      if (pn < 12) { gn = p.dqn + l * 64; dst = p.Pm + (size_t)row0 * PMW + pn * 128 + hc; ldd = PMW; oscale = LOG2E * 0.125f; }
      else if (pn < 16) { gn = p.dkn + l * 64; dst = p.DK + ((size_t)b * NKEY + key0) * 512 + (pn - 12) * 128 + hc; ldd = 512; oscale = 1.f; }
      else if (pn < 28) { gn = p.gqn + l * 64; dst = p.Pm + (size_t)row0 * PMW + pn * 128 - 1024 + hc; ldd = PMW; oscale = LOG2E * 0.125f; }
      else { gn = p.gkn + l * 64; dst = p.GK + ((size_t)b * NKEY + key0) * 128 + hc; ldd = 128; oscale = 1.f; }
      gn = opaque(gn);
      int fro = fr; asm volatile("" : "+v"(fro));
      float inv[4];
#pragma unroll
      for (int j = 0; j < 4; ++j) inv[j] = __builtin_amdgcn_exp2f((float)(4 * (fro >> 30) + 4 * fq + j) * -0.8304820237218406f);
#pragma unroll
      for (int ai = 0; ai < 2; ++ai)
#pragma unroll
        for (int m = 0; m < 4; ++m) {
          const int tok = 128 * ai + 64 * wr + 16 * m + fro;
          f32x4 y[2][2]; float ss = 0.f;
#pragma unroll
          for (int bj = 0; bj < 2; ++bj)
#pragma unroll
            for (int n = 0; n < 2; ++n) { y[bj][n] = acc[ai][bj][m][n]; ss += y[bj][n][0] * y[bj][n][0] + y[bj][n][1] * y[bj][n][1] + y[bj][n][2] * y[bj][n][2] + y[bj][n][3] * y[bj][n][3]; }
          ss += __shfl_xor(ss, 16); ss += __shfl_xor(ss, 32);
          const float rstd = __builtin_amdgcn_rsqf(ss * (1.f / 64.f) + 1e-6f) ;
#pragma unroll
          for (int bj = 0; bj < 2; ++bj)
#pragma unroll
            for (int n = 0; n < 2; ++n) {
              const f32x4 g4 = *(const f32x4*)(gn + 32 * bj + 16 * n + 4 * fq);
#pragma unroll
              for (int j = 0; j < 4; ++j) y[bj][n][j] *= rstd * g4[j];
            }
          if (!isctx) {
            const int tseq = t0 + tok;
#pragma unroll
            for (int bj = 0; bj < 2; ++bj) {
              const float pos = (float)(bj == 0 ? (tseq >> 6) : (tseq & 63));
#pragma unroll
              for (int j = 0; j < 4; ++j) {
                const float ang = pos * inv[j];
                const float cs = __cosf(ang), sn = __sinf(ang);
                const float x1 = y[bj][0][j], x2 = y[bj][1][j];
                y[bj][0][j] = x1 * cs - x2 * sn; y[bj][1][j] = x1 * sn + x2 * cs;
              }
            }
          }
          const unsigned ro = (unsigned)(tok * ldd + 4 * fq) * 2u;
#pragma unroll
          for (int bj = 0; bj < 2; ++bj)
#pragma unroll
            for (int n = 0; n < 2; ++n) {
              u32x2 pk = {pack2(y[bj][n][0] * oscale, y[bj][n][1] * oscale), pack2(y[bj][n][2] * oscale, y[bj][n][3] * oscale)};
              *(u32x2*)((char*)dst + (ro + (unsigned)((32 * bj + 16 * n) * 2))) = pk;
            }
          asm volatile("" ::: "memory"); __builtin_amdgcn_sched_barrier(0);
        }
    }
  }
};

DI void phase2(const Params& p, int l, char* smem) {
  Sched2 S; S.tw.init(132, 17); S.h = (const char*)p.h; S.W = (const char*)(p.WinT + (size_t)l * 7424 * 1024);
  Epi2 E{p, l};
  g8::gemm_phase<true>(smem, S, E);
}

DI void softmax_step(f32x16& S, float& l0, float& l1, bf16x8 (&pf)[2]) {
#pragma unroll
  for (int e = 0; e < 16; ++e) S[e] = __builtin_amdgcn_exp2f(S[e]);
#pragma unroll
  for (int e = 0; e < 8; ++e) { l0 += S[2 * e]; l1 += S[2 * e + 1]; }
#pragma unroll
  for (int s = 0; s < 2; ++s) {
    u32x4 pk = {pack2(S[8 * s], S[8 * s + 1]), pack2(S[8 * s + 2], S[8 * s + 3]), pack2(S[8 * s + 4], S[8 * s + 5]), pack2(S[8 * s + 6], S[8 * s + 7])};
    pf[s] = __builtin_bit_cast(bf16x8, pk);
  }
}

constexpr int ABUFD = 8192 + 128 * 128;
DI int swz_off(int row, int c) { const int R = row >> 1; return R * 256 + (((((row & 1) << 3) | c) ^ (R & 15)) << 4); }
DI unsigned dma_src(int q, int lane, unsigned pitch) {
  const int R = 4 * q + (lane >> 4), C = (lane & 15) ^ (R & 15), row = 2 * R + (C >> 3), ch = C & 7;
  return (unsigned)row * pitch + (unsigned)ch * 16u;
}

template <int DV>
DI void attn_pass(f32x16 (&O)[DV / 32], float& lsum, const bf16x8 (&qf)[4], const bf16_t* __restrict__ Kb, int ldk, const bf16_t* __restrict__ Vt, int nkeys, char* smem) {
  constexpr int NV = DV / 32, NS = DV / 64;
  const int tid = get_tid(), lane = tid & 63, wid = __builtin_amdgcn_readfirstlane(tid >> 6), r = lane & 31, h = lane >> 5;
  const int pr = (r & 19) | ((r & 4) << 1) | ((r & 8) >> 1);
  const char* Kc = (const char*)Kb; const char* Vc = (const char*)Vt;
  G8_LAS unsigned char* lds = (G8_LAS unsigned char*)smem;
  const int nt = nkeys >> 6;
  const unsigned kpitch = (unsigned)ldk * 2u;
  const unsigned ksrc = dma_src(wid, lane, kpitch);
  unsigned vsrc[NS];
#pragma unroll
  for (int j = 0; j < NS; ++j) vsrc[j] = dma_src(wid + 8 * j, lane, (unsigned)NKEY * 2u);
#define ATT_ISSUE(kt_, b_) do { \
    __builtin_amdgcn_global_load_lds((const unsigned*)(Kc + (ksrc + (unsigned)(kt_) * 64u * kpitch)), (G8_LAS unsigned*)(lds + b_ + wid * 1024), 16, 0, 0); \
    _Pragma("unroll") for (int j_ = 0; j_ < NS; ++j_) \
      __builtin_amdgcn_global_load_lds((const unsigned*)(Vc + (vsrc[j_] + (unsigned)(kt_) * 128u)), (G8_LAS unsigned*)(lds + b_ + 8192 + (wid + 8 * j_) * 1024), 16, 0, 0); } while (0)
  ATT_ISSUE(0, 0);
  if (nt > 1) { ATT_ISSUE(1, ABUFD); if (NS == 2) asm volatile("s_waitcnt vmcnt(3)" ::: "memory"); else asm volatile("s_waitcnt vmcnt(2)" ::: "memory"); }
  else asm volatile("s_waitcnt vmcnt(0)" ::: "memory");
  __builtin_amdgcn_s_barrier();
  int ka[4], va[2][2];
#pragma unroll
  for (int t = 0; t < 4; ++t) ka[t] = swz_off(pr, 2 * t + h);
#pragma unroll
  for (int sb = 0; sb < 2; ++sb)
#pragma unroll
    for (int s = 0; s < 2; ++s) va[sb][s] = 8192 + swz_off(r, 4 * sb + 2 * s + h);
#pragma unroll
  for (int bk = 0; bk < NV; ++bk)
#pragma unroll
    for (int e = 0; e < 16; ++e) O[bk][e] = 0.f;
  float l0 = 0.f, l1 = 0.f;
  int bo = 0;
#pragma unroll 2
  for (int kt = 0; kt < nt; ++kt) {
    const char* cur = smem + bo;
    const int b2 = bo >= ABUFD ? bo - ABUFD : bo + 2 * ABUFD;
    if (kt + 2 < nt) ATT_ISSUE(kt + 2, b2);
    bf16x8 kf[2][4], vf[NV][2];
#pragma unroll
    for (int sb = 0; sb < 2; ++sb)
#pragma unroll
      for (int t = 0; t < 4; ++t) kf[sb][t] = *(const bf16x8*)(cur + ka[t] + sb * 4096);
#pragma unroll
    for (int bk = 0; bk < NV; ++bk)
#pragma unroll
      for (int s = 0; s < 2; ++s) vf[bk][s] = *(const bf16x8*)(cur + va[0][s] + bk * 4096);
    f32x16 S0, S1;
#pragma unroll
    for (int e = 0; e < 16; ++e) { S0[e] = 0.f; S1[e] = 0.f; }
#pragma unroll
    for (int t = 0; t < 4; ++t) S0 = MFMA(kf[0][t], qf[t], S0);
#pragma unroll
    for (int t = 0; t < 4; ++t) S1 = MFMA(kf[1][t], qf[t], S1);
    bf16x8 pf[2];
    softmax_step(S0, l0, l1, pf);
#pragma unroll
    for (int bk = 0; bk < NV; ++bk)
#pragma unroll
      for (int s = 0; s < 2; ++s) O[bk] = MFMA(vf[bk][s], pf[s], O[bk]);
#pragma unroll
    for (int bk = 0; bk < NV; ++bk)
#pragma unroll
      for (int s = 0; s < 2; ++s) vf[bk][s] = *(const bf16x8*)(cur + va[1][s] + bk * 4096);
    softmax_step(S1, l0, l1, pf);
#pragma unroll
    for (int bk = 0; bk < NV; ++bk)
#pragma unroll
      for (int s = 0; s < 2; ++s) O[bk] = MFMA(vf[bk][s], pf[s], O[bk]);
    if (kt + 2 < nt) { if (NS == 2) asm volatile("s_waitcnt vmcnt(3)" ::: "memory"); else asm volatile("s_waitcnt vmcnt(2)" ::: "memory"); }
    else asm volatile("s_waitcnt vmcnt(0)" ::: "memory");
    asm volatile("s_waitcnt lgkmcnt(0)" ::: "memory");
    __builtin_amdgcn_s_barrier();
    bo = bo == 2 * ABUFD ? 0 : bo + ABUFD;
  }
#undef ATT_ISSUE
  lsum = l0 + l1;
}

DI void load_q(bf16x8 (&qf)[4], const bf16_t* __restrict__ qp  , int h) {
#pragma unroll
  for (int t = 0; t < 4; ++t) qf[t] = *(const bf16x8*)(qp + 16 * t + 8 * h);
}

DI void diff_unit(const Params& p, int l, int b, int hh, int qrow0, int nkeys, char* smem) {
  f32x16 O[4]; float ls;
  float sc1 = 0.f;
#pragma unroll 1
  for (int c = 0; c < 2; ++c) {
    {
      const int tid = get_tid(), lane = tid & 63, w = tid >> 6, r = lane & 31, h = lane >> 5;
      bf16x8 qf[4];
      load_q(qf, p.Pm + (size_t)(qrow0 + 32 * w + r) * PMW + C_DQ + (2 * hh + c) * 64, h);
      attn_pass<128>(O, ls, qf, p.DK + (size_t)b * NKEY * 512 + (2 * hh + c) * 64, 512, p.DVt + ((size_t)b * 512 + hh * 128) * NKEY, nkeys, smem);
    }
    ls += __shfl_xor(ls, 32);
    if (c == 0) {
      const int tid = get_tid();
      float* st = p.stash + (size_t)blockIdx.x * 32768 + tid * 64;
      const float inv = 1.f / ls;
#pragma unroll
      for (int bk = 0; bk < 4; ++bk)
#pragma unroll
        for (int g4 = 0; g4 < 4; ++g4) {
          const f32x4 v4 = {O[bk][4 * g4] * inv, O[bk][4 * g4 + 1] * inv, O[bk][4 * g4 + 2] * inv, O[bk][4 * g4 + 3] * inv};
          *(f32x4*)(st + bk * 16 + g4 * 4) = v4;
        }
    } else sc1 = -p.consts[l * 4 + 0] / ls;
  }
  const int tid = get_tid(), lane = tid & 63, w = tid >> 6, r = lane & 31, h = lane >> 5;
  const float* st = p.stash + (size_t)blockIdx.x * 32768 + tid * 64;
  float ss = 0.f;
#pragma unroll
  for (int bk = 0; bk < 4; ++bk)
#pragma unroll
    for (int g4 = 0; g4 < 4; ++g4) {
      const f32x4 s4 = *(const f32x4*)(st + bk * 16 + g4 * 4);
#pragma unroll
      for (int e = 0; e < 4; ++e) { const float v = s4[e] + sc1 * O[bk][4 * g4 + e]; O[bk][4 * g4 + e] = v; ss += v * v; }
    }
  ss += __shfl_xor(ss, 32);
  const float rs = __builtin_amdgcn_rsqf(ss * (1.f / 128.f) + 1e-6f) * (1.f - p.consts[l * 4 + 3]);
  const float* sub = opaque(p.dsub + l * 128);
  bf16_t* zrow = p.Pm + (size_t)(qrow0 + 32 * w + r) * PMW + C_ZD + hh * 128;
#pragma unroll
  for (int bk = 0; bk < 4; ++bk)
#pragma unroll
    for (int g4 = 0; g4 < 4; ++g4) {
      const int dv0 = 32 * bk + 8 * g4 + 4 * h;
      const u32x2 z = *(const u32x2*)(zrow + dv0);
      const f32x4 sg = *(const f32x4*)(sub + dv0);
      const float o0 = O[bk][4 * g4] * rs * sg[0] * bflo(z[0]), o1 = O[bk][4 * g4 + 1] * rs * sg[1] * bfhi(z[0]);
      const float o2 = O[bk][4 * g4 + 2] * rs * sg[2] * bflo(z[1]), o3 = O[bk][4 * g4 + 3] * rs * sg[3] * bfhi(z[1]);
      u32x2 pk = {pack2(o0, o1), pack2(o2, o3)};
      *(u32x2*)(zrow + dv0) = pk;
      asm volatile("" ::: "memory"); __builtin_amdgcn_sched_barrier(0);
    }
}

DI void attn_pass_d2(f32x16 (&O)[2][4], float (&lsum)[2], const bf16x8 (&qf)[2][4], const bf16_t* __restrict__ Kb, const bf16_t* __restrict__ Vt, char* smem) {
  const int tid = get_tid(), lane = tid & 63, wid = __builtin_amdgcn_readfirstlane(tid >> 6), r = lane & 31, h = lane >> 5;
  const int pr = (r & 19) | ((r & 4) << 1) | ((r & 8) >> 1);
  const char* Kc = (const char*)Kb; const char* Vc = (const char*)Vt;
  G8_LAS unsigned char* lds = (G8_LAS unsigned char*)smem;
  constexpr int nt = NKEY >> 6;
  const unsigned ksrc = dma_src(wid, lane, 1024u), vsrc0 = dma_src(wid, lane, (unsigned)NKEY * 2u), vsrc1 = dma_src(wid + 8, lane, (unsigned)NKEY * 2u);
#define D2_ISSUE(kt_, b_) do { \
    __builtin_amdgcn_global_load_lds((const unsigned*)(Kc + (ksrc + (unsigned)(kt_) * 64u * 1024u)), (G8_LAS unsigned*)(lds + (b_) + wid * 1024), 16, 0, 0); \
    __builtin_amdgcn_global_load_lds((const unsigned*)(Vc + (vsrc0 + (unsigned)(kt_) * 128u)), (G8_LAS unsigned*)(lds + (b_) + 8192 + wid * 1024), 16, 0, 0); \
    __builtin_amdgcn_global_load_lds((const unsigned*)(Vc + (vsrc1 + (unsigned)(kt_) * 128u)), (G8_LAS unsigned*)(lds + (b_) + 8192 + (wid + 8) * 1024), 16, 0, 0); } while (0)
  D2_ISSUE(0, 0);
  D2_ISSUE(1, ABUFD);
  asm volatile("s_waitcnt vmcnt(3)" ::: "memory");
  __builtin_amdgcn_s_barrier();
  int ka[4], va[2][2];
#pragma unroll
  for (int t = 0; t < 4; ++t) ka[t] = swz_off(pr, 2 * t + h);
#pragma unroll
  for (int sb = 0; sb < 2; ++sb)
#pragma unroll
    for (int s2 = 0; s2 < 2; ++s2) va[sb][s2] = 8192 + swz_off(r, 4 * sb + 2 * s2 + h);
#pragma unroll
  for (int qb = 0; qb < 2; ++qb)
#pragma unroll
    for (int bk = 0; bk < 4; ++bk)
#pragma unroll
      for (int e = 0; e < 16; ++e) O[qb][bk][e] = 0.f;
  float l0[2] = {0.f, 0.f};
  int bo = 0;
#pragma unroll 1
  for (int kt = 0; kt < nt; ++kt) {
    const char* cur = smem + bo;
    const int b2 = bo >= ABUFD ? bo - ABUFD : bo + 2 * ABUFD;
    if (kt + 2 < nt) D2_ISSUE(kt + 2, b2);
#pragma unroll 1
    for (int sb = 0; sb < 2; ++sb) {
      bf16x8 pf0[2], pf1[2];
      {
        bf16x8 kf[4];
#pragma unroll
        for (int t = 0; t < 4; ++t) kf[t] = *(const bf16x8*)(cur + ka[t] + sb * 4096);
        f32x16 S0, S1;
#pragma unroll
        for (int e = 0; e < 16; ++e) { S0[e] = 0.f; S1[e] = 0.f; }
#pragma unroll
        for (int t = 0; t < 4; ++t) S0 = MFMA(kf[t], qf[0][t], S0);
#pragma unroll
        for (int t = 0; t < 4; ++t) S1 = MFMA(kf[t], qf[1][t], S1);
        softmax_step(S0, l0[0], l0[0], pf0);
        softmax_step(S1, l0[1], l0[1], pf1);
      }
#pragma unroll
      for (int bk = 0; bk < 4; ++bk)
#pragma unroll
        for (int s2 = 0; s2 < 2; ++s2) {
          const bf16x8 vf = *(const bf16x8*)(cur + va[0][s2] + sb * 64 * 0 + bk * 4096 + (sb ? (va[1][s2] - va[0][s2]) : 0));
          O[0][bk] = MFMA(vf, pf0[s2], O[0][bk]);
          O[1][bk] = MFMA(vf, pf1[s2], O[1][bk]);
        }
    }
    if (kt + 2 < nt) asm volatile("s_waitcnt vmcnt(3)" ::: "memory"); else asm volatile("s_waitcnt vmcnt(0)" ::: "memory");
    asm volatile("s_waitcnt lgkmcnt(0)" ::: "memory");
    __builtin_amdgcn_s_barrier();
    bo = bo == 2 * ABUFD ? 0 : bo + ABUFD;
  }
#undef D2_ISSUE
  lsum[0] = l0[0]; lsum[1] = l0[1];
}

DI void diff_unit2(const Params& p, int l, int b, int hh, int qrow0, char* smem) {
  f32x16 O[2][4]; float ls[2];
  float sc1[2] = {0.f, 0.f};
#pragma unroll 1
  for (int c = 0; c < 2; ++c) {
    {
      const int tid = get_tid(), lane = tid & 63, w = tid >> 6, r = lane & 31, h = lane >> 5;
      bf16x8 qf[2][4];
#pragma unroll
      for (int qb = 0; qb < 2; ++qb) load_q(qf[qb], p.Pm + (size_t)(qrow0 + 64 * w + 32 * qb + r) * PMW + C_DQ + (2 * hh + c) * 64, h);
      attn_pass_d2(O, ls, qf, p.DK + (size_t)b * NKEY * 512 + (2 * hh + c) * 64, p.DVt + ((size_t)b * 512 + hh * 128) * NKEY, smem);
    }
#pragma unroll
    for (int qb = 0; qb < 2; ++qb) ls[qb] += __shfl_xor(ls[qb], 32);
    if (c == 0) {
      const int tid = get_tid();
      float* st = p.stash + (size_t)blockIdx.x * 65536 + tid * 128;
#pragma unroll
      for (int qb = 0; qb < 2; ++qb) {
        const float inv = 1.f / ls[qb];
#pragma unroll
        for (int bk = 0; bk < 4; ++bk)
#pragma unroll
          for (int g4 = 0; g4 < 4; ++g4) {
            const f32x4 v4 = {O[qb][bk][4 * g4] * inv, O[qb][bk][4 * g4 + 1] * inv, O[qb][bk][4 * g4 + 2] * inv, O[qb][bk][4 * g4 + 3] * inv};
            *(f32x4*)(st + qb * 64 + bk * 16 + g4 * 4) = v4;
          }
      }
    } else { sc1[0] = -p.consts[l * 4 + 0] / ls[0]; sc1[1] = -p.consts[l * 4 + 0] / ls[1]; }
  }
  const int tid = get_tid(), lane = tid & 63, w = tid >> 6, r = lane & 31, h = lane >> 5;
  const float* st = p.stash + (size_t)blockIdx.x * 65536 + tid * 128;
  const float* sub = opaque(p.dsub + l * 128);
#pragma unroll
  for (int qb = 0; qb < 2; ++qb) {
    float ss = 0.f;
#pragma unroll
    for (int bk = 0; bk < 4; ++bk)
#pragma unroll
      for (int g4 = 0; g4 < 4; ++g4) {
        const f32x4 s4 = *(const f32x4*)(st + qb * 64 + bk * 16 + g4 * 4);
#pragma unroll
        for (int e = 0; e < 4; ++e) { const float v = s4[e] + sc1[qb] * O[qb][bk][4 * g4 + e]; O[qb][bk][4 * g4 + e] = v; ss += v * v; }
      }
    ss += __shfl_xor(ss, 32);
    const float rs = __builtin_amdgcn_rsqf(ss * (1.f / 128.f) + 1e-6f) * (1.f - p.consts[l * 4 + 3]);
    bf16_t* zrow = p.Pm + (size_t)(qrow0 + 64 * w + 32 * qb + r) * PMW + C_ZD + hh * 128;
#pragma unroll
    for (int bk = 0; bk < 4; ++bk)
#pragma unroll
      for (int g4 = 0; g4 < 4; ++g4) {
        const int dv0 = 32 * bk + 8 * g4 + 4 * h;
        const u32x2 z = *(const u32x2*)(zrow + dv0);
        const f32x4 sg = *(const f32x4*)(sub + dv0);
        const float o0 = O[qb][bk][4 * g4] * rs * sg[0] * bflo(z[0]), o1 = O[qb][bk][4 * g4 + 1] * rs * sg[1] * bfhi(z[0]);
        const float o2 = O[qb][bk][4 * g4 + 2] * rs * sg[2] * bflo(z[1]), o3 = O[qb][bk][4 * g4 + 3] * rs * sg[3] * bfhi(z[1]);
        u32x2 pk = {pack2(o0, o1), pack2(o2, o3)};
        *(u32x2*)(zrow + dv0) = pk;
        asm volatile("" ::: "memory");
      }
  }
}

DI void gqa_unit(const Params& p, int l, int b, int qh, int qrow0, int nkeys, char* smem) {
  const int tid = get_tid(), lane = tid & 63, w = tid >> 6, r = lane & 31, h = lane >> 5;
  const int qrow = qrow0 + 32 * w + r, kvh = qh >> 2;
  f32x16 O[2]; float ls; bf16x8 qf[4];
  load_q(qf, p.Pm + (size_t)qrow * PMW + C_GQ + qh * 64, h);
  attn_pass<64>(O, ls, qf, p.GK + (size_t)b * NKEY * 128 + kvh * 64, 128, p.GVt + ((size_t)b * 128 + kvh * 64) * NKEY, nkeys, smem);
  ls += __shfl_xor(ls, 32);
  const float inv = 1.f / ls;
  bf16_t* zrow = p.Pm + (size_t)qrow * PMW + C_ZG + qh * 64;
#pragma unroll
  for (int bk = 0; bk < 2; ++bk)
#pragma unroll
    for (int g4 = 0; g4 < 4; ++g4) {
      const int dv0 = 32 * bk + 8 * g4 + 4 * h;
      const u32x2 z = *(const u32x2*)(zrow + dv0);
      const float o0 = O[bk][4 * g4] * inv * bflo(z[0]), o1 = O[bk][4 * g4 + 1] * inv * bfhi(z[0]);
      const float o2 = O[bk][4 * g4 + 2] * inv * bflo(z[1]), o3 = O[bk][4 * g4 + 3] * inv * bfhi(z[1]);
      u32x2 pk = {pack2(o0, o1), pack2(o2, o3)};
      *(u32x2*)(zrow + dv0) = pk;
    }
}

DI void attn_pass_g2(f32x16 (&O)[2][2], float (&lsum)[2], const bf16x8 (&qf)[2][4], const bf16_t* __restrict__ Kb, const bf16_t* __restrict__ Vt, int nkeys, char* smem) {
  const int tid = get_tid(), lane = tid & 63, wid = __builtin_amdgcn_readfirstlane(tid >> 6), r = lane & 31, h = lane >> 5;
  const int pr = (r & 19) | ((r & 4) << 1) | ((r & 8) >> 1);
  const char* Kc = (const char*)Kb; const char* Vc = (const char*)Vt;
  G8_LAS unsigned char* lds = (G8_LAS unsigned char*)smem;
  const int nt = nkeys >> 6;
  const unsigned ksrc = dma_src(wid, lane, 256u), vsrc = dma_src(wid, lane, (unsigned)NKEY * 2u);
#define G2_ISSUE(kt_, b_) do { \
    __builtin_amdgcn_global_load_lds((const unsigned*)(Kc + (ksrc + (unsigned)(kt_) * 64u * 256u)), (G8_LAS unsigned*)(lds + b_ + wid * 1024), 16, 0, 0); \
    __builtin_amdgcn_global_load_lds((const unsigned*)(Vc + (vsrc + (unsigned)(kt_) * 128u)), (G8_LAS unsigned*)(lds + b_ + 8192 + wid * 1024), 16, 0, 0); } while (0)
  G2_ISSUE(0, 0);
  if (nt > 1) { G2_ISSUE(1, ABUFD); asm volatile("s_waitcnt vmcnt(2)" ::: "memory"); }
  else asm volatile("s_waitcnt vmcnt(0)" ::: "memory");
  __builtin_amdgcn_s_barrier();
  int ka[4], va[2][2];
#pragma unroll
  for (int t = 0; t < 4; ++t) ka[t] = swz_off(pr, 2 * t + h);
#pragma unroll
  for (int sb = 0; sb < 2; ++sb)
#pragma unroll
    for (int s2 = 0; s2 < 2; ++s2) va[sb][s2] = 8192 + swz_off(r, 4 * sb + 2 * s2 + h);
#pragma unroll
  for (int qb = 0; qb < 2; ++qb)
#pragma unroll
    for (int bk = 0; bk < 2; ++bk)
#pragma unroll
      for (int e = 0; e < 16; ++e) O[qb][bk][e] = 0.f;
  float l0[2] = {0.f, 0.f}, l1[2] = {0.f, 0.f};
  int bo = 0;
#pragma unroll 1
  for (int kt = 0; kt < nt; ++kt) {
    const char* cur = smem + bo;
    const int b2 = bo >= ABUFD ? bo - ABUFD : bo + 2 * ABUFD;
    if (kt + 2 < nt) G2_ISSUE(kt + 2, b2);
#pragma unroll
    for (int sb = 0; sb < 2; ++sb) {
      bf16x8 kf[4];
#pragma unroll
      for (int t = 0; t < 4; ++t) kf[t] = *(const bf16x8*)(cur + ka[t] + sb * 4096);
      f32x16 S0, S1;
#pragma unroll
      for (int e = 0; e < 16; ++e) { S0[e] = 0.f; S1[e] = 0.f; }
#pragma unroll
      for (int t = 0; t < 4; ++t) S0 = MFMA(kf[t], qf[0][t], S0);
#pragma unroll
      for (int t = 0; t < 4; ++t) S1 = MFMA(kf[t], qf[1][t], S1);
      bf16x8 vf[2][2];
#pragma unroll
      for (int bk = 0; bk < 2; ++bk)
#pragma unroll
        for (int s2 = 0; s2 < 2; ++s2) vf[bk][s2] = *(const bf16x8*)(cur + va[sb][s2] + bk * 4096);
      bf16x8 pf[2];
      softmax_step(S0, l0[0], l1[0], pf);
#pragma unroll
      for (int bk = 0; bk < 2; ++bk)
#pragma unroll
        for (int s2 = 0; s2 < 2; ++s2) O[0][bk] = MFMA(vf[bk][s2], pf[s2], O[0][bk]);
      softmax_step(S1, l0[1], l1[1], pf);
#pragma unroll
      for (int bk = 0; bk < 2; ++bk)
#pragma unroll
        for (int s2 = 0; s2 < 2; ++s2) O[1][bk] = MFMA(vf[bk][s2], pf[s2], O[1][bk]);
    }
    if (kt + 2 < nt) asm volatile("s_waitcnt vmcnt(2)" ::: "memory"); else asm volatile("s_waitcnt vmcnt(0)" ::: "memory");
    asm volatile("s_waitcnt lgkmcnt(0)" ::: "memory");
    __builtin_amdgcn_s_barrier();
    bo = bo == 2 * ABUFD ? 0 : bo + ABUFD;
  }
#undef G2_ISSUE
  lsum[0] = l0[0] + l1[0]; lsum[1] = l0[1] + l1[1];
}

DI void gqa_unit2(const Params& p, int l, int b, int qh, int qrow0, char* smem) {
  const int tid = get_tid(), lane = tid & 63, w = tid >> 6, r = lane & 31, h = lane >> 5;
  const int kvh = qh >> 2;
  f32x16 O[2][2]; float ls[2]; bf16x8 qf[2][4];
#pragma unroll
  for (int qb = 0; qb < 2; ++qb) load_q(qf[qb], p.Pm + (size_t)(qrow0 + 64 * w + 32 * qb + r) * PMW + C_GQ + qh * 64, h);
  attn_pass_g2(O, ls, qf, p.GK + (size_t)b * NKEY * 128 + kvh * 64, p.GVt + ((size_t)b * 128 + kvh * 64) * NKEY, NKEY, smem);
#pragma unroll
  for (int qb = 0; qb < 2; ++qb) {
    float lsq = ls[qb]; lsq += __shfl_xor(lsq, 32);
    const float inv = 1.f / lsq;
    bf16_t* zrow = p.Pm + (size_t)(qrow0 + 64 * w + 32 * qb + r) * PMW + C_ZG + qh * 64;
#pragma unroll
    for (int bk = 0; bk < 2; ++bk)
#pragma unroll
      for (int g4 = 0; g4 < 4; ++g4) {
        const int dv0 = 32 * bk + 8 * g4 + 4 * h;
        const u32x2 z = *(const u32x2*)(zrow + dv0);
        const float o0 = O[qb][bk][4 * g4] * inv * bflo(z[0]), o1 = O[qb][bk][4 * g4 + 1] * inv * bfhi(z[0]);
        const float o2 = O[qb][bk][4 * g4 + 2] * inv * bflo(z[1]), o3 = O[qb][bk][4 * g4 + 3] * inv * bfhi(z[1]);
        u32x2 pk = {pack2(o0, o1), pack2(o2, o3)};
        *(u32x2*)(zrow + dv0) = pk;
      }
  }
}

DI void pool_unit(const Params& p, int l, int mt, int g, char* smem) {
  const int tid = (get_tid() & 255), lane = tid & 63, w = tid >> 6, wm = w >> 1, wn = w & 1, r = lane & 31, h = lane >> 5;
  const int row0 = mt * 128;
  int seq0, n, t0;
  if (mt < 256) { seq0 = (mt >> 6) * 8192; n = 8192; t0 = (mt & 63) * 128; }
  else { const int c = mt - 256; seq0 = NLAT + (c >> 1) * 256; n = 256; t0 = (c & 1) * 128; }
  const int wnd = 2 << g, left = wnd >> 1, right = wnd - 1 - left;
  char* ut = smem + 2 * TILEB;
  u32x4 wreg[8];
#pragma unroll
  for (int q = 0; q < 8; ++q) {
    const int idx = tid + 256 * q, tok = idx >> 4, ch = idx & 15;
    wreg[q] = *(const u32x4*)(p.WpT + (size_t)(l * 4 + g) * 128 * 128 + (size_t)tok * 128 + ch * 8);
  }
  {
    const bf16_t* up = p.Pm + (size_t)seq0 * PMW + C_U + g * 128;
    u32x4 uv[9];
#pragma unroll
    for (int q = 0; q < 9; ++q) {
      const int idx = tid + 256 * q, urow = idx >> 4, ch = idx & 15, tt = t0 - 8 + urow;
      uv[q] = (u32x4){0u, 0u, 0u, 0u};
      if (tt >= 0 && tt < n) uv[q] = *(const u32x4*)(up + (size_t)tt * PMW + ch * 8);
    }
#pragma unroll
    for (int q = 0; q < 9; ++q) { const int idx = tid + 256 * q; *(u32x4*)(ut + (idx >> 4) * 256 + (idx & 15) * 16) = uv[q]; }
  }
  __syncthreads();
#pragma unroll 2
  for (int q = 0; q < 8; ++q) {
    const int idx = tid + 256 * q, tok = idx >> 4, ch = idx & 15;
    const int t = t0 + tok;
    const int lo = t - left < 0 ? 0 : t - left, hi = t + right + 1 > n ? n : t + right + 1;
    float sm[8] = {0.f, 0.f, 0.f, 0.f, 0.f, 0.f, 0.f, 0.f};
    const char* ub = ut + (tok + 8 - left) * 256 + ch * 16;
#pragma unroll
    for (int d = 0; d < 16; ++d) {
      if (d < wnd) {
        const u32x4 v = *(const u32x4*)(ub + d * 256);
#pragma unroll
        for (int e = 0; e < 4; ++e) { sm[2 * e] += bflo(v[e]); sm[2 * e + 1] += bfhi(v[e]); }
      }
    }
    const u32x4 sv = *(const u32x4*)(ut + (tok + 8) * 256 + ch * 16);
    const float ic = 1.f / (float)(hi - lo);
    u32x4 o;
#pragma unroll
    for (int e = 0; e < 4; ++e) o[e] = pack2(sm[2 * e] * ic - bflo(sv[e]), sm[2 * e + 1] * ic - bfhi(sv[e]));
    *(u32x4*)(smem + (ch >> 3) * TILEB + tok * TROW + (ch & 7) * 16) = o;
  }
  __syncthreads();
#pragma unroll
  for (int q = 0; q < 8; ++q) {
    const int idx = tid + 256 * q, tok = idx >> 4, ch = idx & 15;
    *(u32x4*)(smem + (2 + (ch >> 3)) * TILEB + tok * TROW + (ch & 7) * 16) = wreg[q];
  }
  __syncthreads();
  f32x16 acc[2][2]; zero_acc22(acc);
  const int aoff = (64 * wm + r) * TROW + 16 * h;
  const int boff = 2 * TILEB + (64 * wn + r) * TROW + 16 * h;
#pragma unroll
  for (int kt = 0; kt < 2; ++kt) {
    const char* cur = smem + kt * TILEB;
#pragma unroll
    for (int t = 0; t < 4; ++t) {
      const bf16x8 a0 = *(const bf16x8*)(cur + aoff + 32 * t);
      const bf16x8 a1 = *(const bf16x8*)(cur + aoff + 32 * TROW + 32 * t);
      const bf16x8 b0 = *(const bf16x8*)(cur + boff + 32 * t);
      const bf16x8 b1 = *(const bf16x8*)(cur + boff + 32 * TROW + 32 * t);
      acc[0][0] = MFMA(b0, a0, acc[0][0]); acc[0][1] = MFMA(b1, a0, acc[0][1]);
      acc[1][0] = MFMA(b0, a1, acc[1][0]); acc[1][1] = MFMA(b1, a1, acc[1][1]);
    }
  }
  __syncthreads();
  const float* ps = p.pool_scale + l * 512 + g * 128 + 64 * wn;
#pragma unroll
  for (int i = 0; i < 2; ++i) {
    bf16_t* zrow = p.Pm + (size_t)(row0 + 64 * wm + 32 * i + r) * PMW + C_ZP + g * 128 + 64 * wn;
#pragma unroll
    for (int j = 0; j < 2; ++j)
#pragma unroll
      for (int g4 = 0; g4 < 4; ++g4) {
        const int c0 = 32 * j + 8 * g4 + 4 * h;
        const u32x2 z = *(const u32x2*)(zrow + c0);
        const f32x4 sc = *(const f32x4*)(ps + c0);
        const float o0 = acc[i][j][4 * g4] * sc[0] * bflo(z[0]), o1 = acc[i][j][4 * g4 + 1] * sc[1] * bfhi(z[0]);
        const float o2 = acc[i][j][4 * g4 + 2] * sc[2] * bflo(z[1]), o3 = acc[i][j][4 * g4 + 3] * sc[3] * bfhi(z[1]);
        u32x2 pk = {pack2(o0, o1), pack2(o2, o3)};
        *(u32x2*)(zrow + c0) = pk;
      }
  }
}

DI void phase3(const Params& p, int l, char* smem_all) {
  const int nD = 256, nG = 512, nCD = l == 0 ? 16 : 0, nCG = l == 0 ? 32 : 0;
  const int e1 = nD, e2 = e1 + nG, e3 = e2 + nCD, e4 = e3 + nCG;
  for (int i = blockIdx.x; i < e4; i += gridDim.x) {
    if (i < e1) { const int x = i & 7, j = i >> 3, bh = x + 8 * (j >> 4), qb = j & 15; diff_unit2(p, l, bh >> 2, bh & 3, (bh >> 2) * 8192 + qb * 512, smem_all); }
    else if (i < e2) { const int i2 = i - e1, x = i2 & 7, j = i2 >> 3, qb = j & 15, b = x >> 1, qh = (x & 1) * 4 + (j >> 4); gqa_unit2(p, l, b, qh, b * 8192 + qb * 512, smem_all); }
    else if (i < e3) { const int i3 = i - e2, b = i3 >> 2, hh = i3 & 3; diff_unit(p, l, b, hh, NLAT + b * 256, 256, smem_all); }
    else { const int i4 = i - e3, b = i4 >> 3, qh = i4 & 7; gqa_unit(p, l, b, qh, NLAT + b * 256, 256, smem_all); }
  }
  const int grp = get_tid() >> 8;
  char* smem = smem_all + grp * GRP_SMEM;
  const int nPool = (l == 0 ? 264 : 256) * 4;
  for (int k = blockIdx.x; 2 * k < nPool; k += gridDim.x) {
    const int i5 = 2 * k + grp;
    pool_unit(p, l, i5 >> 2, i5 & 3, smem);
  }
}

DI void gemm_kloop4(f32x16 (&acc)[2][2], const bf16_t* __restrict__ A, int lda, const bf16_t* __restrict__ Bt, int ldb, int K, char* smem) {
  const int tid = get_tid() & 255, lane = tid & 63, w = tid >> 6, wm = w >> 1, wn = w & 1, r = lane & 31, h = lane >> 5;
  const int srow = tid >> 3, sch = tid & 7;
  const unsigned ago = (unsigned)(srow * lda + sch * 8) * 2u, bgo = (unsigned)(srow * ldb + sch * 8) * 2u;
  const unsigned astep = (unsigned)lda * 64u, bstep = (unsigned)ldb * 64u;
  const char* Ab = (const char*)A; const char* Bb = (const char*)Bt;
  const int soff = srow * TROW + sch * 16;
  u32x4 ra[4], rb[4];
#pragma unroll
  for (int q = 0; q < 4; ++q) { ra[q] = *(const u32x4*)(Ab + (ago + q * astep)); rb[q] = *(const u32x4*)(Bb + (bgo + q * bstep)); }
#pragma unroll
  for (int q = 0; q < 4; ++q) { *(u32x4*)(smem + soff + q * 32 * TROW) = ra[q]; *(u32x4*)(smem + TILEB + soff + q * 32 * TROW) = rb[q]; }
  __syncthreads();
  const int nk = K >> 6;
  const int aoff = (64 * wm + r) * TROW + 16 * h;
  const int boff = TILEB + (64 * wn + r) * TROW + 16 * h;
#pragma unroll 1
  for (int kt = 0; kt < nk; ++kt) {
    const char* cur = smem + (kt & 1) * (2 * TILEB);
    if (kt + 1 < nk) {
#pragma unroll
      for (int q = 0; q < 4; ++q) {
        ra[q] = *(const u32x4*)(Ab + (ago + q * astep + (unsigned)(kt + 1) * 128u));
        rb[q] = *(const u32x4*)(Bb + (bgo + q * bstep + (unsigned)(kt + 1) * 128u));
      }
    }
#pragma unroll
    for (int t = 0; t < 4; ++t) {
      const bf16x8 a0 = *(const bf16x8*)(cur + aoff + 32 * t);
      const bf16x8 a1 = *(const bf16x8*)(cur + aoff + 32 * TROW + 32 * t);
      const bf16x8 b0 = *(const bf16x8*)(cur + boff + 32 * t);
      const bf16x8 b1 = *(const bf16x8*)(cur + boff + 32 * TROW + 32 * t);
      acc[0][0] = MFMA(b0, a0, acc[0][0]); acc[0][1] = MFMA(b1, a0, acc[0][1]);
      acc[1][0] = MFMA(b0, a1, acc[1][0]); acc[1][1] = MFMA(b1, a1, acc[1][1]);
    }
    if (kt + 1 < nk) {
      char* nxt = smem + ((kt + 1) & 1) * (2 * TILEB);
#pragma unroll
      for (int q = 0; q < 4; ++q) { *(u32x4*)(nxt + soff + q * 32 * TROW) = ra[q]; *(u32x4*)(nxt + TILEB + soff + q * 32 * TROW) = rb[q]; }
    }
    __syncthreads();
  }
}

DI void ctx_p4_tile(const Params& p, int l, int mt, int pn, char* smem) {
  const int tid = get_tid() & 255, lane = tid & 63, w = tid >> 6, wm = w >> 1, wn = w & 1, r = lane & 31, h = lane >> 5;
  const int m0 = NLAT + mt * 128, n0 = pn * 128;
  const bf16_t* W = p.WinT + (size_t)l * 7424 * 1024;
  char* yb = (char*)(p.y + (size_t)m0 * 1024 + n0);
  unsigned lo = (unsigned)((64 * wm + r) * 1024 + 64 * wn + 4 * h) * 2u;
  asm volatile("" : "+v"(lo));
#pragma unroll 1
  for (int i = 0; i < 3; ++i) {
    unsigned gpk[2][2][8];
    {
      f32x16 acc[2][2]; zero_acc22(acc);
      gemm_kloop4(acc, p.h + (size_t)m0 * 1024, 1024, W + (size_t)(4352 + i * 1024 + n0) * 1024, 1024, 1024, smem);
#pragma unroll
      for (int a = 0; a < 2; ++a)
#pragma unroll
        for (int c = 0; c < 2; ++c)
#pragma unroll
          for (int e = 0; e < 8; ++e) gpk[a][c][e] = pack2(fast_sigmoid(acc[a][c][2 * e]), fast_sigmoid(acc[a][c][2 * e + 1]));
    }
    f32x16 acc[2][2]; zero_acc22(acc);
    const int zc = i == 0 ? C_ZP : (i == 1 ? C_ZD : C_ZG);
    gemm_kloop4(acc, p.Pm + (size_t)m0 * PMW + zc, PMW, p.WbT + ((size_t)(l * 3 + i) * 1024 + n0) * 512, 512, 512, smem);
#pragma unroll
    for (int a = 0; a < 2; ++a)
#pragma unroll
      for (int c = 0; c < 2; ++c) {
#pragma unroll
        for (int g4 = 0; g4 < 4; ++g4) {
          const unsigned o = lo + (unsigned)(((32 * a) * 1024 + 32 * c + 8 * g4) * 2);
          u32x2 y = {0u, 0u};
          if (i > 0) y = *(const u32x2*)(yb + o);
          const unsigned g0 = gpk[a][c][2 * g4], g1 = gpk[a][c][2 * g4 + 1];
          u32x2 out = {pack2(bflo(y[0]) + bflo(g0) * acc[a][c][4 * g4], bfhi(y[0]) + bfhi(g0) * acc[a][c][4 * g4 + 1]),
                       pack2(bflo(y[1]) + bflo(g1) * acc[a][c][4 * g4 + 2], bfhi(y[1]) + bfhi(g1) * acc[a][c][4 * g4 + 3])};
          *(u32x2*)(yb + o) = out;
        }
        asm volatile("" ::: "memory");
      }
  }
}

DI void ctx_p5_tile(const Params& p, int l, int mt, int pn, char* smem) {
  const int tid = get_tid() & 255, lane = tid & 63, w = tid >> 6, wm = w >> 1, wn = w & 1, r = lane & 31, h = lane >> 5;
  const int m0 = NLAT + mt * 128, n0 = pn * 128;
  f32x16 acc[2][2]; zero_acc22(acc);
  gemm_kloop4(acc, p.y + (size_t)m0 * 1024, 1024, p.WoT + ((size_t)l * 1024 + n0) * 1024, 1024, 1024, smem);
  const char* srcb = (const char*)(p.ctx + (size_t)(mt * 128) * 1024 + n0);
  char* dstb = (char*)(p.xc1 + (size_t)(mt * 128) * 1024 + n0);
  const float* gate = p.mod + (l * 5 + 4) * 3072 + 2048 + n0 + 64 * wn + 4 * h;
  unsigned lo = (unsigned)((64 * wm + r) * 1024 + 64 * wn + 4 * h) * 4u;
  asm volatile("" : "+v"(lo));
#pragma unroll
  for (int a = 0; a < 2; ++a)
#pragma unroll
    for (int c = 0; c < 2; ++c) {
#pragma unroll
      for (int g4 = 0; g4 < 4; ++g4) {
        const unsigned o = lo + (unsigned)(((32 * a) * 1024 + 32 * c + 8 * g4) * 4);
        const f32x4 xv = *(const f32x4*)(srcb + o);
        const f32x4 gt = *(const f32x4*)(gate + 32 * c + 8 * g4);
        const f32x4 av = {acc[a][c][4 * g4], acc[a][c][4 * g4 + 1], acc[a][c][4 * g4 + 2], acc[a][c][4 * g4 + 3]};
        *(f32x4*)(dstb + o) = xv + gt * av;
      }
      asm volatile("" ::: "memory");
    }
}

DI void ctx_small_phase(const Params& p, int l, char* smem_all, bool is5) {
  const int grp = get_tid() >> 8;
  char* smem = smem_all + grp * GRP_SMEM;
  for (int k = blockIdx.x; 2 * k < 64; k += gridDim.x) {
    const int t = 2 * k + grp;
    if (is5) ctx_p5_tile(p, l, t >> 3, t & 7, smem); else ctx_p4_tile(p, l, t >> 3, t & 7, smem);
  }
}

struct Sched4 {
  TileWalk tw; const char* h; const char* W; const char* Pm; const char* Wb;
  DI bool next(int i, g8::Unit& u) const {
    const int ti = i / 6, s = i - 6 * ti, i3 = s >> 1;
    int mt, pn2;
    if (!tw.at(ti, mt, pn2)) return false;
    if ((s & 1) == 0) {
      u.A = h + (size_t)mt * 256 * 2048; u.lda2 = 2048; u.B = W + (size_t)(4352 + i3 * 1024 + pn2 * 256) * 2048; u.ldb2 = 2048; u.nt = 16; u.kind = 0;
    } else {
      const int zc = i3 == 0 ? C_ZP : (i3 == 1 ? C_ZD : C_ZG);
      u.A = Pm + ((size_t)mt * 256 * PMW + zc) * 2; u.lda2 = PMW * 2; u.B = Wb + (size_t)(i3 * 1024 + pn2 * 256) * 1024; u.ldb2 = 1024; u.nt = 8; u.kind = 1;
    }
    u.i0 = mt; u.i1 = pn2; u.i2 = i3;
    return true;
  }
};
struct Epi4 {
  const Params& p; char* gbase; unsigned goff;
  DI void operator()(const f32x4 (&acc)[2][2][4][2], const g8::Unit& u, int wr, int wc, int fr, int fq) const {
    unsigned go = goff; asm volatile("" : "+v"(go));
    if (u.kind == 0) {
#pragma unroll
      for (int ai = 0; ai < 2; ++ai)
#pragma unroll
        for (int bj = 0; bj < 2; ++bj) {
#pragma unroll
          for (int m = 0; m < 4; ++m) {
            const f32x4 a0 = acc[ai][bj][m][0], a1 = acc[ai][bj][m][1];
            u32x4 g = {pack2(fast_sigmoid(a0[0]), fast_sigmoid(a0[1])), pack2(fast_sigmoid(a0[2]), fast_sigmoid(a0[3])),
                       pack2(fast_sigmoid(a1[0]), fast_sigmoid(a1[1])), pack2(fast_sigmoid(a1[2]), fast_sigmoid(a1[3]))};
            *(u32x4*)(gbase + (go + (unsigned)((((ai * 2 + bj) * 4 + m) * 4) * 4))) = g;
          }
          asm volatile("" ::: "memory"); __builtin_amdgcn_sched_barrier(0);
        }
    } else {
      const int i3 = u.i2;
      bf16_t* dst = p.y + (size_t)(u.i0 * 256 + 64 * wr + fr) * 1024 + u.i1 * 256 + 32 * wc + 4 * fq;
#pragma unroll
      for (int ai = 0; ai < 2; ++ai) {
        u32x4 g[2][4], y[2][4];
#pragma unroll
        for (int bj = 0; bj < 2; ++bj)
#pragma unroll
          for (int m = 0; m < 4; ++m) {
            g[bj][m] = *(const u32x4*)(gbase + (go + (unsigned)((((ai * 2 + bj) * 4 + m) * 4) * 4)));
            y[bj][m] = (u32x4){0u, 0u, 0u, 0u};
            if (i3 > 0) y[bj][m] = *(const u32x4*)(gbase + (go + (unsigned)((64 + ((ai * 2 + bj) * 4 + m) * 4) * 4)));
          }
#pragma unroll
        for (int bj = 0; bj < 2; ++bj)
#pragma unroll
          for (int m = 0; m < 4; ++m) {
            const f32x4 a0 = acc[ai][bj][m][0], a1 = acc[ai][bj][m][1];
            const u32x4 gg = g[bj][m], yy = y[bj][m];
            u32x4 o = {pack2(bflo(yy[0]) + bflo(gg[0]) * a0[0], bfhi(yy[0]) + bfhi(gg[0]) * a0[1]), pack2(bflo(yy[1]) + bflo(gg[1]) * a0[2], bfhi(yy[1]) + bfhi(gg[1]) * a0[3]),
                       pack2(bflo(yy[2]) + bflo(gg[2]) * a1[0], bfhi(yy[2]) + bfhi(gg[2]) * a1[1]), pack2(bflo(yy[3]) + bflo(gg[3]) * a1[2], bfhi(yy[3]) + bfhi(gg[3]) * a1[3])};
            if (i3 < 2) *(u32x4*)(gbase + (go + (unsigned)((64 + ((ai * 2 + bj) * 4 + m) * 4) * 4))) = o;
            else {
              bf16_t* d = dst + (size_t)(128 * ai + 16 * m) * 1024 + 128 * bj;
              u32x2 o0 = {o[0], o[1]}, o1 = {o[2], o[3]};
              *(u32x2*)(d) = o0; *(u32x2*)(d + 16) = o1;
            }
          }
        asm volatile("" ::: "memory"); __builtin_amdgcn_sched_barrier(0);
      }
    }
  }
};

DI void phase4(const Params& p, int l, char* smem) {
  Sched4 S; S.tw.init(128, 4); S.h = (const char*)p.h; S.W = (const char*)(p.WinT + (size_t)l * 7424 * 1024);
  S.Pm = (const char*)p.Pm; S.Wb = (const char*)(p.WbT + (size_t)l * 3 * 1024 * 512);
  Epi4 E{p, (char*)(p.gsc + (size_t)blockIdx.x * 512 * 128), (unsigned)get_tid() * 512u};
  g8::gemm_phase<false>(smem, S, E);
  if (l == 0) ctx_small_phase(p, l, smem, false);
}

struct Sched5 {
  TileWalk tw; const char* y; const char* Wo;
  DI bool next(int i, g8::Unit& u) const {
    int mt, pn2;
    if (!tw.at(i, mt, pn2)) return false;
    u.A = y + (size_t)mt * 256 * 2048; u.lda2 = 2048; u.B = Wo + (size_t)pn2 * 256 * 2048; u.ldb2 = 2048; u.nt = 16;
    u.kind = 0; u.i0 = mt; u.i1 = pn2; u.i2 = 0;
    return true;
  }
};
struct Epi5 {
  const Params& p; int l;
  DI void operator()(const f32x4 (&acc)[2][2][4][2], const g8::Unit& u, int wr, int wc, int fr, int fq) const {
    const int mt = u.i0, row0 = mt * 256, col0 = u.i1 * 256 + 32 * wc + 4 * fq;
    const bool isctx = mt >= 128;
    const float* xlat = l == 0 ? p.x : p.out;
    const float* src = (isctx ? p.ctx + (size_t)(row0 - NLAT) * 1024 : xlat + (size_t)row0 * 1024) + (size_t)(64 * wr + fr) * 1024 + col0;
    float* dst = (isctx ? p.xc1 + (size_t)(row0 - NLAT) * 1024 : p.out + (size_t)row0 * 1024) + (size_t)(64 * wr + fr) * 1024 + col0;
    const float* gate = p.mod + (l * 5 + (isctx ? 4 : (mt >> 5))) * 3072 + 2048 + col0;
    f32x4 gt[2][2];
#pragma unroll
    for (int bj = 0; bj < 2; ++bj)
#pragma unroll
      for (int n = 0; n < 2; ++n) gt[bj][n] = *(const f32x4*)(gate + 128 * bj + 16 * n);
#pragma unroll
    for (int ai = 0; ai < 2; ++ai) {
      f32x4 xv[4][2][2];
#pragma unroll
      for (int m = 0; m < 4; ++m)
#pragma unroll
        for (int bj = 0; bj < 2; ++bj)
#pragma unroll
          for (int n = 0; n < 2; ++n) xv[m][bj][n] = *(const f32x4*)(src + (size_t)(128 * ai + 16 * m) * 1024 + 128 * bj + 16 * n);
#pragma unroll
      for (int m = 0; m < 4; ++m)
#pragma unroll
        for (int bj = 0; bj < 2; ++bj)
#pragma unroll
          for (int n = 0; n < 2; ++n) *(f32x4*)(dst + (size_t)(128 * ai + 16 * m) * 1024 + 128 * bj + 16 * n) = xv[m][bj][n] + gt[bj][n] * acc[ai][bj][m][n];
      asm volatile("" ::: "memory"); __builtin_amdgcn_sched_barrier(0);
    }
  }
};

DI void phase5(const Params& p, int l, char* smem) {
  Sched5 S; S.tw.init(128, 4); S.y = (const char*)p.y; S.Wo = (const char*)(p.WoT + (size_t)l * 1024 * 1024);
  Epi5 E{p, l};
  g8::gemm_phase<false>(smem, S, E);
  if (l == 0) ctx_small_phase(p, l, smem, true);
}

DI void grid_barrier(unsigned* ctr, unsigned k) {
  __syncthreads();
  if (threadIdx.x == 0) {
    __builtin_amdgcn_fence(__ATOMIC_RELEASE, "agent");
    asm volatile("s_waitcnt vmcnt(0)" ::: "memory");
    const unsigned members = gridDim.x >> 3;
    const unsigned old = __hip_atomic_fetch_add(ctr + 32 * (1 + (get_bid() & 7)), 1u, __ATOMIC_RELAXED, __HIP_MEMORY_SCOPE_AGENT);
    if (old == k * members - 1u) __hip_atomic_fetch_add(ctr, 1u, __ATOMIC_RELAXED, __HIP_MEMORY_SCOPE_AGENT);
    while (__hip_atomic_load(ctr, __ATOMIC_RELAXED, __HIP_MEMORY_SCOPE_AGENT) < 8u * k) __builtin_amdgcn_s_sleep(1);
    __builtin_amdgcn_fence(__ATOMIC_ACQUIRE, "agent");
    asm volatile("s_waitcnt vmcnt(0)" ::: "memory");
  }
  __syncthreads();
}

#ifndef PROBE_SEL
#define PROBE_SEL -1
#endif
__global__ void __launch_bounds__(512, 2) fwd_kernel(Params p, int ph0, int ph1) {
  __shared__ __attribute__((aligned(16))) char smem[SMEM_BYTES];
  cg::grid_group grid = cg::this_grid();
  unsigned long long t_prev = PROBE_SEL >= 0 ? __builtin_amdgcn_s_memrealtime() : 0ull, t_sel = 0;
  for (int ph = ph0; ph < ph1; ++ph) {
    if (ph == 0) phase0(p, smem);
    else {
      const int l = (ph - 1) / 5, s = (ph - 1) % 5;
      if (s == 0) phase1(p, l);
      else if (s == 1) phase2(p, l, smem);
      else if (s == 2) phase3(p, l, smem);
      else if (s == 3) phase4(p, l, smem);
      else phase5(p, l, smem);
    }
    if (ph + 1 < ph1) {
      if (ph1 > 64) grid.sync();
      else grid_barrier(p.bar, (unsigned)(ph - ph0 + 1));
    }
    if (PROBE_SEL >= 0) {
      const unsigned long long t_now = __builtin_amdgcn_s_memrealtime();
      const int slot = ph == 0 ? 0 : 1 + (ph - 1) % 5;
      if (slot == PROBE_SEL) t_sel += t_now - t_prev;
      t_prev = t_now;
    }
  }
  if (PROBE_SEL >= 0 && blockIdx.x == 0 && threadIdx.x == 0) {
    const unsigned long long t0 = __builtin_amdgcn_s_memrealtime();
    while (__builtin_amdgcn_s_memrealtime() - t0 < t_sel) __builtin_amdgcn_s_sleep(8);
  }
}

extern "C" void kernel_launch(void* const* d_in, const int* in_sizes, int n_in, void* d_out, int out_size,
                              void* d_ws, size_t ws_size, hipStream_t stream) {
  static int grid_blocks = 0;
  if (!grid_blocks) {
    int dev = 0, cus = 0, per_cu = 0;
    (void)hipGetDevice(&dev);
    (void)hipDeviceGetAttribute(&cus, hipDeviceAttributeMultiprocessorCount, dev);
    (void)hipOccupancyMaxActiveBlocksPerMultiprocessor(&per_cu, fwd_kernel, 512, 0);
    if (per_cu > 1) per_cu = 1;
    if (per_cu < 1) per_cu = 1;
    grid_blocks = (cus * per_cu) & ~7;
  }
  Params p{};
  p.x = (const float*)d_in[0]; p.c = (const float*)d_in[1]; p.ctx = (const float*)d_in[2]; p.c_ctx = (const float*)d_in[3];
  p.ada_w = (const float*)d_in[4]; p.ada_b = (const float*)d_in[5]; p.norm_g = (const float*)d_in[6]; p.w_in = (const float*)d_in[7];
  p.pool_w = (const float*)d_in[8]; p.pool_scale = (const float*)d_in[9]; p.dqn = (const float*)d_in[10]; p.dkn = (const float*)d_in[11];
  p.dlam = (const float*)d_in[12]; p.dsub = (const float*)d_in[13]; p.gqn = (const float*)d_in[14]; p.gkn = (const float*)d_in[15];
  p.w_branch = (const float*)d_in[16]; p.w_out = (const float*)d_in[17];
  p.out = (float*)d_out;
  char* ws = (char*)d_ws; size_t off = 0;
  auto take = [&](size_t bytes) { char* q = ws + off; off += (bytes + 255) & ~(size_t)255; return q; };
  p.mod = (float*)take(2 * 5 * 3072 * 4);
  p.consts = (float*)take(256);
  p.bar = (unsigned*)take(2048);
  p.WinT = (bf16_t*)take((size_t)2 * 7424 * 1024 * 2);
  p.WbT = (bf16_t*)take((size_t)2 * 3 * 1024 * 512 * 2);
  p.WoT = (bf16_t*)take((size_t)2 * 1024 * 1024 * 2);
  p.WpT = (bf16_t*)take((size_t)2 * 4 * 128 * 128 * 2);
  p.h = (bf16_t*)take((size_t)NTOK * 1024 * 2);
  p.y = (bf16_t*)take((size_t)NTOK * 1024 * 2);
  p.Pm = (bf16_t*)take((size_t)NTOK * PMW * 2);
  p.DK = (bf16_t*)take((size_t)4 * NKEY * 512 * 2);
  p.DVt = (bf16_t*)take((size_t)4 * NKEY * 512 * 2);
  p.GK = (bf16_t*)take((size_t)4 * NKEY * 128 * 2);
  p.GVt = (bf16_t*)take((size_t)4 * NKEY * 128 * 2);
  p.xc1 = (float*)take((size_t)1024 * 1024 * 4);
  p.gsc = (unsigned*)p.DK;
  p.stash = (float*)p.y;
  if (off > ws_size) { fprintf(stderr, "workspace too small: need %zu have %zu\n", off, ws_size); return; }
#if MULTI_LAUNCH
  for (int ph = 0; ph < 11; ++ph) hipLaunchKernelGGL(fwd_kernel, dim3(grid_blocks), dim3(512), 0, stream, p, ph, ph + 1);
#else
  (void)hipMemsetAsync(p.bar, 0, 2048, stream);
  int ph0 = 0, ph1 = 11;
  void* args[] = {&p, &ph0, &ph1};
  hipError_t e = hipLaunchCooperativeKernel((void*)fwd_kernel, dim3(grid_blocks), dim3(512), args, 0, stream);
  if (e != hipSuccess) fprintf(stderr, "cooperative launch failed: %s (grid %d)\n", hipGetErrorString(e), grid_blocks);
#endif
}
```

```cpp
#include <hip/hip_runtime.h>
#include <hip/hip_cooperative_groups.h>
#include <cstdio>
namespace cg = cooperative_groups;

typedef unsigned short bf16_t;
typedef short bf16x8 __attribute__((ext_vector_type(8)));
typedef float f32x16 __attribute__((ext_vector_type(16)));
typedef float f32x4 __attribute__((ext_vector_type(4)));
typedef float f32x2 __attribute__((ext_vector_type(2)));
typedef unsigned u32x4 __attribute__((ext_vector_type(4)));
typedef unsigned u32x2 __attribute__((ext_vector_type(2)));
typedef __bf16 bf16v2 __attribute__((ext_vector_type(2)));

#define DI __device__ __forceinline__
#define MFMA(a, b, c) __builtin_amdgcn_mfma_f32_32x32x16_bf16((a), (b), (c), 0, 0, 0)

#ifndef MULTI_LAUNCH
#define MULTI_LAUNCH 0
#endif

constexpr int NLAT = 32768, NTOK = 33792, NKEY = 8448;
constexpr int PMW = 3072;
constexpr int C_U = 0, C_ZP = 512, C_DQ = 1024, C_ZD = 1536, C_GQ = 2048, C_ZG = 2560;
constexpr int TROW = 144;
constexpr int TILEB = 128 * TROW;
constexpr int TILE256 = 256 * TROW;
constexpr int STAGE8 = 2 * TILE256;
constexpr int SMEM_BYTES = 2 * STAGE8;
constexpr int GRP_SMEM = STAGE8;
constexpr int ABUF = 64 * TROW + 128 * TROW;
constexpr float LOG2E = 1.4426950408889634f;

struct Params {
  const float *x, *c, *ctx, *c_ctx, *ada_w, *ada_b, *norm_g, *w_in, *pool_w, *pool_scale, *dqn, *dkn, *dlam, *dsub, *gqn, *gkn, *w_branch, *w_out;
  float* out;
  float* mod;
  float* consts;
  bf16_t *WinT, *WbT, *WoT, *WpT, *h, *y, *Pm, *DK, *DVt, *GK, *GVt;
  float* xc1;
  float* stash;
  unsigned* gsc;
  unsigned* bar;
};

DI unsigned pack2(float a, float b) { f32x2 v = {a, b}; bf16v2 r = __builtin_convertvector(v, bf16v2); return __builtin_bit_cast(unsigned, r); }
DI bf16_t f2bf(float a) { return (bf16_t)(pack2(a, a) & 0xffffu); }
DI float bf2f(unsigned v) { return __uint_as_float(v << 16); }
DI float bflo(unsigned v) { return __uint_as_float(v << 16); }
DI float bfhi(unsigned v) { return __uint_as_float(v & 0xffff0000u); }
DI float fast_sigmoid(float v) { return __builtin_amdgcn_rcpf(1.f + __expf(-v)); }
DI float fast_silu(float v) { return v * fast_sigmoid(v); }
DI float wave_sum(float v) {
#pragma unroll
  for (int o = 32; o >= 1; o >>= 1) v += __shfl_xor(v, o);
  return v;
}
DI float wave_max(float v) {
#pragma unroll
  for (int o = 32; o >= 1; o >>= 1) v = fmaxf(v, __shfl_xor(v, o));
  return v;
}
DI int get_tid() { int t = threadIdx.x; asm volatile("" : "+v"(t)); return t; }
template <typename T> DI const T* opaque(const T* q) { asm volatile("" : "+s"(q)); return q; }
DI int get_bid() { int b = blockIdx.x; asm volatile("" : "+s"(b)); return b; }
DI int crow(int reg, int h) { return (reg & 3) + 8 * (reg >> 2) + 4 * h; }

namespace g8 {
#define G8_LAS __attribute__((address_space(3)))
constexpr int BK = 64, HALF = 128, HTB = HALF * BK * 2, STAGE_BYTES = 8 * HTB;
DI int lds_byte(int r, int c) { const int st = (r >> 4) * 2 + (c >> 5), rr = r & 15, cc = c & 31, ob = rr * 64 + cc * 2; return st * 1024 + (ob ^ (((ob >> 9) & 1) << 5)); }
DI void stage_rc(int b, int& R, int& C) { const int st = b / 1024, sb = b % 1024, swz = sb ^ (((sb >> 9) & 1) << 5); R = (st >> 1) * 16 + swz / 64; C = (st & 1) * 32 + (swz % 64) / 2; }

struct Unit {
  const char* A; const char* B;
  int lda2, ldb2;
  int nt;
  int kind, i0, i1, i2;
};

template <bool SIGMA, class Sched, class Epi>
DI void gemm_phase(char* smem, const Sched& S, const Epi& E) {
  G8_LAS unsigned char* lds = (G8_LAS unsigned char*)smem;
  const int tid = get_tid(), wid = __builtin_amdgcn_readfirstlane(tid >> 6), lane = tid & 63, wr = wid >> 2, wc = wid & 3, fr = lane & 15, fq = lane >> 4;
  int Rn[2], Rb[2], C2[2];
#pragma unroll
  for (int i = 0; i < 2; ++i) { int R, C; stage_rc(tid * 16 + i * 8192, R, C); Rn[i] = R; Rb[i] = SIGMA ? 64 * (R >> 5) + (R & 31) : R; C2[i] = C * 2; }
  const unsigned ldsw = (unsigned)wid * 1024u;
  const int aoff = lds_byte(wr * 64 + fr, fq * 8), boff = lds_byte(wc * 32 + fr, fq * 8);
#define G8_SA(b, h) (((b) * 2 + (h)) * HTB)
#define G8_SB(b, h) ((4 + (b) * 2 + (h)) * HTB)
#define G8_STAGE(bufoff, gbase, RR, ld2) do { \
    __builtin_amdgcn_global_load_lds((const unsigned*)((const char*)(gbase) + (unsigned)((RR)[0] * (ld2) + C2[0])), (G8_LAS unsigned*)(lds + (bufoff) + ldsw), 16, 0, 0); \
    __builtin_amdgcn_global_load_lds((const unsigned*)((const char*)(gbase) + (unsigned)((RR)[1] * (ld2) + C2[1])), (G8_LAS unsigned*)(lds + (bufoff) + ldsw + 8192), 16, 0, 0); } while (0)
#define G8_LDA(dst, b, h) do { _Pragma("unroll") for (int m = 0; m < 4; ++m) _Pragma("unroll") for (int k = 0; k < 2; ++k) dst[m][k] = *(const G8_LAS bf16x8*)(lds + G8_SA(b, h) + aoff + m * 2048 + k * 1024); } while (0)
#define G8_LDB(dst, b, h) do { _Pragma("unroll") for (int n = 0; n < 2; ++n) _Pragma("unroll") for (int k = 0; k < 2; ++k) dst[n][k] = *(const G8_LAS bf16x8*)(lds + G8_SB(b, h) + boff + n * 2048 + k * 1024); } while (0)
#define G8_MMA(ai, bj, At, Bt) do { __builtin_amdgcn_s_setprio(1); _Pragma("unroll") for (int m = 0; m < 4; ++m) _Pragma("unroll") for (int n = 0; n < 2; ++n) _Pragma("unroll") for (int k = 0; k < 2; ++k) \
    acc[ai][bj][m][n] = __builtin_amdgcn_mfma_f32_16x16x32_bf16(Bt[n][k], At[m][k], acc[ai][bj][m][n], 0, 0, 0); __builtin_amdgcn_s_setprio(0); } while (0)
#define G8_WAIT_V(n) asm volatile("s_waitcnt vmcnt(" #n ")" ::: "memory")
#define G8_WAIT_L(n) asm volatile("s_waitcnt lgkmcnt(" #n ")" ::: "memory")
#define G8_BAR __builtin_amdgcn_s_barrier()
#define G8_SCHED __builtin_amdgcn_sched_barrier(0)
  Unit cur, nxt; int ui = 0;
  if (!S.next(0, cur)) return;
  f32x4 acc[2][2][4][2];
#pragma unroll
  for (int a = 0; a < 2; ++a)
#pragma unroll
    for (int b = 0; b < 2; ++b)
#pragma unroll
      for (int m = 0; m < 4; ++m)
#pragma unroll
        for (int n = 0; n < 2; ++n) acc[a][b][m][n] = (f32x4){0.f, 0.f, 0.f, 0.f};
  bf16x8 At[4][2], B0[2][2], B1[2][2];
  int lA = cur.lda2, lB = cur.ldb2;
  unsigned hA = (unsigned)(HALF * lA), hB = (unsigned)((SIGMA ? 32 : HALF) * lB);
  const size_t kstep = (size_t)(BK * 2);
  const char* cA = cur.A; const char* cB = cur.B;
  G8_STAGE(G8_SB(0, 0), cB, Rb, lB); G8_STAGE(G8_SA(0, 0), cA, Rn, lA); G8_STAGE(G8_SB(0, 1), cB + hB, Rb, lB); G8_STAGE(G8_SA(0, 1), cA + hA, Rn, lA);
  if (wr == 1) G8_BAR;
  G8_WAIT_V(4); G8_BAR;
  G8_STAGE(G8_SB(1, 0), cB + kstep, Rb, lB); G8_STAGE(G8_SA(1, 0), cA + kstep, Rn, lA); G8_STAGE(G8_SB(1, 1), cB + hB + kstep, Rb, lB);
  G8_WAIT_V(6); G8_BAR;
  for (;;) {
    const bool has_next = S.next(ui + 1, nxt);
    const char* nA = has_next ? nxt.A : cA; const char* nB = has_next ? nxt.B : cB;
    const int nlA = has_next ? nxt.lda2 : lA, nlB = has_next ? nxt.ldb2 : lB;
    const unsigned nhA = (unsigned)(HALF * nlA), nhB = (unsigned)((SIGMA ? 32 : HALF) * nlB);
    const int nt = cur.nt;
    for (int t = 0; t < nt; t += 2) {
      const bool last = (t == nt - 2);
      const char* a1 = cA + (size_t)(t + 1) * kstep;
      const char* a2 = last ? nA : cA + (size_t)(t + 2) * kstep; const char* b2 = last ? nB : cB + (size_t)(t + 2) * kstep;
      const char* a3 = a2 + kstep; const char* b3 = b2 + kstep;
      const int xlA = last ? nlA : lA, xlB = last ? nlB : lB;
      const unsigned xhA = last ? nhA : hA, xhB = last ? nhB : hB;
      G8_LDB(B0, 0, 0); G8_SCHED; G8_LDA(At, 0, 0); G8_STAGE(G8_SA(1, 1), a1 + hA, Rn, lA);
      G8_WAIT_L(8); G8_BAR; G8_WAIT_L(0); G8_MMA(0, 0, At, B0); G8_BAR; G8_SCHED;
      G8_LDB(B1, 0, 1); G8_STAGE(G8_SB(0, 0), b2, Rb, xlB);
      G8_BAR; G8_WAIT_L(0); G8_MMA(0, 1, At, B1); G8_BAR;
      G8_LDA(At, 0, 1); G8_STAGE(G8_SA(0, 0), a2, Rn, xlA);
      G8_BAR; G8_WAIT_L(0); G8_MMA(1, 0, At, B0); G8_BAR; G8_SCHED;
      G8_STAGE(G8_SB(0, 1), b2 + xhB, Rb, xlB);
      G8_WAIT_V(6); G8_BAR; G8_MMA(1, 1, At, B1); G8_BAR;
      G8_LDB(B0, 1, 0); G8_SCHED; G8_LDA(At, 1, 0); G8_STAGE(G8_SA(0, 1), a2 + xhA, Rn, xlA);
      G8_WAIT_L(8); G8_BAR; G8_WAIT_L(0); G8_MMA(0, 0, At, B0); G8_BAR; G8_SCHED;
      G8_LDB(B1, 1, 1); G8_STAGE(G8_SB(1, 0), b3, Rb, xlB);
      G8_BAR; G8_WAIT_L(0); G8_MMA(0, 1, At, B1); G8_BAR;
      G8_LDA(At, 1, 1); G8_STAGE(G8_SA(1, 0), a3, Rn, xlA);
      G8_BAR; G8_WAIT_L(0); G8_MMA(1, 0, At, B0); G8_BAR; G8_SCHED;
      G8_STAGE(G8_SB(1, 1), b3 + xhB, Rb, xlB);
      G8_WAIT_V(6); G8_BAR; G8_MMA(1, 1, At, B1); G8_BAR;
    }
    E(acc, cur, wr, wc, fr, fq);
    if (!has_next) break;
#pragma unroll
    for (int a = 0; a < 2; ++a)
#pragma unroll
      for (int b = 0; b < 2; ++b)
#pragma unroll
        for (int m = 0; m < 4; ++m)
#pragma unroll
          for (int n = 0; n < 2; ++n) acc[a][b][m][n] = (f32x4){0.f, 0.f, 0.f, 0.f};
    cur = nxt; cA = nA; cB = nB; lA = nlA; lB = nlB; hA = nhA; hB = nhB; ++ui;
  }
  G8_WAIT_V(0);
  if (wr == 0) G8_BAR;
  G8_BAR;
#undef G8_SA
#undef G8_SB
#undef G8_STAGE
#undef G8_LDA
#undef G8_LDB
#undef G8_MMA
#undef G8_WAIT_V
#undef G8_WAIT_L
#undef G8_BAR
#undef G8_SCHED
}
}

DI void zero_acc22(f32x16 (&acc)[2][2]) {
#pragma unroll
  for (int i = 0; i < 2; ++i)
#pragma unroll
    for (int j = 0; j < 2; ++j)
#pragma unroll
      for (int e = 0; e < 16; ++e) acc[i][j][e] = 0.f;
}

struct TileWalk {
  int MP, pwf, wlast, nfull, npart, extra, NPf, x, lb, nbx;
  DI void init(int MT, int NT) {
    const int bid = get_bid(); x = bid & 7; lb = bid >> 3; nbx = gridDim.x >> 3;
    MP = MT >> 2;
    if (NT <= 8) { pwf = NT; NPf = 1; wlast = 0; nfull = MP; npart = 0; }
    else { pwf = 8; NPf = NT >> 3; wlast = NT - 8 * NPf; nfull = NPf * MP; npart = wlast ? MP : 0; }
    extra = nfull & 7;
  }
  DI bool at(int it, int& m, int& n) const {
    const int j = lb + it * nbx;
    const int kf = x < nfull ? (nfull - x + 7) >> 3 : 0, tf = 4 * pwf;
    if (j < kf * tf) {
      const int k = j / tf, q = j % tf, id = x + 8 * k, np = id / MP, mp = id % MP;
      m = mp * 4 + (q & 3); n = np * 8 + (q >> 2);
    } else {
      if (npart == 0 || x < extra) return false;
      const int j2 = j - kf * tf, tp = 4 * wlast, pj = (x - extra) + (8 - extra) * (j2 / tp), q = j2 % tp;
      if (pj >= npart) return false;
      m = pj * 4 + (q & 3); n = NPf * 8 + (q >> 2);
    }
    return true;
  }
};

struct TrDesc { const float* src; bf16_t* dst; int N, K; };
DI TrDesc tr_desc(const Params& p, int u) {
  constexpr int PER_L = 1856 + 384 + 256 + 16;
  const int l = u / PER_L; int r = u % PER_L;
  TrDesc d; int kt, nt;
  if (r < 1856) { d.src = p.w_in + (size_t)l * 1024 * 7424; d.N = 7424; d.dst = p.WinT + (size_t)l * 7424 * 1024; d.K = 1024; kt = r / 116; nt = r % 116; }
  else if (r < 2240) { r -= 1856; const int i = r >> 7, r2 = r & 127; d.src = p.w_branch + (size_t)(l * 3 + i) * 512 * 1024; d.N = 1024; d.dst = p.WbT + (size_t)(l * 3 + i) * 1024 * 512; d.K = 512; kt = r2 >> 4; nt = r2 & 15; }
  else if (r < 2496) { r -= 2240; d.src = p.w_out + (size_t)l * 1024 * 1024; d.N = 1024; d.dst = p.WoT + (size_t)l * 1024 * 1024; d.K = 1024; kt = r >> 4; nt = r & 15; }
  else { r -= 2496; const int g = r >> 2; d.src = p.pool_w + (size_t)(l * 4 + g) * 128 * 128; d.N = 128; d.dst = p.WpT + (size_t)(l * 4 + g) * 128 * 128; d.K = 128; kt = (r >> 1) & 1; nt = r & 1; }
  d.src += (size_t)(kt * 64) * d.N + nt * 64;
  d.dst += (size_t)(nt * 64) * d.K + kt * 64;
  return d;
}
DI void tr_load(f32x4 (&v)[2], const TrDesc& d, int tid) {
#pragma unroll
  for (int q = 0; q < 2; ++q) { const int idx = tid + 512 * q, row = idx >> 4, c4 = idx & 15; v[q] = *(const f32x4*)(d.src + (size_t)row * d.N + c4 * 4); }
}
DI void tr_finish(const f32x4 (&v)[2], const TrDesc& d, int tid, char* smem) {
  float* t = (float*)smem;
#pragma unroll
  for (int q = 0; q < 2; ++q) {
    const int idx = tid + 512 * q, row = idx >> 4, c4 = idx & 15;
    t[row * 65 + c4 * 4 + 0] = v[q][0]; t[row * 65 + c4 * 4 + 1] = v[q][1]; t[row * 65 + c4 * 4 + 2] = v[q][2]; t[row * 65 + c4 * 4 + 3] = v[q][3];
  }
  __syncthreads();
  {
    const int jn = tid >> 3, kc = tid & 7;
    u32x4 o;
#pragma unroll
    for (int e = 0; e < 4; ++e) o[e] = pack2(t[(kc * 8 + 2 * e) * 65 + jn], t[(kc * 8 + 2 * e + 1) * 65 + jn]);
    *(u32x4*)(d.dst + (size_t)jn * d.K + kc * 8) = o;
  }
  __syncthreads();
}

DI void phase0(const Params& p, char* smem) {
  const int tid = get_tid(), lane = tid & 63, w = tid >> 6;
  constexpr int PER_L = 1856 + 384 + 256 + 16;
  constexpr int NTR = 2 * PER_L, NADA = 96;
  {
    int u = blockIdx.x; bool have = u < NTR;
    TrDesc d; f32x4 v[2];
    if (have) { d = tr_desc(p, u); tr_load(v, d, tid); }
    while (have) {
      const int un = u + gridDim.x; const bool hn = un < NTR;
      TrDesc dn = d; f32x4 vn[2] = {v[0], v[1]};
      if (hn) { dn = tr_desc(p, un); tr_load(vn, dn, tid); }
      tr_finish(v, d, tid, smem);
      u = un; have = hn; d = dn; v[0] = vn[0]; v[1] = vn[1];
    }
  }
  for (int u = blockIdx.x; u < NTR + NADA + 1; u += gridDim.x) {
    if (u < NTR) {
      continue;
    } else if (u < NTR + NADA) {
      const int a = u - NTR, l = a / 48, n0 = (a % 48) * 64;
      float* s = (float*)smem;
      for (int i = tid; i < 5 * 1024; i += 512) {
        const int rr = i >> 10, k = i & 1023;
        const float v = rr < 4 ? p.c[rr * 1024 + k] : p.c_ctx[k];
        s[i] = v / (1.f + __expf(-v));
      }
      __syncthreads();
      float a5[5] = {0.f, 0.f, 0.f, 0.f, 0.f};
      const float* wp = p.ada_w + (size_t)l * 1024 * 3072 + n0 + lane;
      for (int k0 = w * 128; k0 < w * 128 + 128; k0 += 16) {
        float wv[16];
#pragma unroll
        for (int u = 0; u < 16; ++u) wv[u] = wp[(size_t)(k0 + u) * 3072];
#pragma unroll
        for (int u = 0; u < 16; ++u)
#pragma unroll
          for (int rr = 0; rr < 5; ++rr) a5[rr] += s[rr * 1024 + k0 + u] * wv[u];
      }
      __syncthreads();
      float* part = (float*)smem + 5 * 1024;
#pragma unroll
      for (int rr = 0; rr < 5; ++rr) part[(w * 5 + rr) * 64 + lane] = a5[rr];
      __syncthreads();
      for (int i = tid; i < 5 * 64; i += 512) {
        const int rr = i >> 6, nn = i & 63;
        float v = 0.f;
#pragma unroll
        for (int ww = 0; ww < 8; ++ww) v += part[(ww * 5 + rr) * 64 + nn];
        p.mod[(l * 5 + rr) * 3072 + n0 + nn] = v + p.ada_b[l * 3072 + n0 + nn];
      }
      __syncthreads();
    } else {
      if (w == 0) {
#pragma unroll 1
        for (int l = 0; l < 2; ++l) {
          const float* lp = opaque(p.dlam + l * 256);
          const float s1 = wave_sum(lp[lane] * lp[64 + lane]);
          const float s2 = wave_sum(lp[128 + lane] * lp[192 + lane]);
          const float lam_init = 0.8f - 0.6f * expf(-0.3f * (float)l);
          const float lam = expf(s1) - expf(s2) + lam_init;
          const float mdq = wave_max(fabsf(p.dqn[l * 64 + lane])), mdk = wave_max(fabsf(p.dkn[l * 64 + lane]));
          const float mgq = wave_max(fabsf(p.gqn[l * 64 + lane])), mgk = wave_max(fabsf(p.gkn[l * 64 + lane]));
          if (lane == 0) {
            p.consts[l * 4 + 0] = lam;
            p.consts[l * 4 + 1] = -(LOG2E * 8.f * mdq * mdk);
            p.consts[l * 4 + 2] = -(LOG2E * 8.f * mgq * mgk);
            p.consts[l * 4 + 3] = lam_init;
          }
        }
      }
    }
  }
}

DI void phase1(const Params& p, int l) {
  const int tid = get_tid(), lane = tid & 63, w = tid >> 6;
  const float* xlat = l == 0 ? p.x : p.out;
  const float* xctx = l == 0 ? p.ctx : p.xc1;
  const float* g = p.norm_g + l * 1024;
  f32x4 ma[4], mb[4]; int cur_mr = -1;
  for (int rb = blockIdx.x * 16; rb < NTOK; rb += gridDim.x * 16) {
    const int mr = rb < NLAT ? (rb >> 13) : 4;
    f32x4 v[2][4];
#pragma unroll
    for (int u = 0; u < 2; ++u) {
      const int row = rb + 2 * w + u;
      const float* sp = row < NLAT ? xlat + (size_t)row * 1024 : xctx + (size_t)(row - NLAT) * 1024;
#pragma unroll
      for (int q = 0; q < 4; ++q) v[u][q] = *(const f32x4*)(sp + q * 256 + lane * 4);
    }
    if (mr != cur_mr) {
      cur_mr = mr;
      const float* md = p.mod + (l * 5 + mr) * 3072;
#pragma unroll
      for (int q = 0; q < 4; ++q) {
        const int k = q * 256 + lane * 4;
        const f32x4 gg = *(const f32x4*)(g + k), sc = *(const f32x4*)(md + 1024 + k);
        mb[q] = *(const f32x4*)(md + k);
        ma[q] = gg * (1.f + sc);
      }
    }
    float ss[2];
#pragma unroll
    for (int u = 0; u < 2; ++u) {
      float s2 = 0.f;
#pragma unroll
      for (int q = 0; q < 4; ++q) s2 += v[u][q][0] * v[u][q][0] + v[u][q][1] * v[u][q][1] + v[u][q][2] * v[u][q][2] + v[u][q][3] * v[u][q][3];
      ss[u] = wave_sum(s2);
    }
#pragma unroll
    for (int u = 0; u < 2; ++u) {
      const int row = rb + 2 * w + u;
      const float rstd = __builtin_amdgcn_rsqf(ss[u] * (1.f / 1024.f) + 1e-6f);
#pragma unroll
      for (int q = 0; q < 4; ++q) {
        const int k = q * 256 + lane * 4;
        float o[4];
#pragma unroll
        for (int e = 0; e < 4; ++e) o[e] = v[u][q][e] * rstd * ma[q][e] + mb[q][e];
        u32x2 pk = {pack2(o[0], o[1]), pack2(o[2], o[3])};
        *(u32x2*)(p.h + (size_t)row * 1024 + k) = pk;
      }
    }
  }
}

struct Sched2 {
  TileWalk tw; const char* h; const char* W;
  DI bool next(int i, g8::Unit& u) const {
    int mt, pn2;
    if (!tw.at(i, mt, pn2)) return false;
    u.A = h + (size_t)mt * 256 * 2048; u.B = W + (size_t)pn2 * 256 * 2048; u.lda2 = 2048; u.ldb2 = 2048; u.nt = 16;
    u.kind = 0; u.i0 = mt; u.i1 = pn2; u.i2 = 0;
    return true;
  }
};
struct Epi2 {
  const Params& p; int l;
  DI void operator()(const f32x4 (&acc)[2][2][4][2], const g8::Unit& u, int wr, int wc, int fr, int fq) const {
    const int mt = u.i0, pn2 = u.i1, row0 = mt * 256;
    const bool isctx = mt >= 128;
    const int b = isctx ? (mt - 128) : (mt >> 5);
    const int t0 = isctx ? 0 : (mt & 31) * 256;
    const int key0 = isctx ? 0 : 256 + t0;
    const int pn = 2 * pn2 + (wc >> 1), hc = (wc & 1) * 64;
    const bool plain = pn < 8 || (pn >= 20 && pn < 24) || pn >= 30;
    if (plain) {
      int pcol; bool silu;
      if (pn < 4) { pcol = pn * 128; silu = false; } else if (pn < 8) { pcol = pn * 128; silu = true; }
      else if (pn < 24) { pcol = pn * 128 - 1024; silu = true; } else { pcol = pn * 128 - 1280; silu = true; }
      char* dstb = (char*)(p.Pm + (size_t)row0 * PMW + pcol + hc);
      unsigned lo = (unsigned)((64 * wr + fr) * PMW + 4 * fq) * 2u;
      asm volatile("" : "+v"(lo));
#pragma unroll
      for (int ai = 0; ai < 2; ++ai)
#pragma unroll
        for (int m = 0; m < 4; ++m) {
#pragma unroll
          for (int bj = 0; bj < 2; ++bj)
#pragma unroll
            for (int n = 0; n < 2; ++n) {
              f32x4 v = acc[ai][bj][m][n];
              if (silu) { v[0] = fast_silu(v[0]); v[1] = fast_silu(v[1]); v[2] = fast_silu(v[2]); v[3] = fast_silu(v[3]); }
              u32x2 pk = {pack2(v[0], v[1]), pack2(v[2], v[3])};
              *(u32x2*)(dstb + (lo + (unsigned)(((128 * ai + 16 * m) * PMW + 32 * bj + 16 * n) * 2))) = pk;
            }
          asm volatile("" ::: "memory"); __builtin_amdgcn_sched_barrier(0);
        }
    } else if ((pn >= 16 && pn < 20) || pn == 29) {
      char* dstb = (char*)(pn == 29 ? p.GVt + ((size_t)b * 128 + hc) * NKEY + key0 : p.DVt + ((size_t)b * 512 + (pn - 16) * 128 + hc) * NKEY + key0);
      unsigned lo = (unsigned)((4 * fq) * NKEY + 64 * wr + fr) * 2u;
      asm volatile("" : "+v"(lo));
#pragma unroll
      for (int ai = 0; ai < 2; ++ai)
#pragma unroll
        for (int m = 0; m < 4; ++m) {
#pragma unroll
          for (int bj = 0; bj < 2; ++bj)
#pragma unroll
            for (int n = 0; n < 2; ++n)
#pragma unroll
              for (int j = 0; j < 4; ++j)
                *(bf16_t*)(dstb + (lo + (unsigned)(((32 * bj + 16 * n + j) * NKEY + 128 * ai + 16 * m) * 2))) = f2bf(acc[ai][bj][m][n][j]);
          asm volatile("" ::: "memory"); __builtin_amdgcn_sched_barrier(0);
        }
    } else {
      const float* gn; bf16_t* dst; int ldd; float oscale;
      if (pn < 12) { gn = p.dqn + l * 64; dst = p.Pm + (size_t)row0 * PMW + pn * 128 + hc; ldd = PMW; oscale = LOG2E * 0.125f; }
      else if (pn < 16) { gn = p.dkn + l * 64; dst = p.DK + ((size_t)b * NKEY + key0) * 512 + (pn - 12) * 128 + hc; ldd = 512; oscale = 1.f; }
      else if (pn < 28) { gn = p.gqn + l * 64; dst = p.Pm + (size_t)row0 * PMW + pn * 128 - 1024 + hc; ldd = PMW; oscale = LOG2E * 0.125f; }
      else { gn = p.gkn + l * 64; dst = p.GK + ((size_t)b * NKEY + key0) * 128 + hc; ldd = 128; oscale = 1.f; }
      gn = opaque(gn);
      int fro = fr; asm volatile("" : "+v"(fro));
      float inv[4];
#pragma unroll
      for (int j = 0; j < 4; ++j) inv[j] = __builtin_amdgcn_exp2f((float)(4 * (fro >> 30) + 4 * fq + j) * -0.8304820237218406f);
#pragma unroll
      for (int ai = 0; ai < 2; ++ai)
#pragma unroll
        for (int m = 0; m < 4; ++m) {
          const int tok = 128 * ai + 64 * wr + 16 * m + fro;
          f32x4 y[2][2]; float ss = 0.f;
#pragma unroll
          for (int bj = 0; bj < 2; ++bj)
#pragma unroll
            for (int n = 0; n < 2; ++n) { y[bj][n] = acc[ai][bj][m][n]; ss += y[bj][n][0] * y[bj][n][0] + y[bj][n][1] * y[bj][n][1] + y[bj][n][2] * y[bj][n][2] + y[bj][n][3] * y[bj][n][3]; }
          ss += __shfl_xor(ss, 16); ss += __shfl_xor(ss, 32);
          const float rstd = __builtin_amdgcn_rsqf(ss * (1.f / 64.f) + 1e-6f) ;
#pragma unroll
          for (int bj = 0; bj < 2; ++bj)
#pragma unroll
            for (int n = 0; n < 2; ++n) {
              const f32x4 g4 = *(const f32x4*)(gn + 32 * bj + 16 * n + 4 * fq);
#pragma unroll
              for (int j = 0; j < 4; ++j) y[bj][n][j] *= rstd * g4[j];
            }
          if (!isctx) {
            const int tseq = t0 + tok;
#pragma unroll
            for (int bj = 0; bj < 2; ++bj) {
              const float pos = (float)(bj == 0 ? (tseq >> 6) : (tseq & 63));
#pragma unroll
              for (int j = 0; j < 4; ++j) {
                const float ang = pos * inv[j];
                const float cs = __cosf(ang), sn = __sinf(ang);
                const float x1 = y[bj][0][j], x2 = y[bj][1][j];
                y[bj][0][j] = x1 * cs - x2 * sn; y[bj][1][j] = x1 * sn + x2 * cs;
              }
            }
          }
          const unsigned ro = (unsigned)(tok * ldd + 4 * fq) * 2u;
#pragma unroll
          for (int bj = 0; bj < 2; ++bj)
#pragma unroll
            for (int n = 0; n < 2; ++n) {
              u32x2 pk = {pack2(y[bj][n][0] * oscale, y[bj][n][1] * oscale), pack2(y[bj][n][2] * oscale, y[bj][n][3] * oscale)};
              *(u32x2*)((char*)dst + (ro + (unsigned)((32 * bj + 16 * n) * 2))) = pk;
            }
          asm volatile("" ::: "memory"); __builtin_amdgcn_sched_barrier(0);
        }
    }
  }
};

DI void phase2(const Params& p, int l, char* smem) {
  Sched2 S; S.tw.init(132, 17); S.h = (const char*)p.h; S.W = (const char*)(p.WinT + (size_t)l * 7424 * 1024);
  Epi2 E{p, l};
  g8::gemm_phase<true>(smem, S, E);
}

DI void softmax_step(f32x16& S, float& l0, float& l1, bf16x8 (&pf)[2]) {
#pragma unroll
  for (int e = 0; e < 16; ++e) S[e] = __builtin_amdgcn_exp2f(S[e]);
#pragma unroll
  for (int e = 0; e < 8; ++e) { l0 += S[2 * e]; l1 += S[2 * e + 1]; }
#pragma unroll
  for (int s = 0; s < 2; ++s) {
    u32x4 pk = {pack2(S[8 * s], S[8 * s + 1]), pack2(S[8 * s + 2], S[8 * s + 3]), pack2(S[8 * s + 4], S[8 * s + 5]), pack2(S[8 * s + 6], S[8 * s + 7])};
    pf[s] = __builtin_bit_cast(bf16x8, pk);
  }
}

constexpr int ABUFD = 8192 + 128 * 128;
DI int swz_off(int row, int c) { const int R = row >> 1; return R * 256 + (((((row & 1) << 3) | c) ^ (R & 15)) << 4); }
DI unsigned dma_src(int q, int lane, unsigned pitch) {
  const int R = 4 * q + (lane >> 4), C = (lane & 15) ^ (R & 15), row = 2 * R + (C >> 3), ch = C & 7;
  return (unsigned)row * pitch + (unsigned)ch * 16u;
}

template <int DV>
DI void attn_pass(f32x16 (&O)[DV / 32], float& lsum, const bf16x8 (&qf)[4], const bf16_t* __restrict__ Kb, int ldk, const bf16_t* __restrict__ Vt, int nkeys, char* smem) {
  constexpr int NV = DV / 32, NS = DV / 64;
  const int tid = get_tid(), lane = tid & 63, wid = __builtin_amdgcn_readfirstlane(tid >> 6), r = lane & 31, h = lane >> 5;
  const int pr = (r & 19) | ((r & 4) << 1) | ((r & 8) >> 1);
  const char* Kc = (const char*)Kb; const char* Vc = (const char*)Vt;
  G8_LAS unsigned char* lds = (G8_LAS unsigned char*)smem;
  const int nt = nkeys >> 6;
  const unsigned kpitch = (unsigned)ldk * 2u;
  const unsigned ksrc = dma_src(wid, lane, kpitch);
  unsigned vsrc[NS];
#pragma unroll
  for (int j = 0; j < NS; ++j) vsrc[j] = dma_src(wid + 8 * j, lane, (unsigned)NKEY * 2u);
#define ATT_ISSUE(kt_, b_) do { \
    __builtin_amdgcn_global_load_lds((const unsigned*)(Kc + (ksrc + (unsigned)(kt_) * 64u * kpitch)), (G8_LAS unsigned*)(lds + b_ + wid * 1024), 16, 0, 0); \
    _Pragma("unroll") for (int j_ = 0; j_ < NS; ++j_) \
      __builtin_amdgcn_global_load_lds((const unsigned*)(Vc + (vsrc[j_] + (unsigned)(kt_) * 128u)), (G8_LAS unsigned*)(lds + b_ + 8192 + (wid + 8 * j_) * 1024), 16, 0, 0); } while (0)
  ATT_ISSUE(0, 0);
  if (nt > 1) { ATT_ISSUE(1, ABUFD); if (NS == 2) asm volatile("s_waitcnt vmcnt(3)" ::: "memory"); else asm volatile("s_waitcnt vmcnt(2)" ::: "memory"); }
  else asm volatile("s_waitcnt vmcnt(0)" ::: "memory");
  __builtin_amdgcn_s_barrier();
  int ka[4], va[2][2];
#pragma unroll
  for (int t = 0; t < 4; ++t) ka[t] = swz_off(pr, 2 * t + h);
#pragma unroll
  for (int sb = 0; sb < 2; ++sb)
#pragma unroll
    for (int s = 0; s < 2; ++s) va[sb][s] = 8192 + swz_off(r, 4 * sb + 2 * s + h);
#pragma unroll
  for (int bk = 0; bk < NV; ++bk)
#pragma unroll
    for (int e = 0; e < 16; ++e) O[bk][e] = 0.f;
  float l0 = 0.f, l1 = 0.f;
  int bo = 0;
#pragma unroll 2
  for (int kt = 0; kt < nt; ++kt) {
    const char* cur = smem + bo;
    const int b2 = bo >= ABUFD ? bo - ABUFD : bo + 2 * ABUFD;
    if (kt + 2 < nt) ATT_ISSUE(kt + 2, b2);
    bf16x8 kf[2][4], vf[NV][2];
#pragma unroll
    for (int sb = 0; sb < 2; ++sb)
#pragma unroll
      for (int t = 0; t < 4; ++t) kf[sb][t] = *(const bf16x8*)(cur + ka[t] + sb * 4096);
#pragma unroll
    for (int bk = 0; bk < NV; ++bk)
#pragma unroll
      for (int s = 0; s < 2; ++s) vf[bk][s] = *(const bf16x8*)(cur + va[0][s] + bk * 4096);
    f32x16 S0, S1;
#pragma unroll
    for (int e = 0; e < 16; ++e) { S0[e] = 0.f; S1[e] = 0.f; }
#pragma unroll
    for (int t = 0; t < 4; ++t) S0 = MFMA(kf[0][t], qf[t], S0);
#pragma unroll
    for (int t = 0; t < 4; ++t) S1 = MFMA(kf[1][t], qf[t], S1);
    bf16x8 pf[2];
    softmax_step(S0, l0, l1, pf);
#pragma unroll
    for (int bk = 0; bk < NV; ++bk)
#pragma unroll
      for (int s = 0; s < 2; ++s) O[bk] = MFMA(vf[bk][s], pf[s], O[bk]);
#pragma unroll
    for (int bk = 0; bk < NV; ++bk)
#pragma unroll
      for (int s = 0; s < 2; ++s) vf[bk][s] = *(const bf16x8*)(cur + va[1][s] + bk * 4096);
    softmax_step(S1, l0, l1, pf);
#pragma unroll
    for (int bk = 0; bk < NV; ++bk)
#pragma unroll
      for (int s = 0; s < 2; ++s) O[bk] = MFMA(vf[bk][s], pf[s], O[bk]);
    if (kt + 2 < nt) { if (NS == 2) asm volatile("s_waitcnt vmcnt(3)" ::: "memory"); else asm volatile("s_waitcnt vmcnt(2)" ::: "memory"); }
    else asm volatile("s_waitcnt vmcnt(0)" ::: "memory");
    asm volatile("s_waitcnt lgkmcnt(0)" ::: "memory");
    __builtin_amdgcn_s_barrier();
    bo = bo == 2 * ABUFD ? 0 : bo + ABUFD;
  }
#undef ATT_ISSUE
  lsum = l0 + l1;
}

DI void load_q(bf16x8 (&qf)[4], const bf16_t* __restrict__ qp  , int h) {
#pragma unroll
  for (int t = 0; t < 4; ++t) qf[t] = *(const bf16x8*)(qp + 16 * t + 8 * h);
}

DI void diff_unit(const Params& p, int l, int b, int hh, int qrow0, int nkeys, char* smem) {
  f32x16 O[4]; float ls;
  float sc1 = 0.f;
#pragma unroll 1
  for (int c = 0; c < 2; ++c) {
    {
      const int tid = get_tid(), lane = tid & 63, w = tid >> 6, r = lane & 31, h = lane >> 5;
      bf16x8 qf[4];
      load_q(qf, p.Pm + (size_t)(qrow0 + 32 * w + r) * PMW + C_DQ + (2 * hh + c) * 64, h);
      attn_pass<128>(O, ls, qf, p.DK + (size_t)b * NKEY * 512 + (2 * hh + c) * 64, 512, p.DVt + ((size_t)b * 512 + hh * 128) * NKEY, nkeys, smem);
    }
    ls += __shfl_xor(ls, 32);
    if (c == 0) {
      const int tid = get_tid();
      float* st = p.stash + (size_t)blockIdx.x * 32768 + tid * 64;
      const float inv = 1.f / ls;
#pragma unroll
      for (int bk = 0; bk < 4; ++bk)
#pragma unroll
        for (int g4 = 0; g4 < 4; ++g4) {
          const f32x4 v4 = {O[bk][4 * g4] * inv, O[bk][4 * g4 + 1] * inv, O[bk][4 * g4 + 2] * inv, O[bk][4 * g4 + 3] * inv};
          *(f32x4*)(st + bk * 16 + g4 * 4) = v4;
        }
    } else sc1 = -p.consts[l * 4 + 0] / ls;
  }
  const int tid = get_tid(), lane = tid & 63, w = tid >> 6, r = lane & 31, h = lane >> 5;
  const float* st = p.stash + (size_t)blockIdx.x * 32768 + tid * 64;
  float ss = 0.f;
#pragma unroll
  for (int bk = 0; bk < 4; ++bk)
#pragma unroll
    for (int g4 = 0; g4 < 4; ++g4) {
      const f32x4 s4 = *(const f32x4*)(st + bk * 16 + g4 * 4);
#pragma unroll
      for (int e = 0; e < 4; ++e) { const float v = s4[e] + sc1 * O[bk][4 * g4 + e]; O[bk][4 * g4 + e] = v; ss += v * v; }
    }
  ss += __shfl_xor(ss, 32);
  const float rs = __builtin_amdgcn_rsqf(ss * (1.f / 128.f) + 1e-6f) * (1.f - p.consts[l * 4 + 3]);
  const float* sub = opaque(p.dsub + l * 128);
  bf16_t* zrow = p.Pm + (size_t)(qrow0 + 32 * w + r) * PMW + C_ZD + hh * 128;
#pragma unroll
  for (int bk = 0; bk < 4; ++bk)
#pragma unroll
    for (int g4 = 0; g4 < 4; ++g4) {
      const int dv0 = 32 * bk + 8 * g4 + 4 * h;
      const u32x2 z = *(const u32x2*)(zrow + dv0);
      const f32x4 sg = *(const f32x4*)(sub + dv0);
      const float o0 = O[bk][4 * g4] * rs * sg[0] * bflo(z[0]), o1 = O[bk][4 * g4 + 1] * rs * sg[1] * bfhi(z[0]);
      const float o2 = O[bk][4 * g4 + 2] * rs * sg[2] * bflo(z[1]), o3 = O[bk][4 * g4 + 3] * rs * sg[3] * bfhi(z[1]);
      u32x2 pk = {pack2(o0, o1), pack2(o2, o3)};
      *(u32x2*)(zrow + dv0) = pk;
      asm volatile("" ::: "memory"); __builtin_amdgcn_sched_barrier(0);
    }
}

DI void attn_pass_d2(f32x16 (&O)[2][4], float (&lsum)[2], const bf16x8 (&qf)[2][4], const bf16_t* __restrict__ Kb, const bf16_t* __restrict__ Vt, char* smem) {
  const int tid = get_tid(), lane = tid & 63, wid = __builtin_amdgcn_readfirstlane(tid >> 6), r = lane & 31, h = lane >> 5;
  const int pr = (r & 19) | ((r & 4) << 1) | ((r & 8) >> 1);
  const char* Kc = (const char*)Kb; const char* Vc = (const char*)Vt;
  G8_LAS unsigned char* lds = (G8_LAS unsigned char*)smem;
  constexpr int nt = NKEY >> 6;
  const unsigned ksrc = dma_src(wid, lane, 1024u), vsrc0 = dma_src(wid, lane, (unsigned)NKEY * 2u), vsrc1 = dma_src(wid + 8, lane, (unsigned)NKEY * 2u);
#define D2_ISSUE(kt_, b_) do { \
    __builtin_amdgcn_global_load_lds((const unsigned*)(Kc + (ksrc + (unsigned)(kt_) * 64u * 1024u)), (G8_LAS unsigned*)(lds + (b_) + wid * 1024), 16, 0, 0); \
    __builtin_amdgcn_global_load_lds((const unsigned*)(Vc + (vsrc0 + (unsigned)(kt_) * 128u)), (G8_LAS unsigned*)(lds + (b_) + 8192 + wid * 1024), 16, 0, 0); \
    __builtin_amdgcn_global_load_lds((const unsigned*)(Vc + (vsrc1 + (unsigned)(kt_) * 128u)), (G8_LAS unsigned*)(lds + (b_) + 8192 + (wid + 8) * 1024), 16, 0, 0); } while (0)
  D2_ISSUE(0, 0);
  D2_ISSUE(1, ABUFD);
  asm volatile("s_waitcnt vmcnt(3)" ::: "memory");
  __builtin_amdgcn_s_barrier();
  int ka[4], va[2][2];
#pragma unroll
  for (int t = 0; t < 4; ++t) ka[t] = swz_off(pr, 2 * t + h);
#pragma unroll
  for (int sb = 0; sb < 2; ++sb)
#pragma unroll
    for (int s2 = 0; s2 < 2; ++s2) va[sb][s2] = 8192 + swz_off(r, 4 * sb + 2 * s2 + h);
#pragma unroll
  for (int qb = 0; qb < 2; ++qb)
#pragma unroll
    for (int bk = 0; bk < 4; ++bk)
#pragma unroll
      for (int e = 0; e < 16; ++e) O[qb][bk][e] = 0.f;
  float l0[2] = {0.f, 0.f};
  int bo = 0;
#pragma unroll 1
  for (int kt = 0; kt < nt; ++kt) {
    const char* cur = smem + bo;
    const int b2 = bo >= ABUFD ? bo - ABUFD : bo + 2 * ABUFD;
    if (kt + 2 < nt) D2_ISSUE(kt + 2, b2);
#pragma unroll 1
    for (int sb = 0; sb < 2; ++sb) {
      bf16x8 pf0[2], pf1[2];
      {
        bf16x8 kf[4];
#pragma unroll
        for (int t = 0; t < 4; ++t) kf[t] = *(const bf16x8*)(cur + ka[t] + sb * 4096);
        f32x16 S0, S1;
#pragma unroll
        for (int e = 0; e < 16; ++e) { S0[e] = 0.f; S1[e] = 0.f; }
#pragma unroll
        for (int t = 0; t < 4; ++t) S0 = MFMA(kf[t], qf[0][t], S0);
#pragma unroll
        for (int t = 0; t < 4; ++t) S1 = MFMA(kf[t], qf[1][t], S1);
        softmax_step(S0, l0[0], l0[0], pf0);
        softmax_step(S1, l0[1], l0[1], pf1);
      }
#pragma unroll
      for (int bk = 0; bk < 4; ++bk)
#pragma unroll
        for (int s2 = 0; s2 < 2; ++s2) {
          const bf16x8 vf = *(const bf16x8*)(cur + va[0][s2] + sb * 64 * 0 + bk * 4096 + (sb ? (va[1][s2] - va[0][s2]) : 0));
          O[0][bk] = MFMA(vf, pf0[s2], O[0][bk]);
          O[1][bk] = MFMA(vf, pf1[s2], O[1][bk]);
        }
    }
    if (kt + 2 < nt) asm volatile("s_waitcnt vmcnt(3)" ::: "memory"); else asm volatile("s_waitcnt vmcnt(0)" ::: "memory");
    asm volatile("s_waitcnt lgkmcnt(0)" ::: "memory");
    __builtin_amdgcn_s_barrier();
    bo = bo == 2 * ABUFD ? 0 : bo + ABUFD;
  }
#undef D2_ISSUE
  lsum[0] = l0[0]; lsum[1] = l0[1];
}

DI void diff_unit2(const Params& p, int l, int b, int hh, int qrow0, char* smem) {
  f32x16 O[2][4]; float ls[2];
  float sc1[2] = {0.f, 0.f};
#pragma unroll 1
  for (int c = 0; c < 2; ++c) {
    {
      const int tid = get_tid(), lane = tid & 63, w = tid >> 6, r = lane & 31, h = lane >> 5;
      bf16x8 qf[2][4];
#pragma unroll
      for (int qb = 0; qb < 2; ++qb) load_q(qf[qb], p.Pm + (size_t)(qrow0 + 64 * w + 32 * qb + r) * PMW + C_DQ + (2 * hh + c) * 64, h);
      attn_pass_d2(O, ls, qf, p.DK + (size_t)b * NKEY * 512 + (2 * hh + c) * 64, p.DVt + ((size_t)b * 512 + hh * 128) * NKEY, smem);
    }
#pragma unroll
    for (int qb = 0; qb < 2; ++qb) ls[qb] += __shfl_xor(ls[qb], 32);
    if (c == 0) {
      const int tid = get_tid();
      float* st = p.stash + (size_t)blockIdx.x * 65536 + tid * 128;
#pragma unroll
      for (int qb = 0; qb < 2; ++qb) {
        const float inv = 1.f / ls[qb];
#pragma unroll
        for (int bk = 0; bk < 4; ++bk)
#pragma unroll
          for (int g4 = 0; g4 < 4; ++g4) {
            const f32x4 v4 = {O[qb][bk][4 * g4] * inv, O[qb][bk][4 * g4 + 1] * inv, O[qb][bk][4 * g4 + 2] * inv, O[qb][bk][4 * g4 + 3] * inv};
            *(f32x4*)(st + qb * 64 + bk * 16 + g4 * 4) = v4;
          }
      }
    } else { sc1[0] = -p.consts[l * 4 + 0] / ls[0]; sc1[1] = -p.consts[l * 4 + 0] / ls[1]; }
  }
  const int tid = get_tid(), lane = tid & 63, w = tid >> 6, r = lane & 31, h = lane >> 5;
  const float* st = p.stash + (size_t)blockIdx.x * 65536 + tid * 128;
  const float* sub = opaque(p.dsub + l * 128);
#pragma unroll
  for (int qb = 0; qb < 2; ++qb) {
    float ss = 0.f;
#pragma unroll
    for (int bk = 0; bk < 4; ++bk)
#pragma unroll
      for (int g4 = 0; g4 < 4; ++g4) {
        const f32x4 s4 = *(const f32x4*)(st + qb * 64 + bk * 16 + g4 * 4);
#pragma unroll
        for (int e = 0; e < 4; ++e) { const float v = s4[e] + sc1[qb] * O[qb][bk][4 * g4 + e]; O[qb][bk][4 * g4 + e] = v; ss += v * v; }
      }
    ss += __shfl_xor(ss, 32);
    const float rs = __builtin_amdgcn_rsqf(ss * (1.f / 128.f) + 1e-6f) * (1.f - p.consts[l * 4 + 3]);
    bf16_t* zrow = p.Pm + (size_t)(qrow0 + 64 * w + 32 * qb + r) * PMW + C_ZD + hh * 128;
#pragma unroll
    for (int bk = 0; bk < 4; ++bk)
#pragma unroll
      for (int g4 = 0; g4 < 4; ++g4) {
        const int dv0 = 32 * bk + 8 * g4 + 4 * h;
        const u32x2 z = *(const u32x2*)(zrow + dv0);
        const f32x4 sg = *(const f32x4*)(sub + dv0);
        const float o0 = O[qb][bk][4 * g4] * rs * sg[0] * bflo(z[0]), o1 = O[qb][bk][4 * g4 + 1] * rs * sg[1] * bfhi(z[0]);
        const float o2 = O[qb][bk][4 * g4 + 2] * rs * sg[2] * bflo(z[1]), o3 = O[qb][bk][4 * g4 + 3] * rs * sg[3] * bfhi(z[1]);
        u32x2 pk = {pack2(o0, o1), pack2(o2, o3)};
        *(u32x2*)(zrow + dv0) = pk;
        asm volatile("" ::: "memory");
      }
  }
}

DI void gqa_unit(const Params& p, int l, int b, int qh, int qrow0, int nkeys, char* smem) {
  const int tid = get_tid(), lane = tid & 63, w = tid >> 6, r = lane & 31, h = lane >> 5;
  const int qrow = qrow0 + 32 * w + r, kvh = qh >> 2;
  f32x16 O[2]; float ls; bf16x8 qf[4];
  load_q(qf, p.Pm + (size_t)qrow * PMW + C_GQ + qh * 64, h);
  attn_pass<64>(O, ls, qf, p.GK + (size_t)b * NKEY * 128 + kvh * 64, 128, p.GVt + ((size_t)b * 128 + kvh * 64) * NKEY, nkeys, smem);
  ls += __shfl_xor(ls, 32);
  const float inv = 1.f / ls;
  bf16_t* zrow = p.Pm + (size_t)qrow * PMW + C_ZG + qh * 64;
#pragma unroll
  for (int bk = 0; bk < 2; ++bk)
#pragma unroll
    for (int g4 = 0; g4 < 4; ++g4) {
      const int dv0 = 32 * bk + 8 * g4 + 4 * h;
      const u32x2 z = *(const u32x2*)(zrow + dv0);
      const float o0 = O[bk][4 * g4] * inv * bflo(z[0]), o1 = O[bk][4 * g4 + 1] * inv * bfhi(z[0]);
      const float o2 = O[bk][4 * g4 + 2] * inv * bflo(z[1]), o3 = O[bk][4 * g4 + 3] * inv * bfhi(z[1]);
      u32x2 pk = {pack2(o0, o1), pack2(o2, o3)};
      *(u32x2*)(zrow + dv0) = pk;
    }
}

DI void attn_pass_g2(f32x16 (&O)[2][2], float (&lsum)[2], const bf16x8 (&qf)[2][4], const bf16_t* __restrict__ Kb, const bf16_t* __restrict__ Vt, int nkeys, char* smem) {
  const int tid = get_tid(), lane = tid & 63, wid = __builtin_amdgcn_readfirstlane(tid >> 6), r = lane & 31, h = lane >> 5;
  const int pr = (r & 19) | ((r & 4) << 1) | ((r & 8) >> 1);
  const char* Kc = (const char*)Kb; const char* Vc = (const char*)Vt;
  G8_LAS unsigned char* lds = (G8_LAS unsigned char*)smem;
  const int nt = nkeys >> 6;
  const unsigned ksrc = dma_src(wid, lane, 256u), vsrc = dma_src(wid, lane, (unsigned)NKEY * 2u);
#define G2_ISSUE(kt_, b_) do { \
    __builtin_amdgcn_global_load_lds((const unsigned*)(Kc + (ksrc + (unsigned)(kt_) * 64u * 256u)), (G8_LAS unsigned*)(lds + b_ + wid * 1024), 16, 0, 0); \
    __builtin_amdgcn_global_load_lds((const unsigned*)(Vc + (vsrc + (unsigned)(kt_) * 128u)), (G8_LAS unsigned*)(lds + b_ + 8192 + wid * 1024), 16, 0, 0); } while (0)
  G2_ISSUE(0, 0);
  if (nt > 1) { G2_ISSUE(1, ABUFD); asm volatile("s_waitcnt vmcnt(2)" ::: "memory"); }
  else asm volatile("s_waitcnt vmcnt(0)" ::: "memory");
  __builtin_amdgcn_s_barrier();
  int ka[4], va[2][2];
#pragma unroll
  for (int t = 0; t < 4; ++t) ka[t] = swz_off(pr, 2 * t + h);
#pragma unroll
  for (int sb = 0; sb < 2; ++sb)
#pragma unroll
    for (int s2 = 0; s2 < 2; ++s2) va[sb][s2] = 8192 + swz_off(r, 4 * sb + 2 * s2 + h);
#pragma unroll
  for (int qb = 0; qb < 2; ++qb)
#pragma unroll
    for (int bk = 0; bk < 2; ++bk)
#pragma unroll
      for (int e = 0; e < 16; ++e) O[qb][bk][e] = 0.f;
  float l0[2] = {0.f, 0.f}, l1[2] = {0.f, 0.f};
  int bo = 0;
#pragma unroll 1
  for (int kt = 0; kt < nt; ++kt) {
    const char* cur = smem + bo;
    const int b2 = bo >= ABUFD ? bo - ABUFD : bo + 2 * ABUFD;
    if (kt + 2 < nt) G2_ISSUE(kt + 2, b2);
#pragma unroll
    for (int sb = 0; sb < 2; ++sb) {
      bf16x8 kf[4];
#pragma unroll
      for (int t = 0; t < 4; ++t) kf[t] = *(const bf16x8*)(cur + ka[t] + sb * 4096);
      f32x16 S0, S1;
#pragma unroll
      for (int e = 0; e < 16; ++e) { S0[e] = 0.f; S1[e] = 0.f; }
#pragma unroll
      for (int t = 0; t < 4; ++t) S0 = MFMA(kf[t], qf[0][t], S0);
#pragma unroll
      for (int t = 0; t < 4; ++t) S1 = MFMA(kf[t], qf[1][t], S1);
      bf16x8 vf[2][2];
#pragma unroll
      for (int bk = 0; bk < 2; ++bk)
#pragma unroll
        for (int s2 = 0; s2 < 2; ++s2) vf[bk][s2] = *(const bf16x8*)(cur + va[sb][s2] + bk * 4096);
      bf16x8 pf[2];
      softmax_step(S0, l0[0], l1[0], pf);
#pragma unroll
      for (int bk = 0; bk < 2; ++bk)
#pragma unroll
        for (int s2 = 0; s2 < 2; ++s2) O[0][bk] = MFMA(vf[bk][s2], pf[s2], O[0][bk]);
      softmax_step(S1, l0[1], l1[1], pf);
#pragma unroll
      for (int bk = 0; bk < 2; ++bk)
#pragma unroll
        for (int s2 = 0; s2 < 2; ++s2) O[1][bk] = MFMA(vf[bk][s2], pf[s2], O[1][bk]);
    }
    if (kt + 2 < nt) asm volatile("s_waitcnt vmcnt(2)" ::: "memory"); else asm volatile("s_waitcnt vmcnt(0)" ::: "memory");
    asm volatile("s_waitcnt lgkmcnt(0)" ::: "memory");
    __builtin_amdgcn_s_barrier();
    bo = bo == 2 * ABUFD ? 0 : bo + ABUFD;
  }
#undef G2_ISSUE
  lsum[0] = l0[0] + l1[0]; lsum[1] = l0[1] + l1[1];
}

DI void gqa_unit2(const Params& p, int l, int b, int qh, int qrow0, char* smem) {
  const int tid = get_tid(), lane = tid & 63, w = tid >> 6, r = lane & 31, h = lane >> 5;
  const int kvh = qh >> 2;
  f32x16 O[2][2]; float ls[2]; bf16x8 qf[2][4];
#pragma unroll
  for (int qb = 0; qb < 2; ++qb) load_q(qf[qb], p.Pm + (size_t)(qrow0 + 64 * w + 32 * qb + r) * PMW + C_GQ + qh * 64, h);
  attn_pass_g2(O, ls, qf, p.GK + (size_t)b * NKEY * 128 + kvh * 64, p.GVt + ((size_t)b * 128 + kvh * 64) * NKEY, NKEY, smem);
#pragma unroll
  for (int qb = 0; qb < 2; ++qb) {
    float lsq = ls[qb]; lsq += __shfl_xor(lsq, 32);
    const float inv = 1.f / lsq;
    bf16_t* zrow = p.Pm + (size_t)(qrow0 + 64 * w + 32 * qb + r) * PMW + C_ZG + qh * 64;
#pragma unroll
    for (int bk = 0; bk < 2; ++bk)
#pragma unroll
      for (int g4 = 0; g4 < 4; ++g4) {
        const int dv0 = 32 * bk + 8 * g4 + 4 * h;
        const u32x2 z = *(const u32x2*)(zrow + dv0);
        const float o0 = O[qb][bk][4 * g4] * inv * bflo(z[0]), o1 = O[qb][bk][4 * g4 + 1] * inv * bfhi(z[0]);
        const float o2 = O[qb][bk][4 * g4 + 2] * inv * bflo(z[1]), o3 = O[qb][bk][4 * g4 + 3] * inv * bfhi(z[1]);
        u32x2 pk = {pack2(o0, o1), pack2(o2, o3)};
        *(u32x2*)(zrow + dv0) = pk;
      }
  }
}

DI void pool_unit(const Params& p, int l, int mt, int g, char* smem) {
  const int tid = (get_tid() & 255), lane = tid & 63, w = tid >> 6, wm = w >> 1, wn = w & 1, r = lane & 31, h = lane >> 5;
  const int row0 = mt * 128;
  int seq0, n, t0;
  if (mt < 256) { seq0 = (mt >> 6) * 8192; n = 8192; t0 = (mt & 63) * 128; }
  else { const int c = mt - 256; seq0 = NLAT + (c >> 1) * 256; n = 256; t0 = (c & 1) * 128; }
  const int wnd = 2 << g, left = wnd >> 1, right = wnd - 1 - left;
  char* ut = smem + 2 * TILEB;
  u32x4 wreg[8];
#pragma unroll
  for (int q = 0; q < 8; ++q) {
    const int idx = tid + 256 * q, tok = idx >> 4, ch = idx & 15;
    wreg[q] = *(const u32x4*)(p.WpT + (size_t)(l * 4 + g) * 128 * 128 + (size_t)tok * 128 + ch * 8);
  }
  {
    const bf16_t* up = p.Pm + (size_t)seq0 * PMW + C_U + g * 128;
    u32x4 uv[9];
#pragma unroll
    for (int q = 0; q < 9; ++q) {
      const int idx = tid + 256 * q, urow = idx >> 4, ch = idx & 15, tt = t0 - 8 + urow;
      uv[q] = (u32x4){0u, 0u, 0u, 0u};
      if (tt >= 0 && tt < n) uv[q] = *(const u32x4*)(up + (size_t)tt * PMW + ch * 8);
    }
#pragma unroll
    for (int q = 0; q < 9; ++q) { const int idx = tid + 256 * q; *(u32x4*)(ut + (idx >> 4) * 256 + (idx & 15) * 16) = uv[q]; }
  }
  __syncthreads();
#pragma unroll 2
  for (int q = 0; q < 8; ++q) {
    const int idx = tid + 256 * q, tok = idx >> 4, ch = idx & 15;
    const int t = t0 + tok;
    const int lo = t - left < 0 ? 0 : t - left, hi = t + right + 1 > n ? n : t + right + 1;
    float sm[8] = {0.f, 0.f, 0.f, 0.f, 0.f, 0.f, 0.f, 0.f};
    const char* ub = ut + (tok + 8 - left) * 256 + ch * 16;
#pragma unroll
    for (int d = 0; d < 16; ++d) {
      if (d < wnd) {
        const u32x4 v = *(const u32x4*)(ub + d * 256);
#pragma unroll
        for (int e = 0; e < 4; ++e) { sm[2 * e] += bflo(v[e]); sm[2 * e + 1] += bfhi(v[e]); }
      }
    }
    const u32x4 sv = *(const u32x4*)(ut + (tok + 8) * 256 + ch * 16);
    const float ic = 1.f / (float)(hi - lo);
    u32x4 o;
#pragma unroll
    for (int e = 0; e < 4; ++e) o[e] = pack2(sm[2 * e] * ic - bflo(sv[e]), sm[2 * e + 1] * ic - bfhi(sv[e]));
    *(u32x4*)(smem + (ch >> 3) * TILEB + tok * TROW + (ch & 7) * 16) = o;
  }
  __syncthreads();
#pragma unroll
  for (int q = 0; q < 8; ++q) {
    const int idx = tid + 256 * q, tok = idx >> 4, ch = idx & 15;
    *(u32x4*)(smem + (2 + (ch >> 3)) * TILEB + tok * TROW + (ch & 7) * 16) = wreg[q];
  }
  __syncthreads();
  f32x16 acc[2][2]; zero_acc22(acc);
  const int aoff = (64 * wm + r) * TROW + 16 * h;
  const int boff = 2 * TILEB + (64 * wn + r) * TROW + 16 * h;
#pragma unroll
  for (int kt = 0; kt < 2; ++kt) {
    const char* cur = smem + kt * TILEB;
#pragma unroll
    for (int t = 0; t < 4; ++t) {
      const bf16x8 a0 = *(const bf16x8*)(cur + aoff + 32 * t);
      const bf16x8 a1 = *(const bf16x8*)(cur + aoff + 32 * TROW + 32 * t);
      const bf16x8 b0 = *(const bf16x8*)(cur + boff + 32 * t);
      const bf16x8 b1 = *(const bf16x8*)(cur + boff + 32 * TROW + 32 * t);
      acc[0][0] = MFMA(b0, a0, acc[0][0]); acc[0][1] = MFMA(b1, a0, acc[0][1]);
      acc[1][0] = MFMA(b0, a1, acc[1][0]); acc[1][1] = MFMA(b1, a1, acc[1][1]);
    }
  }
  __syncthreads();
  const float* ps = p.pool_scale + l * 512 + g * 128 + 64 * wn;
#pragma unroll
  for (int i = 0; i < 2; ++i) {
    bf16_t* zrow = p.Pm + (size_t)(row0 + 64 * wm + 32 * i + r) * PMW + C_ZP + g * 128 + 64 * wn;
#pragma unroll
    for (int j = 0; j < 2; ++j)
#pragma unroll
      for (int g4 = 0; g4 < 4; ++g4) {
        const int c0 = 32 * j + 8 * g4 + 4 * h;
        const u32x2 z = *(const u32x2*)(zrow + c0);
        const f32x4 sc = *(const f32x4*)(ps + c0);
        const float o0 = acc[i][j][4 * g4] * sc[0] * bflo(z[0]), o1 = acc[i][j][4 * g4 + 1] * sc[1] * bfhi(z[0]);
        const float o2 = acc[i][j][4 * g4 + 2] * sc[2] * bflo(z[1]), o3 = acc[i][j][4 * g4 + 3] * sc[3] * bfhi(z[1]);
        u32x2 pk = {pack2(o0, o1), pack2(o2, o3)};
        *(u32x2*)(zrow + c0) = pk;
      }
  }
}

DI void phase3(const Params& p, int l, char* smem_all) {
  const int nD = 256, nG = 512, nCD = l == 0 ? 16 : 0, nCG = l == 0 ? 32 : 0;
  const int e1 = nD, e2 = e1 + nG, e3 = e2 + nCD, e4 = e3 + nCG;
  for (int i = blockIdx.x; i < e4; i += gridDim.x) {
    if (i < e1) { const int x = i & 7, j = i >> 3, bh = x + 8 * (j >> 4), qb = j & 15; diff_unit2(p, l, bh >> 2, bh & 3, (bh >> 2) * 8192 + qb * 512, smem_all); }
    else if (i < e2) { const int i2 = i - e1, x = i2 & 7, j = i2 >> 3, qb = j & 15, b = x >> 1, qh = (x & 1) * 4 + (j >> 4); gqa_unit2(p, l, b, qh, b * 8192 + qb * 512, smem_all); }
    else if (i < e3) { const int i3 = i - e2, b = i3 >> 2, hh = i3 & 3; diff_unit(p, l, b, hh, NLAT + b * 256, 256, smem_all); }
    else { const int i4 = i - e3, b = i4 >> 3, qh = i4 & 7; gqa_unit(p, l, b, qh, NLAT + b * 256, 256, smem_all); }
  }
  const int grp = get_tid() >> 8;
  char* smem = smem_all + grp * GRP_SMEM;
  const int nPool = (l == 0 ? 264 : 256) * 4;
  for (int k = blockIdx.x; 2 * k < nPool; k += gridDim.x) {
    const int i5 = 2 * k + grp;
    pool_unit(p, l, i5 >> 2, i5 & 3, smem);
  }
}

DI void gemm_kloop4(f32x16 (&acc)[2][2], const bf16_t* __restrict__ A, int lda, const bf16_t* __restrict__ Bt, int ldb, int K, char* smem) {
  const int tid = get_tid() & 255, lane = tid & 63, w = tid >> 6, wm = w >> 1, wn = w & 1, r = lane & 31, h = lane >> 5;
  const int srow = tid >> 3, sch = tid & 7;
  const unsigned ago = (unsigned)(srow * lda + sch * 8) * 2u, bgo = (unsigned)(srow * ldb + sch * 8) * 2u;
  const unsigned astep = (unsigned)lda * 64u, bstep = (unsigned)ldb * 64u;
  const char* Ab = (const char*)A; const char* Bb = (const char*)Bt;
  const int soff = srow * TROW + sch * 16;
  u32x4 ra[4], rb[4];
#pragma unroll
  for (int q = 0; q < 4; ++q) { ra[q] = *(const u32x4*)(Ab + (ago + q * astep)); rb[q] = *(const u32x4*)(Bb + (bgo + q * bstep)); }
#pragma unroll
  for (int q = 0; q < 4; ++q) { *(u32x4*)(smem + soff + q * 32 * TROW) = ra[q]; *(u32x4*)(smem + TILEB + soff + q * 32 * TROW) = rb[q]; }
  __syncthreads();
  const int nk = K >> 6;
  const int aoff = (64 * wm + r) * TROW + 16 * h;
  const int boff = TILEB + (64 * wn + r) * TROW + 16 * h;
#pragma unroll 1
  for (int kt = 0; kt < nk; ++kt) {
    const char* cur = smem + (kt & 1) * (2 * TILEB);
    if (kt + 1 < nk) {
#pragma unroll
      for (int q = 0; q < 4; ++q) {
        ra[q] = *(const u32x4*)(Ab + (ago + q * astep + (unsigned)(kt + 1) * 128u));
        rb[q] = *(const u32x4*)(Bb + (bgo + q * bstep + (unsigned)(kt + 1) * 128u));
      }
    }
#pragma unroll
    for (int t = 0; t < 4; ++t) {
      const bf16x8 a0 = *(const bf16x8*)(cur + aoff + 32 * t);
      const bf16x8 a1 = *(const bf16x8*)(cur + aoff + 32 * TROW + 32 * t);
      const bf16x8 b0 = *(const bf16x8*)(cur + boff + 32 * t);
      const bf16x8 b1 = *(const bf16x8*)(cur + boff + 32 * TROW + 32 * t);
      acc[0][0] = MFMA(b0, a0, acc[0][0]); acc[0][1] = MFMA(b1, a0, acc[0][1]);
      acc[1][0] = MFMA(b0, a1, acc[1][0]); acc[1][1] = MFMA(b1, a1, acc[1][1]);
    }
    if (kt + 1 < nk) {
      char* nxt = smem + ((kt + 1) & 1) * (2 * TILEB);
#pragma unroll
      for (int q = 0; q < 4; ++q) { *(u32x4*)(nxt + soff + q * 32 * TROW) = ra[q]; *(u32x4*)(nxt + TILEB + soff + q * 32 * TROW) = rb[q]; }
    }
    __syncthreads();
  }
}

DI void ctx_p4_tile(const Params& p, int l, int mt, int pn, char* smem) {
  const int tid = get_tid() & 255, lane = tid & 63, w = tid >> 6, wm = w >> 1, wn = w & 1, r = lane & 31, h = lane >> 5;
  const int m0 = NLAT + mt * 128, n0 = pn * 128;
  const bf16_t* W = p.WinT + (size_t)l * 7424 * 1024;
  char* yb = (char*)(p.y + (size_t)m0 * 1024 + n0);
  unsigned lo = (unsigned)((64 * wm + r) * 1024 + 64 * wn + 4 * h) * 2u;
  asm volatile("" : "+v"(lo));
#pragma unroll 1
  for (int i = 0; i < 3; ++i) {
    unsigned gpk[2][2][8];
    {
      f32x16 acc[2][2]; zero_acc22(acc);
      gemm_kloop4(acc, p.h + (size_t)m0 * 1024, 1024, W + (size_t)(4352 + i * 1024 + n0) * 1024, 1024, 1024, smem);
#pragma unroll
      for (int a = 0; a < 2; ++a)
#pragma unroll
        for (int c = 0; c < 2; ++c)
#pragma unroll
          for (int e = 0; e < 8; ++e) gpk[a][c][e] = pack2(fast_sigmoid(acc[a][c][2 * e]), fast_sigmoid(acc[a][c][2 * e + 1]));
    }
    f32x16 acc[2][2]; zero_acc22(acc);
    const int zc = i == 0 ? C_ZP : (i == 1 ? C_ZD : C_ZG);
    gemm_kloop4(acc, p.Pm + (size_t)m0 * PMW + zc, PMW, p.WbT + ((size_t)(l * 3 + i) * 1024 + n0) * 512, 512, 512, smem);
#pragma unroll
    for (int a = 0; a < 2; ++a)
#pragma unroll
      for (int c = 0; c < 2; ++c) {
#pragma unroll
        for (int g4 = 0; g4 < 4; ++g4) {
          const unsigned o = lo + (unsigned)(((32 * a) * 1024 + 32 * c + 8 * g4) * 2);
          u32x2 y = {0u, 0u};
          if (i > 0) y = *(const u32x2*)(yb + o);
          const unsigned g0 = gpk[a][c][2 * g4], g1 = gpk[a][c][2 * g4 + 1];
          u32x2 out = {pack2(bflo(y[0]) + bflo(g0) * acc[a][c][4 * g4], bfhi(y[0]) + bfhi(g0) * acc[a][c][4 * g4 + 1]),
                       pack2(bflo(y[1]) + bflo(g1) * acc[a][c][4 * g4 + 2], bfhi(y[1]) + bfhi(g1) * acc[a][c][4 * g4 + 3])};
          *(u32x2*)(yb + o) = out;
        }
        asm volatile("" ::: "memory");
      }
  }
}

DI void ctx_p5_tile(const Params& p, int l, int mt, int pn, char* smem) {
  const int tid = get_tid() & 255, lane = tid & 63, w = tid >> 6, wm = w >> 1, wn = w & 1, r = lane & 31, h = lane >> 5;
  const int m0 = NLAT + mt * 128, n0 = pn * 128;
  f32x16 acc[2][2]; zero_acc22(acc);
  gemm_kloop4(acc, p.y + (size_t)m0 * 1024, 1024, p.WoT + ((size_t)l * 1024 + n0) * 1024, 1024, 1024, smem);
  const char* srcb = (const char*)(p.ctx + (size_t)(mt * 128) * 1024 + n0);
  char* dstb = (char*)(p.xc1 + (size_t)(mt * 128) * 1024 + n0);
  const float* gate = p.mod + (l * 5 + 4) * 3072 + 2048 + n0 + 64 * wn + 4 * h;
  unsigned lo = (unsigned)((64 * wm + r) * 1024 + 64 * wn + 4 * h) * 4u;
  asm volatile("" : "+v"(lo));
#pragma unroll
  for (int a = 0; a < 2; ++a)
#pragma unroll
    for (int c = 0; c < 2; ++c) {
#pragma unroll
      for (int g4 = 0; g4 < 4; ++g4) {
        const unsigned o = lo + (unsigned)(((32 * a) * 1024 + 32 * c + 8 * g4) * 4);
        const f32x4 xv = *(const f32x4*)(srcb + o);
        const f32x4 gt = *(const f32x4*)(gate + 32 * c + 8 * g4);
        const f32x4 av = {acc[a][c][4 * g4], acc[a][c][4 * g4 + 1], acc[a][c][4 * g4 + 2], acc[a][c][4 * g4 + 3]};
        *(f32x4*)(dstb + o) = xv + gt * av;
      }
      asm volatile("" ::: "memory");
    }
}

DI void ctx_small_phase(const Params& p, int l, char* smem_all, bool is5) {
  const int grp = get_tid() >> 8;
  char* smem = smem_all + grp * GRP_SMEM;
  for (int k = blockIdx.x; 2 * k < 64; k += gridDim.x) {
    const int t = 2 * k + grp;
    if (is5) ctx_p5_tile(p, l, t >> 3, t & 7, smem); else ctx_p4_tile(p, l, t >> 3, t & 7, smem);
  }
}

struct Sched4 {
  TileWalk tw; const char* h; const char* W; const char* Pm; const char* Wb;
  DI bool next(int i, g8::Unit& u) const {
    const int ti = i / 6, s = i - 6 * ti, i3 = s >> 1;
    int mt, pn2;
    if (!tw.at(ti, mt, pn2)) return false;
    if ((s & 1) == 0) {
      u.A = h + (size_t)mt * 256 * 2048; u.lda2 = 2048; u.B = W + (size_t)(4352 + i3 * 1024 + pn2 * 256) * 2048; u.ldb2 = 2048; u.nt = 16; u.kind = 0;
    } else {
      const int zc = i3 == 0 ? C_ZP : (i3 == 1 ? C_ZD : C_ZG);
      u.A = Pm + ((size_t)mt * 256 * PMW + zc) * 2; u.lda2 = PMW * 2; u.B = Wb + (size_t)(i3 * 1024 + pn2 * 256) * 1024; u.ldb2 = 1024; u.nt = 8; u.kind = 1;
    }
    u.i0 = mt; u.i1 = pn2; u.i2 = i3;
    return true;
  }
};
struct Epi4 {
  const Params& p; char* gbase; unsigned goff;
  DI void operator()(const f32x4 (&acc)[2][2][4][2], const g8::Unit& u, int wr, int wc, int fr, int fq) const {
    unsigned go = goff; asm volatile("" : "+v"(go));
    if (u.kind == 0) {
#pragma unroll
      for (int ai = 0; ai < 2; ++ai)
#pragma unroll
        for (int bj = 0; bj < 2; ++bj) {
#pragma unroll
          for (int m = 0; m < 4; ++m) {
            const f32x4 a0 = acc[ai][bj][m][0], a1 = acc[ai][bj][m][1];
            u32x4 g = {pack2(fast_sigmoid(a0[0]), fast_sigmoid(a0[1])), pack2(fast_sigmoid(a0[2]), fast_sigmoid(a0[3])),
                       pack2(fast_sigmoid(a1[0]), fast_sigmoid(a1[1])), pack2(fast_sigmoid(a1[2]), fast_sigmoid(a1[3]))};
            *(u32x4*)(gbase + (go + (unsigned)((((ai * 2 + bj) * 4 + m) * 4) * 4))) = g;
          }
          asm volatile("" ::: "memory"); __builtin_amdgcn_sched_barrier(0);
        }
    } else {
      const int i3 = u.i2;
      bf16_t* dst = p.y + (size_t)(u.i0 * 256 + 64 * wr + fr) * 1024 + u.i1 * 256 + 32 * wc + 4 * fq;
#pragma unroll
      for (int ai = 0; ai < 2; ++ai) {
        u32x4 g[2][4], y[2][4];
#pragma unroll
        for (int bj = 0; bj < 2; ++bj)
#pragma unroll
          for (int m = 0; m < 4; ++m) {
            g[bj][m] = *(const u32x4*)(gbase + (go + (unsigned)((((ai * 2 + bj) * 4 + m) * 4) * 4)));
            y[bj][m] = (u32x4){0u, 0u, 0u, 0u};
            if (i3 > 0) y[bj][m] = *(const u32x4*)(gbase + (go + (unsigned)((64 + ((ai * 2 + bj) * 4 + m) * 4) * 4)));
          }
#pragma unroll
        for (int bj = 0; bj < 2; ++bj)
#pragma unroll
          for (int m = 0; m < 4; ++m) {
            const f32x4 a0 = acc[ai][bj][m][0], a1 = acc[ai][bj][m][1];
            const u32x4 gg = g[bj][m], yy = y[bj][m];
            u32x4 o = {pack2(bflo(yy[0]) + bflo(gg[0]) * a0[0], bfhi(yy[0]) + bfhi(gg[0]) * a0[1]), pack2(bflo(yy[1]) + bflo(gg[1]) * a0[2], bfhi(yy[1]) + bfhi(gg[1]) * a0[3]),
                       pack2(bflo(yy[2]) + bflo(gg[2]) * a1[0], bfhi(yy[2]) + bfhi(gg[2]) * a1[1]), pack2(bflo(yy[3]) + bflo(gg[3]) * a1[2], bfhi(yy[3]) + bfhi(gg[3]) * a1[3])};
            if (i3 < 2) *(u32x4*)(gbase + (go + (unsigned)((64 + ((ai * 2 + bj) * 4 + m) * 4) * 4))) = o;
            else {
              bf16_t* d = dst + (size_t)(128 * ai + 16 * m) * 1024 + 128 * bj;
              u32x2 o0 = {o[0], o[1]}, o1 = {o[2], o[3]};
              *(u32x2*)(d) = o0; *(u32x2*)(d + 16) = o1;
            }
          }
        asm volatile("" ::: "memory"); __builtin_amdgcn_sched_barrier(0);
      }
    }
  }
};

DI void phase4(const Params& p, int l, char* smem) {
  Sched4 S; S.tw.init(128, 4); S.h = (const char*)p.h; S.W = (const char*)(p.WinT + (size_t)l * 7424 * 1024);
  S.Pm = (const char*)p.Pm; S.Wb = (const char*)(p.WbT + (size_t)l * 3 * 1024 * 512);
  Epi4 E{p, (char*)(p.gsc + (size_t)blockIdx.x * 512 * 128), (unsigned)get_tid() * 512u};
  g8::gemm_phase<false>(smem, S, E);
}

struct Sched5 {
  TileWalk tw; const char* y; const char* Wo;
  DI bool next(int i, g8::Unit& u) const {
    int mt, pn2;
    if (!tw.at(i, mt, pn2)) return false;
    u.A = y + (size_t)mt * 256 * 2048; u.lda2 = 2048; u.B = Wo + (size_t)pn2 * 256 * 2048; u.ldb2 = 2048; u.nt = 16;
    u.kind = 0; u.i0 = mt; u.i1 = pn2; u.i2 = 0;
    return true;
  }
};
struct Epi5 {
  const Params& p; int l;
  DI void operator()(const f32x4 (&acc)[2][2][4][2], const g8::Unit& u, int wr, int wc, int fr, int fq) const {
    const int mt = u.i0, row0 = mt * 256, col0 = u.i1 * 256 + 32 * wc + 4 * fq;
    const bool isctx = mt >= 128;
    const float* xlat = l == 0 ? p.x : p.out;
    const float* src = (isctx ? p.ctx + (size_t)(row0 - NLAT) * 1024 : xlat + (size_t)row0 * 1024) + (size_t)(64 * wr + fr) * 1024 + col0;
    float* dst = (isctx ? p.xc1 + (size_t)(row0 - NLAT) * 1024 : p.out + (size_t)row0 * 1024) + (size_t)(64 * wr + fr) * 1024 + col0;
    const float* gate = p.mod + (l * 5 + (isctx ? 4 : (mt >> 5))) * 3072 + 2048 + col0;
    f32x4 gt[2][2];
#pragma unroll
    for (int bj = 0; bj < 2; ++bj)
#pragma unroll
      for (int n = 0; n < 2; ++n) gt[bj][n] = *(const f32x4*)(gate + 128 * bj + 16 * n);
#pragma unroll
    for (int ai = 0; ai < 2; ++ai) {
      f32x4 xv[4][2][2];
#pragma unroll
      for (int m = 0; m < 4; ++m)
#pragma unroll
        for (int bj = 0; bj < 2; ++bj)
#pragma unroll
          for (int n = 0; n < 2; ++n) xv[m][bj][n] = *(const f32x4*)(src + (size_t)(128 * ai + 16 * m) * 1024 + 128 * bj + 16 * n);
#pragma unroll
      for (int m = 0; m < 4; ++m)
#pragma unroll
        for (int bj = 0; bj < 2; ++bj)
#pragma unroll
          for (int n = 0; n < 2; ++n) *(f32x4*)(dst + (size_t)(128 * ai + 16 * m) * 1024 + 128 * bj + 16 * n) = xv[m][bj][n] + gt[bj][n] * acc[ai][bj][m][n];
      asm volatile("" ::: "memory"); __builtin_amdgcn_sched_barrier(0);
    }
  }
};

DI void grid_barrier(unsigned* ctr, unsigned k);
DI void phase5(const Params& p, int l, char* smem, unsigned& kbar) {
  Sched5 S; S.tw.init(128, 4); S.y = (const char*)p.y; S.Wo = (const char*)(p.WoT + (size_t)l * 1024 * 1024);
  const int bid = get_bid();
  if (l == 0) { S.tw.lb = (bid - 32) >> 3; S.tw.nbx = ((int)gridDim.x - 32) >> 3; }
  Epi5 E{p, l};
  if (l != 0 || bid >= 32) g8::gemm_phase<false>(smem, S, E);
  if (l == 0) {
    if (bid < 32) ctx_small_phase(p, l, smem, false);
    grid_barrier(p.bar, ++kbar);
    ctx_small_phase(p, l, smem, true);
  }
}

DI void grid_barrier(unsigned* ctr, unsigned k) {
  __syncthreads();
  if (threadIdx.x == 0) {
    __builtin_amdgcn_fence(__ATOMIC_RELEASE, "agent");
    asm volatile("s_waitcnt vmcnt(0)" ::: "memory");
    const unsigned members = gridDim.x >> 3;
    const unsigned old = __hip_atomic_fetch_add(ctr + 32 * (1 + (blockIdx.x & 7)), 1u, __ATOMIC_RELAXED, __HIP_MEMORY_SCOPE_AGENT);
    if (old == k * members - 1u) __hip_atomic_fetch_add(ctr, 1u, __ATOMIC_RELAXED, __HIP_MEMORY_SCOPE_AGENT);
    while (__hip_atomic_load(ctr, __ATOMIC_RELAXED, __HIP_MEMORY_SCOPE_AGENT) < 8u * k) __builtin_amdgcn_s_sleep(1);
    __builtin_amdgcn_fence(__ATOMIC_ACQUIRE, "agent");
    asm volatile("s_waitcnt vmcnt(0)" ::: "memory");
  }
  __syncthreads();
}

#ifndef PROBE_SEL
#define PROBE_SEL -1
#endif
__global__ void __launch_bounds__(512, 2) fwd_kernel(Params p, int ph0, int ph1) {
  __shared__ __attribute__((aligned(16))) char smem[SMEM_BYTES];
  cg::grid_group grid = cg::this_grid();
  unsigned kbar = 0;
  unsigned long long t_prev = PROBE_SEL >= 0 ? __builtin_amdgcn_s_memrealtime() : 0ull, t_sel = 0;
  for (int ph = ph0; ph < ph1; ++ph) {
    if (ph == 0) phase0(p, smem);
    else {
      const int l = (ph - 1) / 5, s = (ph - 1) % 5;
      if (s == 0) phase1(p, l);
      else if (s == 1) phase2(p, l, smem);
      else if (s == 2) phase3(p, l, smem);
      else if (s == 3) phase4(p, l, smem);
      else phase5(p, l, smem, kbar);
    }
    if (ph + 1 < ph1) {
      if (ph1 > 64) grid.sync();
      else grid_barrier(p.bar, ++kbar);
    }
    if (PROBE_SEL >= 0) {
      const unsigned long long t_now = __builtin_amdgcn_s_memrealtime();
      const int slot = ph == 0 ? 0 : 1 + (ph - 1) % 5;
      if (slot == PROBE_SEL) t_sel += t_now - t_prev;
      t_prev = t_now;
    }
  }
  if (PROBE_SEL >= 0 && blockIdx.x == 0 && threadIdx.x == 0) {
    const unsigned long long t0 = __builtin_amdgcn_s_memrealtime();
    while (__builtin_amdgcn_s_memrealtime() - t0 < t_sel) __builtin_amdgcn_s_sleep(8);
  }
}

extern "C" void kernel_launch(void* const* d_in, const int* in_sizes, int n_in, void* d_out, int out_size,
                              void* d_ws, size_t ws_size, hipStream_t stream) {
  static int grid_blocks = 0;
  if (!grid_blocks) {
    int dev = 0, cus = 0, per_cu = 0;
    (void)hipGetDevice(&dev);
    (void)hipDeviceGetAttribute(&cus, hipDeviceAttributeMultiprocessorCount, dev);
    (void)hipOccupancyMaxActiveBlocksPerMultiprocessor(&per_cu, fwd_kernel, 512, 0);
    if (per_cu > 1) per_cu = 1;
    if (per_cu < 1) per_cu = 1;
    grid_blocks = (cus * per_cu) & ~7;
  }
  Params p{};
  p.x = (const float*)d_in[0]; p.c = (const float*)d_in[1]; p.ctx = (const float*)d_in[2]; p.c_ctx = (const float*)d_in[3];
  p.ada_w = (const float*)d_in[4]; p.ada_b = (const float*)d_in[5]; p.norm_g = (const float*)d_in[6]; p.w_in = (const float*)d_in[7];
  p.pool_w = (const float*)d_in[8]; p.pool_scale = (const float*)d_in[9]; p.dqn = (const float*)d_in[10]; p.dkn = (const float*)d_in[11];
  p.dlam = (const float*)d_in[12]; p.dsub = (const float*)d_in[13]; p.gqn = (const float*)d_in[14]; p.gkn = (const float*)d_in[15];
  p.w_branch = (const float*)d_in[16]; p.w_out = (const float*)d_in[17];
  p.out = (float*)d_out;
  char* ws = (char*)d_ws; size_t off = 0;
  auto take = [&](size_t bytes) { char* q = ws + off; off += (bytes + 255) & ~(size_t)255; return q; };
  p.mod = (float*)take(2 * 5 * 3072 * 4);
  p.consts = (float*)take(256);
  p.bar = (unsigned*)take(2048);
  p.WinT = (bf16_t*)take((size_t)2 * 7424 * 1024 * 2);
  p.WbT = (bf16_t*)take((size_t)2 * 3 * 1024 * 512 * 2);
  p.WoT = (bf16_t*)take((size_t)2 * 1024 * 1024 * 2);
  p.WpT = (bf16_t*)take((size_t)2 * 4 * 128 * 128 * 2);
  p.h = (bf16_t*)take((size_t)NTOK * 1024 * 2);
  p.y = (bf16_t*)take((size_t)NTOK * 1024 * 2);
  p.Pm = (bf16_t*)take((size_t)NTOK * PMW * 2);
  p.DK = (bf16_t*)take((size_t)4 * NKEY * 512 * 2);
  p.DVt = (bf16_t*)take((size_t)4 * NKEY * 512 * 2);
  p.GK = (bf16_t*)take((size_t)4 * NKEY * 128 * 2);
  p.GVt = (bf16_t*)take((size_t)4 * NKEY * 128 * 2);
  p.xc1 = (float*)take((size_t)1024 * 1024 * 4);
  p.gsc = (unsigned*)p.DK;
  p.stash = (float*)p.y;
  if (off > ws_size) { fprintf(stderr, "workspace too small: need %zu have %zu\n", off, ws_size); return; }
#if MULTI_LAUNCH
  for (int ph = 0; ph < 11; ++ph) hipLaunchKernelGGL(fwd_kernel, dim3(grid_blocks), dim3(512), 0, stream, p, ph, ph + 1);
#else
  (void)hipMemsetAsync(p.bar, 0, 2048, stream);
  int ph0 = 0, ph1 = 11;
  void* args[] = {&p, &ph0, &ph1};
  hipError_t e = hipLaunchCooperativeKernel((void*)fwd_kernel, dim3(grid_blocks), dim3(512), args, 0, stream);
  if (e != hipSuccess) fprintf(stderr, "cooperative launch failed: %s (grid %d)\n", hipGetErrorString(e), grid_blocks);
#endif
}
```

```cpp
#include <hip/hip_runtime.h>
#include <hip/hip_cooperative_groups.h>
#include <cstdio>
namespace cg = cooperative_groups;

typedef unsigned short bf16_t;
typedef short bf16x8 __attribute__((ext_vector_type(8)));
typedef float f32x16 __attribute__((ext_vector_type(16)));
typedef float f32x4 __attribute__((ext_vector_type(4)));
typedef float f32x2 __attribute__((ext_vector_type(2)));
typedef unsigned u32x4 __attribute__((ext_vector_type(4)));
typedef unsigned u32x2 __attribute__((ext_vector_type(2)));
typedef __bf16 bf16v2 __attribute__((ext_vector_type(2)));

#define DI __device__ __forceinline__
#define MFMA(a, b, c) __builtin_amdgcn_mfma_f32_32x32x16_bf16((a), (b), (c), 0, 0, 0)

#ifndef MULTI_LAUNCH
#define MULTI_LAUNCH 0
#endif

constexpr int NLAT = 32768, NTOK = 33792, NKEY = 8448;
constexpr int PMW = 3072;
constexpr int C_U = 0, C_ZP = 512, C_DQ = 1024, C_ZD = 1536, C_GQ = 2048, C_ZG = 2560;
constexpr int TROW = 144;
constexpr int TILEB = 128 * TROW;
constexpr int TILE256 = 256 * TROW;
constexpr int STAGE8 = 2 * TILE256;
constexpr int SMEM_BYTES = 2 * STAGE8;
constexpr int GRP_SMEM = STAGE8;
constexpr int ABUF = 64 * TROW + 128 * TROW;
constexpr float LOG2E = 1.4426950408889634f;

struct Params {
  const float *x, *c, *ctx, *c_ctx, *ada_w, *ada_b, *norm_g, *w_in, *pool_w, *pool_scale, *dqn, *dkn, *dlam, *dsub, *gqn, *gkn, *w_branch, *w_out;
  float* out;
  float* mod;
  float* consts;
  bf16_t *WinT, *WbT, *WoT, *WpT, *h, *y, *Pm, *DK, *DVt, *GK, *GVt;
  float* xc1;
  float* stash;
  unsigned* gsc;
  unsigned* bar;
};

DI unsigned pack2(float a, float b) { f32x2 v = {a, b}; bf16v2 r = __builtin_convertvector(v, bf16v2); return __builtin_bit_cast(unsigned, r); }
DI bf16_t f2bf(float a) { return (bf16_t)(pack2(a, a) & 0xffffu); }
DI float bf2f(unsigned v) { return __uint_as_float(v << 16); }
DI float bflo(unsigned v) { return __uint_as_float(v << 16); }
DI float bfhi(unsigned v) { return __uint_as_float(v & 0xffff0000u); }
DI float fast_sigmoid(float v) { return __builtin_amdgcn_rcpf(1.f + __expf(-v)); }
DI float fast_silu(float v) { return v * fast_sigmoid(v); }
DI float wave_sum(float v) {
#pragma unroll
  for (int o = 32; o >= 1; o >>= 1) v += __shfl_xor(v, o);
  return v;
}
DI float wave_max(float v) {
#pragma unroll
  for (int o = 32; o >= 1; o >>= 1) v = fmaxf(v, __shfl_xor(v, o));
  return v;
}
DI int get_tid() { int t = threadIdx.x; asm volatile("" : "+v"(t)); return t; }
template <typename T> DI const T* opaque(const T* q) { asm volatile("" : "+s"(q)); return q; }
DI int get_bid() { int b = blockIdx.x; asm volatile("" : "+s"(b)); return b; }
DI int crow(int reg, int h) { return (reg & 3) + 8 * (reg >> 2) + 4 * h; }

namespace g8 {
#define G8_LAS __attribute__((address_space(3)))
constexpr int BK = 64, HALF = 128, HTB = HALF * BK * 2, STAGE_BYTES = 8 * HTB;
DI int lds_byte(int r, int c) { const int st = (r >> 4) * 2 + (c >> 5), rr = r & 15, cc = c & 31, ob = rr * 64 + cc * 2; return st * 1024 + (ob ^ (((ob >> 9) & 1) << 5)); }
DI void stage_rc(int b, int& R, int& C) { const int st = b / 1024, sb = b % 1024, swz = sb ^ (((sb >> 9) & 1) << 5); R = (st >> 1) * 16 + swz / 64; C = (st & 1) * 32 + (swz % 64) / 2; }

struct Unit {
  const char* A; const char* B;
  int lda2, ldb2;
  int nt;
  int kind, i0, i1, i2;
};

template <bool SIGMA, class Sched, class Epi>
DI void gemm_phase(char* smem, const Sched& S, const Epi& E) {
  G8_LAS unsigned char* lds = (G8_LAS unsigned char*)smem;
  const int tid = get_tid(), wid = __builtin_amdgcn_readfirstlane(tid >> 6), lane = tid & 63, wr = wid >> 2, wc = wid & 3, fr = lane & 15, fq = lane >> 4;
  int Rn[2], Rb[2], C2[2];
#pragma unroll
  for (int i = 0; i < 2; ++i) { int R, C; stage_rc(tid * 16 + i * 8192, R, C); Rn[i] = R; Rb[i] = SIGMA ? 64 * (R >> 5) + (R & 31) : R; C2[i] = C * 2; }
  const unsigned ldsw = (unsigned)wid * 1024u;
  const int aoff = lds_byte(wr * 64 + fr, fq * 8), boff = lds_byte(wc * 32 + fr, fq * 8);
#define G8_SA(b, h) (((b) * 2 + (h)) * HTB)
#define G8_SB(b, h) ((4 + (b) * 2 + (h)) * HTB)
#define G8_STAGE(bufoff, gbase, RR, ld2) do { \
    __builtin_amdgcn_global_load_lds((const unsigned*)((const char*)(gbase) + (unsigned)((RR)[0] * (ld2) + C2[0])), (G8_LAS unsigned*)(lds + (bufoff) + ldsw), 16, 0, 0); \
    __builtin_amdgcn_global_load_lds((const unsigned*)((const char*)(gbase) + (unsigned)((RR)[1] * (ld2) + C2[1])), (G8_LAS unsigned*)(lds + (bufoff) + ldsw + 8192), 16, 0, 0); } while (0)
#define G8_LDA(dst, b, h) do { _Pragma("unroll") for (int m = 0; m < 4; ++m) _Pragma("unroll") for (int k = 0; k < 2; ++k) dst[m][k] = *(const G8_LAS bf16x8*)(lds + G8_SA(b, h) + aoff + m * 2048 + k * 1024); } while (0)
#define G8_LDB(dst, b, h) do { _Pragma("unroll") for (int n = 0; n < 2; ++n) _Pragma("unroll") for (int k = 0; k < 2; ++k) dst[n][k] = *(const G8_LAS bf16x8*)(lds + G8_SB(b, h) + boff + n * 2048 + k * 1024); } while (0)
#define G8_MMA(ai, bj, At, Bt) do { __builtin_amdgcn_s_setprio(1); _Pragma("unroll") for (int m = 0; m < 4; ++m) _Pragma("unroll") for (int n = 0; n < 2; ++n) _Pragma("unroll") for (int k = 0; k < 2; ++k) \
    acc[ai][bj][m][n] = __builtin_amdgcn_mfma_f32_16x16x32_bf16(Bt[n][k], At[m][k], acc[ai][bj][m][n], 0, 0, 0); __builtin_amdgcn_s_setprio(0); } while (0)
#define G8_WAIT_V(n) asm volatile("s_waitcnt vmcnt(" #n ")" ::: "memory")
#define G8_WAIT_L(n) asm volatile("s_waitcnt lgkmcnt(" #n ")" ::: "memory")
#define G8_BAR __builtin_amdgcn_s_barrier()
#define G8_SCHED __builtin_amdgcn_sched_barrier(0)
  Unit cur, nxt; int ui = 0;
  if (!S.next(0, cur)) return;
  f32x4 acc[2][2][4][2];
#pragma unroll
  for (int a = 0; a < 2; ++a)
#pragma unroll
    for (int b = 0; b < 2; ++b)
#pragma unroll
      for (int m = 0; m < 4; ++m)
#pragma unroll
        for (int n = 0; n < 2; ++n) acc[a][b][m][n] = (f32x4){0.f, 0.f, 0.f, 0.f};
  bf16x8 At[4][2], B0[2][2], B1[2][2];
  int lA = cur.lda2, lB = cur.ldb2;
  unsigned hA = (unsigned)(HALF * lA), hB = (unsigned)((SIGMA ? 32 : HALF) * lB);
  const size_t kstep = (size_t)(BK * 2);
  const char* cA = cur.A; const char* cB = cur.B;
  G8_STAGE(G8_SB(0, 0), cB, Rb, lB); G8_STAGE(G8_SA(0, 0), cA, Rn, lA); G8_STAGE(G8_SB(0, 1), cB + hB, Rb, lB); G8_STAGE(G8_SA(0, 1), cA + hA, Rn, lA);
  if (wr == 1) G8_BAR;
  G8_WAIT_V(4); G8_BAR;
  G8_STAGE(G8_SB(1, 0), cB + kstep, Rb, lB); G8_STAGE(G8_SA(1, 0), cA + kstep, Rn, lA); G8_STAGE(G8_SB(1, 1), cB + hB + kstep, Rb, lB);
  G8_WAIT_V(6); G8_BAR;
  for (;;) {
    const bool has_next = S.next(ui + 1, nxt);
    const char* nA = has_next ? nxt.A : cA; const char* nB = has_next ? nxt.B : cB;
    const int nlA = has_next ? nxt.lda2 : lA, nlB = has_next ? nxt.ldb2 : lB;
    const unsigned nhA = (unsigned)(HALF * nlA), nhB = (unsigned)((SIGMA ? 32 : HALF) * nlB);
    const int nt = cur.nt;
    for (int t = 0; t < nt; t += 2) {
      const bool last = (t == nt - 2);
      const char* a1 = cA + (size_t)(t + 1) * kstep;
      const char* a2 = last ? nA : cA + (size_t)(t + 2) * kstep; const char* b2 = last ? nB : cB + (size_t)(t + 2) * kstep;
      const char* a3 = a2 + kstep; const char* b3 = b2 + kstep;
      const int xlA = last ? nlA : lA, xlB = last ? nlB : lB;
      const unsigned xhA = last ? nhA : hA, xhB = last ? nhB : hB;
      G8_LDB(B0, 0, 0); G8_SCHED; G8_LDA(At, 0, 0); G8_STAGE(G8_SA(1, 1), a1 + hA, Rn, lA);
      G8_WAIT_L(8); G8_BAR; G8_WAIT_L(0); G8_MMA(0, 0, At, B0); G8_BAR; G8_SCHED;
      G8_LDB(B1, 0, 1); G8_STAGE(G8_SB(0, 0), b2, Rb, xlB);
      G8_BAR; G8_WAIT_L(0); G8_MMA(0, 1, At, B1); G8_BAR;
      G8_LDA(At, 0, 1); G8_STAGE(G8_SA(0, 0), a2, Rn, xlA);
      G8_BAR; G8_WAIT_L(0); G8_MMA(1, 0, At, B0); G8_BAR; G8_SCHED;
      G8_STAGE(G8_SB(0, 1), b2 + xhB, Rb, xlB);
      G8_WAIT_V(6); G8_BAR; G8_MMA(1, 1, At, B1); G8_BAR;
      G8_LDB(B0, 1, 0); G8_SCHED; G8_LDA(At, 1, 0); G8_STAGE(G8_SA(0, 1), a2 + xhA, Rn, xlA);
      G8_WAIT_L(8); G8_BAR; G8_WAIT_L(0); G8_MMA(0, 0, At, B0); G8_BAR; G8_SCHED;
      G8_LDB(B1, 1, 1); G8_STAGE(G8_SB(1, 0), b3, Rb, xlB);
      G8_BAR; G8_WAIT_L(0); G8_MMA(0, 1, At, B1); G8_BAR;
      G8_LDA(At, 1, 1); G8_STAGE(G8_SA(1, 0), a3, Rn, xlA);
      G8_BAR; G8_WAIT_L(0); G8_MMA(1, 0, At, B0); G8_BAR; G8_SCHED;
      G8_STAGE(G8_SB(1, 1), b3 + xhB, Rb, xlB);
      G8_WAIT_V(6); G8_BAR; G8_MMA(1, 1, At, B1); G8_BAR;
    }
    E(acc, cur, wr, wc, fr, fq);
    if (!has_next) break;
#pragma unroll
    for (int a = 0; a < 2; ++a)
#pragma unroll
      for (int b = 0; b < 2; ++b)
#pragma unroll
        for (int m = 0; m < 4; ++m)
#pragma unroll
          for (int n = 0; n < 2; ++n) acc[a][b][m][n] = (f32x4){0.f, 0.f, 0.f, 0.f};
    cur = nxt; cA = nA; cB = nB; lA = nlA; lB = nlB; hA = nhA; hB = nhB; ++ui;
  }
  G8_WAIT_V(0);
  if (wr == 0) G8_BAR;
  G8_BAR;
#undef G8_SA
#undef G8_SB
#undef G8_STAGE
#undef G8_LDA
#undef G8_LDB
#undef G8_MMA
#undef G8_WAIT_V
#undef G8_WAIT_L
#undef G8_BAR
#undef G8_SCHED
}
}

DI void zero_acc22(f32x16 (&acc)[2][2]) {
#pragma unroll
  for (int i = 0; i < 2; ++i)
#pragma unroll
    for (int j = 0; j < 2; ++j)
#pragma unroll
      for (int e = 0; e < 16; ++e) acc[i][j][e] = 0.f;
}

struct TileWalk {
  int MP, pwf, wlast, nfull, npart, extra, NPf, x, lb, nbx;
  DI void init(int MT, int NT) {
    const int bid = get_bid(); x = bid & 7; lb = bid >> 3; nbx = gridDim.x >> 3;
    MP = MT >> 2;
    if (NT <= 8) { pwf = NT; NPf = 1; wlast = 0; nfull = MP; npart = 0; }
    else { pwf = 8; NPf = NT >> 3; wlast = NT - 8 * NPf; nfull = NPf * MP; npart = wlast ? MP : 0; }
    extra = nfull & 7;
  }
  DI bool at(int it, int& m, int& n) const {
    const int j = lb + it * nbx;
    const int kf = x < nfull ? (nfull - x + 7) >> 3 : 0, tf = 4 * pwf;
    if (j < kf * tf) {
      const int k = j / tf, q = j % tf, id = x + 8 * k, np = id / MP, mp = id % MP;
      m = mp * 4 + (q & 3); n = np * 8 + (q >> 2);
    } else {
      if (npart == 0 || x < extra) return false;
      const int j2 = j - kf * tf, tp = 4 * wlast, pj = (x - extra) + (8 - extra) * (j2 / tp), q = j2 % tp;
      if (pj >= npart) return false;
      m = pj * 4 + (q & 3); n = NPf * 8 + (q >> 2);
    }
    return true;
  }
};

struct TrDesc { const float* src; bf16_t* dst; int N, K; };
DI TrDesc tr_desc(const Params& p, int u) {
  constexpr int PER_L = 1856 + 384 + 256 + 16;
  const int l = u / PER_L; int r = u % PER_L;
  TrDesc d; int kt, nt;
  if (r < 1856) { d.src = p.w_in + (size_t)l * 1024 * 7424; d.N = 7424; d.dst = p.WinT + (size_t)l * 7424 * 1024; d.K = 1024; kt = r / 116; nt = r % 116; }
  else if (r < 2240) { r -= 1856; const int i = r >> 7, r2 = r & 127; d.src = p.w_branch + (size_t)(l * 3 + i) * 512 * 1024; d.N = 1024; d.dst = p.WbT + (size_t)(l * 3 + i) * 1024 * 512; d.K = 512; kt = r2 >> 4; nt = r2 & 15; }
  else if (r < 2496) { r -= 2240; d.src = p.w_out + (size_t)l * 1024 * 1024; d.N = 1024; d.dst = p.WoT + (size_t)l * 1024 * 1024; d.K = 1024; kt = r >> 4; nt = r & 15; }
  else { r -= 2496; const int g = r >> 2; d.src = p.pool_w + (size_t)(l * 4 + g) * 128 * 128; d.N = 128; d.dst = p.WpT + (size_t)(l * 4 + g) * 128 * 128; d.K = 128; kt = (r >> 1) & 1; nt = r & 1; }
  d.src += (size_t)(kt * 64) * d.N + nt * 64;
  d.dst += (size_t)(nt * 64) * d.K + kt * 64;
  return d;
}
DI void tr_load(f32x4 (&v)[2], const TrDesc& d, int tid) {
#pragma unroll
  for (int q = 0; q < 2; ++q) { const int idx = tid + 512 * q, row = idx >> 4, c4 = idx & 15; v[q] = *(const f32x4*)(d.src + (size_t)row * d.N + c4 * 4); }
}
DI void tr_finish(const f32x4 (&v)[2], const TrDesc& d, int tid, char* smem) {
  float* t = (float*)smem;
#pragma unroll
  for (int q = 0; q < 2; ++q) {
    const int idx = tid + 512 * q, row = idx >> 4, c4 = idx & 15;
    t[row * 65 + c4 * 4 + 0] = v[q][0]; t[row * 65 + c4 * 4 + 1] = v[q][1]; t[row * 65 + c4 * 4 + 2] = v[q][2]; t[row * 65 + c4 * 4 + 3] = v[q][3];
  }
  __syncthreads();
  {
    const int jn = tid >> 3, kc = tid & 7;
    u32x4 o;
#pragma unroll
    for (int e = 0; e < 4; ++e) o[e] = pack2(t[(kc * 8 + 2 * e) * 65 + jn], t[(kc * 8 + 2 * e + 1) * 65 + jn]);
    *(u32x4*)(d.dst + (size_t)jn * d.K + kc * 8) = o;
  }
  __syncthreads();
}

DI void phase0(const Params& p, char* smem) {
  const int tid = get_tid(), lane = tid & 63, w = tid >> 6;
  constexpr int PER_L = 1856 + 384 + 256 + 16;
  constexpr int NTR = 2 * PER_L, NADA = 96;
  {
    int u = blockIdx.x; bool have = u < NTR;
    TrDesc d; f32x4 v[2];
    if (have) { d = tr_desc(p, u); tr_load(v, d, tid); }
    while (have) {
      const int un = u + gridDim.x; const bool hn = un < NTR;
      TrDesc dn = d; f32x4 vn[2] = {v[0], v[1]};
      if (hn) { dn = tr_desc(p, un); tr_load(vn, dn, tid); }
      tr_finish(v, d, tid, smem);
      u = un; have = hn; d = dn; v[0] = vn[0]; v[1] = vn[1];
    }
  }
  for (int u = blockIdx.x; u < NTR + NADA + 1; u += gridDim.x) {
    if (u < NTR) {
      continue;
    } else if (u < NTR + NADA) {
      const int a = u - NTR, l = a / 48, n0 = (a % 48) * 64;
      float* s = (float*)smem;
      for (int i = tid; i < 5 * 1024; i += 512) {
        const int rr = i >> 10, k = i & 1023;
        const float v = rr < 4 ? p.c[rr * 1024 + k] : p.c_ctx[k];
        s[i] = v / (1.f + __expf(-v));
      }
      __syncthreads();
      float a5[5] = {0.f, 0.f, 0.f, 0.f, 0.f};
      const float* wp = p.ada_w + (size_t)l * 1024 * 3072 + n0 + lane;
      for (int k0 = w * 128; k0 < w * 128 + 128; k0 += 16) {
        float wv[16];
#pragma unroll
        for (int u = 0; u < 16; ++u) wv[u] = wp[(size_t)(k0 + u) * 3072];
#pragma unroll
        for (int u = 0; u < 16; ++u)
#pragma unroll
          for (int rr = 0; rr < 5; ++rr) a5[rr] += s[rr * 1024 + k0 + u] * wv[u];
      }
      __syncthreads();
      float* part = (float*)smem + 5 * 1024;
#pragma unroll
      for (int rr = 0; rr < 5; ++rr) part[(w * 5 + rr) * 64 + lane] = a5[rr];
      __syncthreads();
      for (int i = tid; i < 5 * 64; i += 512) {
        const int rr = i >> 6, nn = i & 63;
        float v = 0.f;
#pragma unroll
        for (int ww = 0; ww < 8; ++ww) v += part[(ww * 5 + rr) * 64 + nn];
        p.mod[(l * 5 + rr) * 3072 + n0 + nn] = v + p.ada_b[l * 3072 + n0 + nn];
      }
      __syncthreads();
    } else {
      if (w == 0) {
#pragma unroll 1
        for (int l = 0; l < 2; ++l) {
          const float* lp = opaque(p.dlam + l * 256);
          const float s1 = wave_sum(lp[lane] * lp[64 + lane]);
          const float s2 = wave_sum(lp[128 + lane] * lp[192 + lane]);
          const float lam_init = 0.8f - 0.6f * expf(-0.3f * (float)l);
          const float lam = expf(s1) - expf(s2) + lam_init;
          const float mdq = wave_max(fabsf(p.dqn[l * 64 + lane])), mdk = wave_max(fabsf(p.dkn[l * 64 + lane]));
          const float mgq = wave_max(fabsf(p.gqn[l * 64 + lane])), mgk = wave_max(fabsf(p.gkn[l * 64 + lane]));
          if (lane == 0) {
            p.consts[l * 4 + 0] = lam;
            p.consts[l * 4 + 1] = -(LOG2E * 8.f * mdq * mdk);
            p.consts[l * 4 + 2] = -(LOG2E * 8.f * mgq * mgk);
            p.consts[l * 4 + 3] = lam_init;
          }
        }
      }
    }
  }
}

DI void phase1(const Params& p, int l) {
  const int tid = get_tid(), lane = tid & 63, w = tid >> 6;
  const float* xlat = l == 0 ? p.x : p.out;
  const float* xctx = l == 0 ? p.ctx : p.xc1;
  const float* g = p.norm_g + l * 1024;
  f32x4 ma[4], mb[4]; int cur_mr = -1;
  for (int rb = blockIdx.x * 16; rb < NTOK; rb += gridDim.x * 16) {
    const int mr = rb < NLAT ? (rb >> 13) : 4;
    f32x4 v[2][4];
#pragma unroll
    for (int u = 0; u < 2; ++u) {
      const int row = rb + 2 * w + u;
      const float* sp = row < NLAT ? xlat + (size_t)row * 1024 : xctx + (size_t)(row - NLAT) * 1024;
#pragma unroll
      for (int q = 0; q < 4; ++q) v[u][q] = *(const f32x4*)(sp + q * 256 + lane * 4);
    }
    if (mr != cur_mr) {
      cur_mr = mr;
      const float* md = p.mod + (l * 5 + mr) * 3072;
#pragma unroll
      for (int q = 0; q < 4; ++q) {
        const int k = q * 256 + lane * 4;
        const f32x4 gg = *(const f32x4*)(g + k), sc = *(const f32x4*)(md + 1024 + k);
        mb[q] = *(const f32x4*)(md + k);
        ma[q] = gg * (1.f + sc);
      }
    }
    float ss[2];
#pragma unroll
    for (int u = 0; u < 2; ++u) {
      float s2 = 0.f;
#pragma unroll
      for (int q = 0; q < 4; ++q) s2 += v[u][q][0] * v[u][q][0] + v[u][q][1] * v[u][q][1] + v[u][q][2] * v[u][q][2] + v[u][q][3] * v[u][q][3];
      ss[u] = wave_sum(s2);
    }
#pragma unroll
    for (int u = 0; u < 2; ++u) {
      const int row = rb + 2 * w + u;
      const float rstd = __builtin_amdgcn_rsqf(ss[u] * (1.f / 1024.f) + 1e-6f);
#pragma unroll
      for (int q = 0; q < 4; ++q) {
        const int k = q * 256 + lane * 4;
        float o[4];
#pragma unroll
        for (int e = 0; e < 4; ++e) o[e] = v[u][q][e] * rstd * ma[q][e] + mb[q][e];
        u32x2 pk = {pack2(o[0], o[1]), pack2(o[2], o[3])};
        *(u32x2*)(p.h + (size_t)row * 1024 + k) = pk;
      }
    }
  }
}

struct Sched2 {
  TileWalk tw; const char* h; const char* W;
  DI bool next(int i, g8::Unit& u) const {
    int mt, pn2;
    if (!tw.at(i, mt, pn2)) return false;
    u.A = h + (size_t)mt * 256 * 2048; u.B = W + (size_t)pn2 * 256 * 2048; u.lda2 = 2048; u.ldb2 = 2048; u.nt = 16;
    u.kind = 0; u.i0 = mt; u.i1 = pn2; u.i2 = 0;
    return true;
  }
};
struct Epi2 {
  const Params& p; int l;
  DI void operator()(const f32x4 (&acc)[2][2][4][2], const g8::Unit& u, int wr, int wc, int fr, int fq) const {
    const int mt = u.i0, pn2 = u.i1, row0 = mt * 256;
    const bool isctx = mt >= 128;
    const int b = isctx ? (mt - 128) : (mt >> 5);
    const int t0 = isctx ? 0 : (mt & 31) * 256;
    const int key0 = isctx ? 0 : 256 + t0;
    const int pn = 2 * pn2 + (wc >> 1), hc = (wc & 1) * 64;
    const bool plain = pn < 8 || (pn >= 20 && pn < 24) || pn >= 30;
    if (plain) {
      int pcol; bool silu;
      if (pn < 4) { pcol = pn * 128; silu = false; } else if (pn < 8) { pcol = pn * 128; silu = true; }
      else if (pn < 24) { pcol = pn * 128 - 1024; silu = true; } else { pcol = pn * 128 - 1280; silu = true; }
      char* dstb = (char*)(p.Pm + (size_t)row0 * PMW + pcol + hc);
      unsigned lo = (unsigned)((64 * wr + fr) * PMW + 4 * fq) * 2u;
      asm volatile("" : "+v"(lo));
#pragma unroll
      for (int ai = 0; ai < 2; ++ai)
#pragma unroll
        for (int m = 0; m < 4; ++m) {
#pragma unroll
          for (int bj = 0; bj < 2; ++bj)
#pragma unroll
            for (int n = 0; n < 2; ++n) {
              f32x4 v = acc[ai][bj][m][n];
              if (silu) { v[0] = fast_silu(v[0]); v[1] = fast_silu(v[1]); v[2] = fast_silu(v[2]); v[3] = fast_silu(v[3]); }
              u32x2 pk = {pack2(v[0], v[1]), pack2(v[2], v[3])};
              *(u32x2*)(dstb + (lo + (unsigned)(((128 * ai + 16 * m) * PMW + 32 * bj + 16 * n) * 2))) = pk;
            }
          asm volatile("" ::: "memory"); __builtin_amdgcn_sched_barrier(0);
        }
    } else if ((pn >= 16 && pn < 20) || pn == 29) {
      char* dstb = (char*)(pn == 29 ? p.GVt + ((size_t)b * 128 + hc) * NKEY + key0 : p.DVt + ((size_t)b * 512 + (pn - 16) * 128 + hc) * NKEY + key0);
      unsigned lo = (unsigned)((4 * fq) * NKEY + 64 * wr + fr) * 2u;
      asm volatile("" : "+v"(lo));
#pragma unroll
      for (int ai = 0; ai < 2; ++ai)
#pragma unroll
        for (int m = 0; m < 4; ++m) {
#pragma unroll
          for (int bj = 0; bj < 2; ++bj)
#pragma unroll
            for (int n = 0; n < 2; ++n)
#pragma unroll
              for (int j = 0; j < 4; ++j)
                *(bf16_t*)(dstb + (lo + (unsigned)(((32 * bj + 16 * n + j) * NKEY + 128 * ai + 16 * m) * 2))) = f2bf(acc[ai][bj][m][n][j]);
          asm volatile("" ::: "memory"); __builtin_amdgcn_sched_barrier(0);
        }
    } else {
      const float* gn; bf16_t* dst; int ldd; float oscale;
      if (pn < 12) { gn = p.dqn + l * 64; dst = p.Pm + (size_t)row0 * PMW + pn * 128 + hc; ldd = PMW; oscale = LOG2E * 0.125f; }
      else if (pn < 16) { gn = p.dkn + l * 64; dst = p.DK + ((size_t)b * NKEY + key0) * 512 + (pn - 12) * 128 + hc; ldd = 512; oscale = 1.f; }
      else if (pn < 28) { gn = p.gqn + l * 64; dst = p.Pm + (size_t)row0 * PMW + pn * 128 - 1024 + hc; ldd = PMW; oscale = LOG2E * 0.125f; }
      else { gn = p.gkn + l * 64; dst = p.GK + ((size_t)b * NKEY + key0) * 128 + hc; ldd = 128; oscale = 1.f; }
      gn = opaque(gn);
      int fro = fr; asm volatile("" : "+v"(fro));
      float inv[4];
#pragma unroll
      for (int j = 0; j < 4; ++j) inv[j] = __builtin_amdgcn_exp2f((float)(4 * (fro >> 30) + 4 * fq + j) * -0.8304820237218406f);
#pragma unroll
      for (int ai = 0; ai < 2; ++ai)
#pragma unroll
        for (int m = 0; m < 4; ++m) {
          const int tok = 128 * ai + 64 * wr + 16 * m + fro;
          f32x4 y[2][2]; float ss = 0.f;
#pragma unroll
          for (int bj = 0; bj < 2; ++bj)
#pragma unroll
            for (int n = 0; n < 2; ++n) { y[bj][n] = acc[ai][bj][m][n]; ss += y[bj][n][0] * y[bj][n][0] + y[bj][n][1] * y[bj][n][1] + y[bj][n][2] * y[bj][n][2] + y[bj][n][3] * y[bj][n][3]; }
          ss += __shfl_xor(ss, 16); ss += __shfl_xor(ss, 32);
          const float rstd = __builtin_amdgcn_rsqf(ss * (1.f / 64.f) + 1e-6f) ;
#pragma unroll
          for (int bj = 0; bj < 2; ++bj)
#pragma unroll
            for (int n = 0; n < 2; ++n) {
              const f32x4 g4 = *(const f32x4*)(gn + 32 * bj + 16 * n + 4 * fq);
#pragma unroll
              for (int j = 0; j < 4; ++j) y[bj][n][j] *= rstd * g4[j];
            }
          if (!isctx) {
            const int tseq = t0 + tok;
#pragma unroll
            for (int bj = 0; bj < 2; ++bj) {
              const float pos = (float)(bj == 0 ? (tseq >> 6) : (tseq & 63));
#pragma unroll
              for (int j = 0; j < 4; ++j) {
                const float ang = pos * inv[j];
                const float cs = __cosf(ang), sn = __sinf(ang);
                const float x1 = y[bj][0][j], x2 = y[bj][1][j];
                y[bj][0][j] = x1 * cs - x2 * sn; y[bj][1][j] = x1 * sn + x2 * cs;
              }
            }
          }
          const unsigned ro = (unsigned)(tok * ldd + 4 * fq) * 2u;
#pragma unroll
          for (int bj = 0; bj < 2; ++bj)
#pragma unroll
            for (int n = 0; n < 2; ++n) {
              u32x2 pk = {pack2(y[bj][n][0] * oscale, y[bj][n][1] * oscale), pack2(y[bj][n][2] * oscale, y[bj][n][3] * oscale)};
              *(u32x2*)((char*)dst + (ro + (unsigned)((32 * bj + 16 * n) * 2))) = pk;
            }
          asm volatile("" ::: "memory"); __builtin_amdgcn_sched_barrier(0);
        }
    }
  }
};

DI void phase2(const Params& p, int l, char* smem) {
  Sched2 S; S.tw.init(132, 17); S.h = (const char*)p.h; S.W = (const char*)(p.WinT + (size_t)l * 7424 * 1024);
  Epi2 E{p, l};
  g8::gemm_phase<true>(smem, S, E);
}

DI void softmax_step(f32x16& S, float& l0, float& l1, bf16x8 (&pf)[2]) {
#pragma unroll
  for (int e = 0; e < 16; ++e) S[e] = __builtin_amdgcn_exp2f(S[e]);
#pragma unroll
  for (int e = 0; e < 8; ++e) { l0 += S[2 * e]; l1 += S[2 * e + 1]; }
#pragma unroll
  for (int s = 0; s < 2; ++s) {
    u32x4 pk = {pack2(S[8 * s], S[8 * s + 1]), pack2(S[8 * s + 2], S[8 * s + 3]), pack2(S[8 * s + 4], S[8 * s + 5]), pack2(S[8 * s + 6], S[8 * s + 7])};
    pf[s] = __builtin_bit_cast(bf16x8, pk);
  }
}

constexpr int ABUFD = 8192 + 128 * 128;
DI int swz_off(int row, int c) { const int R = row >> 1; return R * 256 + (((((row & 1) << 3) | c) ^ (R & 15)) << 4); }
DI unsigned dma_src(int q, int lane, unsigned pitch) {
  const int R = 4 * q + (lane >> 4), C = (lane & 15) ^ (R & 15), row = 2 * R + (C >> 3), ch = C & 7;
  return (unsigned)row * pitch + (unsigned)ch * 16u;
}

template <int DV>
DI void attn_pass(f32x16 (&O)[DV / 32], float& lsum, const bf16x8 (&qf)[4], const bf16_t* __restrict__ Kb, int ldk, const bf16_t* __restrict__ Vt, int nkeys, char* smem) {
  constexpr int NV = DV / 32, NS = DV / 64;
  const int tid = get_tid(), lane = tid & 63, wid = __builtin_amdgcn_readfirstlane(tid >> 6), r = lane & 31, h = lane >> 5;
  const int pr = (r & 19) | ((r & 4) << 1) | ((r & 8) >> 1);
  const char* Kc = (const char*)Kb; const char* Vc = (const char*)Vt;
  G8_LAS unsigned char* lds = (G8_LAS unsigned char*)smem;
  const int nt = nkeys >> 6;
  const unsigned kpitch = (unsigned)ldk * 2u;
  const unsigned ksrc = dma_src(wid, lane, kpitch);
  unsigned vsrc[NS];
#pragma unroll
  for (int j = 0; j < NS; ++j) vsrc[j] = dma_src(wid + 8 * j, lane, (unsigned)NKEY * 2u);
#define ATT_ISSUE(kt_, b_) do { \
    __builtin_amdgcn_global_load_lds((const unsigned*)(Kc + (ksrc + (unsigned)(kt_) * 64u * kpitch)), (G8_LAS unsigned*)(lds + b_ + wid * 1024), 16, 0, 0); \
    _Pragma("unroll") for (int j_ = 0; j_ < NS; ++j_) \
      __builtin_amdgcn_global_load_lds((const unsigned*)(Vc + (vsrc[j_] + (unsigned)(kt_) * 128u)), (G8_LAS unsigned*)(lds + b_ + 8192 + (wid + 8 * j_) * 1024), 16, 0, 0); } while (0)
  ATT_ISSUE(0, 0);
  if (nt > 1) { ATT_ISSUE(1, ABUFD); if (NS == 2) asm volatile("s_waitcnt vmcnt(3)" ::: "memory"); else asm volatile("s_waitcnt vmcnt(2)" ::: "memory"); }
  else asm volatile("s_waitcnt vmcnt(0)" ::: "memory");
  __builtin_amdgcn_s_barrier();
  int ka[4], va[2][2];
#pragma unroll
  for (int t = 0; t < 4; ++t) ka[t] = swz_off(pr, 2 * t + h);
#pragma unroll
  for (int sb = 0; sb < 2; ++sb)
#pragma unroll
    for (int s = 0; s < 2; ++s) va[sb][s] = 8192 + swz_off(r, 4 * sb + 2 * s + h);
#pragma unroll
  for (int bk = 0; bk < NV; ++bk)
#pragma unroll
    for (int e = 0; e < 16; ++e) O[bk][e] = 0.f;
  float l0 = 0.f, l1 = 0.f;
  int bo = 0;
#pragma unroll 2
  for (int kt = 0; kt < nt; ++kt) {
    const char* cur = smem + bo;
    const int b2 = bo >= ABUFD ? bo - ABUFD : bo + 2 * ABUFD;
    if (kt + 2 < nt) ATT_ISSUE(kt + 2, b2);
    bf16x8 kf[2][4], vf[NV][2];
#pragma unroll
    for (int sb = 0; sb < 2; ++sb)
#pragma unroll
      for (int t = 0; t < 4; ++t) kf[sb][t] = *(const bf16x8*)(cur + ka[t] + sb * 4096);
#pragma unroll
    for (int bk = 0; bk < NV; ++bk)
#pragma unroll
      for (int s = 0; s < 2; ++s) vf[bk][s] = *(const bf16x8*)(cur + va[0][s] + bk * 4096);
    f32x16 S0, S1;
#pragma unroll
    for (int e = 0; e < 16; ++e) { S0[e] = 0.f; S1[e] = 0.f; }
#pragma unroll
    for (int t = 0; t < 4; ++t) S0 = MFMA(kf[0][t], qf[t], S0);
#pragma unroll
    for (int t = 0; t < 4; ++t) S1 = MFMA(kf[1][t], qf[t], S1);
    bf16x8 pf[2];
    softmax_step(S0, l0, l1, pf);
#pragma unroll
    for (int bk = 0; bk < NV; ++bk)
#pragma unroll
      for (int s = 0; s < 2; ++s) O[bk] = MFMA(vf[bk][s], pf[s], O[bk]);
#pragma unroll
    for (int bk = 0; bk < NV; ++bk)
#pragma unroll
      for (int s = 0; s < 2; ++s) vf[bk][s] = *(const bf16x8*)(cur + va[1][s] + bk * 4096);
    softmax_step(S1, l0, l1, pf);
#pragma unroll
    for (int bk = 0; bk < NV; ++bk)
#pragma unroll
      for (int s = 0; s < 2; ++s) O[bk] = MFMA(vf[bk][s], pf[s], O[bk]);
    if (kt + 2 < nt) { if (NS == 2) asm volatile("s_waitcnt vmcnt(3)" ::: "memory"); else asm volatile("s_waitcnt vmcnt(2)" ::: "memory"); }
    else asm volatile("s_waitcnt vmcnt(0)" ::: "memory");
    asm volatile("s_waitcnt lgkmcnt(0)" ::: "memory");
    __builtin_amdgcn_s_barrier();
    bo = bo == 2 * ABUFD ? 0 : bo + ABUFD;
  }
#undef ATT_ISSUE
  lsum = l0 + l1;
}

DI void load_q(bf16x8 (&qf)[4], const bf16_t* __restrict__ qp  , int h) {
#pragma unroll
  for (int t = 0; t < 4; ++t) qf[t] = *(const bf16x8*)(qp + 16 * t + 8 * h);
}

DI void diff_unit(const Params& p, int l, int b, int hh, int qrow0, int nkeys, char* smem) {
  f32x16 O[4]; float ls;
  float sc1 = 0.f;
#pragma unroll 1
  for (int c = 0; c < 2; ++c) {
    {
      const int tid = get_tid(), lane = tid & 63, w = tid >> 6, r = lane & 31, h = lane >> 5;
      bf16x8 qf[4];
      load_q(qf, p.Pm + (size_t)(qrow0 + 32 * w + r) * PMW + C_DQ + (2 * hh + c) * 64, h);
      attn_pass<128>(O, ls, qf, p.DK + (size_t)b * NKEY * 512 + (2 * hh + c) * 64, 512, p.DVt + ((size_t)b * 512 + hh * 128) * NKEY, nkeys, smem);
    }
    ls += __shfl_xor(ls, 32);
    if (c == 0) {
      const int tid = get_tid();
      float* st = p.stash + (size_t)blockIdx.x * 32768 + tid * 64;
      const float inv = 1.f / ls;
#pragma unroll
      for (int bk = 0; bk < 4; ++bk)
#pragma unroll
        for (int g4 = 0; g4 < 4; ++g4) {
          const f32x4 v4 = {O[bk][4 * g4] * inv, O[bk][4 * g4 + 1] * inv, O[bk][4 * g4 + 2] * inv, O[bk][4 * g4 + 3] * inv};
          *(f32x4*)(st + bk * 16 + g4 * 4) = v4;
        }
    } else sc1 = -p.consts[l * 4 + 0] / ls;
  }
  const int tid = get_tid(), lane = tid & 63, w = tid >> 6, r = lane & 31, h = lane >> 5;
  const float* st = p.stash + (size_t)blockIdx.x * 32768 + tid * 64;
  float ss = 0.f;
#pragma unroll
  for (int bk = 0; bk < 4; ++bk)
#pragma unroll
    for (int g4 = 0; g4 < 4; ++g4) {
      const f32x4 s4 = *(const f32x4*)(st + bk * 16 + g4 * 4);
#pragma unroll
      for (int e = 0; e < 4; ++e) { const float v = s4[e] + sc1 * O[bk][4 * g4 + e]; O[bk][4 * g4 + e] = v; ss += v * v; }
    }
  ss += __shfl_xor(ss, 32);
  const float rs = __builtin_amdgcn_rsqf(ss * (1.f / 128.f) + 1e-6f) * (1.f - p.consts[l * 4 + 3]);
  const float* sub = opaque(p.dsub + l * 128);
  bf16_t* zrow = p.Pm + (size_t)(qrow0 + 32 * w + r) * PMW + C_ZD + hh * 128;
#pragma unroll
  for (int bk = 0; bk < 4; ++bk)
#pragma unroll
    for (int g4 = 0; g4 < 4; ++g4) {
      const int dv0 = 32 * bk + 8 * g4 + 4 * h;
      const u32x2 z = *(const u32x2*)(zrow + dv0);
      const f32x4 sg = *(const f32x4*)(sub + dv0);
      const float o0 = O[bk][4 * g4] * rs * sg[0] * bflo(z[0]), o1 = O[bk][4 * g4 + 1] * rs * sg[1] * bfhi(z[0]);
      const float o2 = O[bk][4 * g4 + 2] * rs * sg[2] * bflo(z[1]), o3 = O[bk][4 * g4 + 3] * rs * sg[3] * bfhi(z[1]);
      u32x2 pk = {pack2(o0, o1), pack2(o2, o3)};
      *(u32x2*)(zrow + dv0) = pk;
      asm volatile("" ::: "memory"); __builtin_amdgcn_sched_barrier(0);
    }
}

DI void attn_pass_d2(f32x16 (&O)[2][4], float (&lsum)[2], const bf16x8 (&qf)[2][4], const bf16_t* __restrict__ Kb, const bf16_t* __restrict__ Vt, char* smem) {
  const int tid = get_tid(), lane = tid & 63, wid = __builtin_amdgcn_readfirstlane(tid >> 6), r = lane & 31, h = lane >> 5;
  const int pr = (r & 19) | ((r & 4) << 1) | ((r & 8) >> 1);
  const char* Kc = (const char*)Kb; const char* Vc = (const char*)Vt;
  G8_LAS unsigned char* lds = (G8_LAS unsigned char*)smem;
  constexpr int nt = NKEY >> 6;
  const unsigned ksrc = dma_src(wid, lane, 1024u), vsrc0 = dma_src(wid, lane, (unsigned)NKEY * 2u), vsrc1 = dma_src(wid + 8, lane, (unsigned)NKEY * 2u);
#define D2_ISSUE(kt_, b_) do { \
    __builtin_amdgcn_global_load_lds((const unsigned*)(Kc + (ksrc + (unsigned)(kt_) * 64u * 1024u)), (G8_LAS unsigned*)(lds + (b_) + wid * 1024), 16, 0, 0); \
    __builtin_amdgcn_global_load_lds((const unsigned*)(Vc + (vsrc0 + (unsigned)(kt_) * 128u)), (G8_LAS unsigned*)(lds + (b_) + 8192 + wid * 1024), 16, 0, 0); \
    __builtin_amdgcn_global_load_lds((const unsigned*)(Vc + (vsrc1 + (unsigned)(kt_) * 128u)), (G8_LAS unsigned*)(lds + (b_) + 8192 + (wid + 8) * 1024), 16, 0, 0); } while (0)
  D2_ISSUE(0, 0);
  D2_ISSUE(1, ABUFD);
  asm volatile("s_waitcnt vmcnt(3)" ::: "memory");
  __builtin_amdgcn_s_barrier();
  int ka[4], va[2][2];
#pragma unroll
  for (int t = 0; t < 4; ++t) ka[t] = swz_off(pr, 2 * t + h);
#pragma unroll
  for (int sb = 0; sb < 2; ++sb)
#pragma unroll
    for (int s2 = 0; s2 < 2; ++s2) va[sb][s2] = 8192 + swz_off(r, 4 * sb + 2 * s2 + h);
#pragma unroll
  for (int qb = 0; qb < 2; ++qb)
#pragma unroll
    for (int bk = 0; bk < 4; ++bk)
#pragma unroll
      for (int e = 0; e < 16; ++e) O[qb][bk][e] = 0.f;
  float l0[2] = {0.f, 0.f};
  int bo = 0;
#pragma unroll 1
  for (int kt = 0; kt < nt; ++kt) {
    const char* cur = smem + bo;
    const int b2 = bo >= ABUFD ? bo - ABUFD : bo + 2 * ABUFD;
    if (kt + 2 < nt) D2_ISSUE(kt + 2, b2);
#pragma unroll 1
    for (int sb = 0; sb < 2; ++sb) {
      bf16x8 pf0[2], pf1[2];
      {
        bf16x8 kf[4];
#pragma unroll
        for (int t = 0; t < 4; ++t) kf[t] = *(const bf16x8*)(cur + ka[t] + sb * 4096);
        f32x16 S0, S1;
#pragma unroll
        for (int e = 0; e < 16; ++e) { S0[e] = 0.f; S1[e] = 0.f; }
#pragma unroll
        for (int t = 0; t < 4; ++t) S0 = MFMA(kf[t], qf[0][t], S0);
#pragma unroll
        for (int t = 0; t < 4; ++t) S1 = MFMA(kf[t], qf[1][t], S1);
        softmax_step(S0, l0[0], l0[0], pf0);
        softmax_step(S1, l0[1], l0[1], pf1);
      }
#pragma unroll
      for (int bk = 0; bk < 4; ++bk)
#pragma unroll
        for (int s2 = 0; s2 < 2; ++s2) {
          const bf16x8 vf = *(const bf16x8*)(cur + va[0][s2] + sb * 64 * 0 + bk * 4096 + (sb ? (va[1][s2] - va[0][s2]) : 0));
          O[0][bk] = MFMA(vf, pf0[s2], O[0][bk]);
          O[1][bk] = MFMA(vf, pf1[s2], O[1][bk]);
        }
    }
    if (kt + 2 < nt) asm volatile("s_waitcnt vmcnt(3)" ::: "memory"); else asm volatile("s_waitcnt vmcnt(0)" ::: "memory");
    asm volatile("s_waitcnt lgkmcnt(0)" ::: "memory");
    __builtin_amdgcn_s_barrier();
    bo = bo == 2 * ABUFD ? 0 : bo + ABUFD;
  }
#undef D2_ISSUE
  lsum[0] = l0[0]; lsum[1] = l0[1];
}

DI void diff_unit2(const Params& p, int l, int b, int hh, int qrow0, char* smem) {
  f32x16 O[2][4]; float ls[2];
  float sc1[2] = {0.f, 0.f};
#pragma unroll 1
  for (int c = 0; c < 2; ++c) {
    {
      const int tid = get_tid(), lane = tid & 63, w = tid >> 6, r = lane & 31, h = lane >> 5;
      bf16x8 qf[2][4];
#pragma unroll
      for (int qb = 0; qb < 2; ++qb) load_q(qf[qb], p.Pm + (size_t)(qrow0 + 64 * w + 32 * qb + r) * PMW + C_DQ + (2 * hh + c) * 64, h);
      attn_pass_d2(O, ls, qf, p.DK + (size_t)b * NKEY * 512 + (2 * hh + c) * 64, p.DVt + ((size_t)b * 512 + hh * 128) * NKEY, smem);
    }
#pragma unroll
    for (int qb = 0; qb < 2; ++qb) ls[qb] += __shfl_xor(ls[qb], 32);
    if (c == 0) {
      const int tid = get_tid();
      float* st = p.stash + (size_t)blockIdx.x * 65536 + tid * 128;
#pragma unroll
      for (int qb = 0; qb < 2; ++qb) {
        const float inv = 1.f / ls[qb];
#pragma unroll
        for (int bk = 0; bk < 4; ++bk)
#pragma unroll
          for (int g4 = 0; g4 < 4; ++g4) {
            const f32x4 v4 = {O[qb][bk][4 * g4] * inv, O[qb][bk][4 * g4 + 1] * inv, O[qb][bk][4 * g4 + 2] * inv, O[qb][bk][4 * g4 + 3] * inv};
            *(f32x4*)(st + qb * 64 + bk * 16 + g4 * 4) = v4;
          }
      }
    } else { sc1[0] = -p.consts[l * 4 + 0] / ls[0]; sc1[1] = -p.consts[l * 4 + 0] / ls[1]; }
  }
  const int tid = get_tid(), lane = tid & 63, w = tid >> 6, r = lane & 31, h = lane >> 5;
  const float* st = p.stash + (size_t)blockIdx.x * 65536 + tid * 128;
  const float* sub = opaque(p.dsub + l * 128);
#pragma unroll
  for (int qb = 0; qb < 2; ++qb) {
    float ss = 0.f;
#pragma unroll
    for (int bk = 0; bk < 4; ++bk)
#pragma unroll
      for (int g4 = 0; g4 < 4; ++g4) {
        const f32x4 s4 = *(const f32x4*)(st + qb * 64 + bk * 16 + g4 * 4);
#pragma unroll
        for (int e = 0; e < 4; ++e) { const float v = s4[e] + sc1[qb] * O[qb][bk][4 * g4 + e]; O[qb][bk][4 * g4 + e] = v; ss += v * v; }
      }
    ss += __shfl_xor(ss, 32);
    const float rs = __builtin_amdgcn_rsqf(ss * (1.f / 128.f) + 1e-6f) * (1.f - p.consts[l * 4 + 3]);
    bf16_t* zrow = p.Pm + (size_t)(qrow0 + 64 * w + 32 * qb + r) * PMW + C_ZD + hh * 128;
#pragma unroll
    for (int bk = 0; bk < 4; ++bk)
#pragma unroll
      for (int g4 = 0; g4 < 4; ++g4) {
        const int dv0 = 32 * bk + 8 * g4 + 4 * h;
        const u32x2 z = *(const u32x2*)(zrow + dv0);
        const f32x4 sg = *(const f32x4*)(sub + dv0);
        const float o0 = O[qb][bk][4 * g4] * rs * sg[0] * bflo(z[0]), o1 = O[qb][bk][4 * g4 + 1] * rs * sg[1] * bfhi(z[0]);
        const float o2 = O[qb][bk][4 * g4 + 2] * rs * sg[2] * bflo(z[1]), o3 = O[qb][bk][4 * g4 + 3] * rs * sg[3] * bfhi(z[1]);
        u32x2 pk = {pack2(o0, o1), pack2(o2, o3)};
        *(u32x2*)(zrow + dv0) = pk;
        asm volatile("" ::: "memory");
      }
  }
}

DI void gqa_unit(const Params& p, int l, int b, int qh, int qrow0, int nkeys, char* smem) {
  const int tid = get_tid(), lane = tid & 63, w = tid >> 6, r = lane & 31, h = lane >> 5;
  const int qrow = qrow0 + 32 * w + r, kvh = qh >> 2;
  f32x16 O[2]; float ls; bf16x8 qf[4];
  load_q(qf, p.Pm + (size_t)qrow * PMW + C_GQ + qh * 64, h);
  attn_pass<64>(O, ls, qf, p.GK + (size_t)b * NKEY * 128 + kvh * 64, 128, p.GVt + ((size_t)b * 128 + kvh * 64) * NKEY, nkeys, smem);
  ls += __shfl_xor(ls, 32);
  const float inv = 1.f / ls;
  bf16_t* zrow = p.Pm + (size_t)qrow * PMW + C_ZG + qh * 64;
#pragma unroll
  for (int bk = 0; bk < 2; ++bk)
#pragma unroll
    for (int g4 = 0; g4 < 4; ++g4) {
      const int dv0 = 32 * bk + 8 * g4 + 4 * h;
      const u32x2 z = *(const u32x2*)(zrow + dv0);
      const float o0 = O[bk][4 * g4] * inv * bflo(z[0]), o1 = O[bk][4 * g4 + 1] * inv * bfhi(z[0]);
      const float o2 = O[bk][4 * g4 + 2] * inv * bflo(z[1]), o3 = O[bk][4 * g4 + 3] * inv * bfhi(z[1]);
      u32x2 pk = {pack2(o0, o1), pack2(o2, o3)};
      *(u32x2*)(zrow + dv0) = pk;
    }
}

DI void attn_pass_g2(f32x16 (&O)[2][2], float (&lsum)[2], const bf16x8 (&qf)[2][4], const bf16_t* __restrict__ Kb, const bf16_t* __restrict__ Vt, int nkeys, char* smem) {
  const int tid = get_tid(), lane = tid & 63, wid = __builtin_amdgcn_readfirstlane(tid >> 6), r = lane & 31, h = lane >> 5;
  const int pr = (r & 19) | ((r & 4) << 1) | ((r & 8) >> 1);
  const char* Kc = (const char*)Kb; const char* Vc = (const char*)Vt;
  G8_LAS unsigned char* lds = (G8_LAS unsigned char*)smem;
  const int nt = nkeys >> 6;
  const unsigned ksrc = dma_src(wid, lane, 256u), vsrc = dma_src(wid, lane, (unsigned)NKEY * 2u);
#define G2_ISSUE(kt_, b_) do { \
    __builtin_amdgcn_global_load_lds((const unsigned*)(Kc + (ksrc + (unsigned)(kt_) * 64u * 256u)), (G8_LAS unsigned*)(lds + b_ + wid * 1024), 16, 0, 0); \
    __builtin_amdgcn_global_load_lds((const unsigned*)(Vc + (vsrc + (unsigned)(kt_) * 128u)), (G8_LAS unsigned*)(lds + b_ + 8192 + wid * 1024), 16, 0, 0); } while (0)
  G2_ISSUE(0, 0);
  if (nt > 1) { G2_ISSUE(1, ABUFD); asm volatile("s_waitcnt vmcnt(2)" ::: "memory"); }
  else asm volatile("s_waitcnt vmcnt(0)" ::: "memory");
  __builtin_amdgcn_s_barrier();
  int ka[4], va[2][2];
#pragma unroll
  for (int t = 0; t < 4; ++t) ka[t] = swz_off(pr, 2 * t + h);
#pragma unroll
  for (int sb = 0; sb < 2; ++sb)
#pragma unroll
    for (int s2 = 0; s2 < 2; ++s2) va[sb][s2] = 8192 + swz_off(r, 4 * sb + 2 * s2 + h);
#pragma unroll
  for (int qb = 0; qb < 2; ++qb)
#pragma unroll
    for (int bk = 0; bk < 2; ++bk)
#pragma unroll
      for (int e = 0; e < 16; ++e) O[qb][bk][e] = 0.f;
  float l0[2] = {0.f, 0.f}, l1[2] = {0.f, 0.f};
  int bo = 0;
#pragma unroll 1
  for (int kt = 0; kt < nt; ++kt) {
    const char* cur = smem + bo;
    const int b2 = bo >= ABUFD ? bo - ABUFD : bo + 2 * ABUFD;
    if (kt + 2 < nt) G2_ISSUE(kt + 2, b2);
#pragma unroll
    for (int sb = 0; sb < 2; ++sb) {
      bf16x8 kf[4];
#pragma unroll
      for (int t = 0; t < 4; ++t) kf[t] = *(const bf16x8*)(cur + ka[t] + sb * 4096);
      f32x16 S0, S1;
#pragma unroll
      for (int e = 0; e < 16; ++e) { S0[e] = 0.f; S1[e] = 0.f; }
#pragma unroll
      for (int t = 0; t < 4; ++t) S0 = MFMA(kf[t], qf[0][t], S0);
#pragma unroll
      for (int t = 0; t < 4; ++t) S1 = MFMA(kf[t], qf[1][t], S1);
      bf16x8 vf[2][2];
#pragma unroll
      for (int bk = 0; bk < 2; ++bk)
#pragma unroll
        for (int s2 = 0; s2 < 2; ++s2) vf[bk][s2] = *(const bf16x8*)(cur + va[sb][s2] + bk * 4096);
      bf16x8 pf[2];
      softmax_step(S0, l0[0], l1[0], pf);
#pragma unroll
      for (int bk = 0; bk < 2; ++bk)
#pragma unroll
        for (int s2 = 0; s2 < 2; ++s2) O[0][bk] = MFMA(vf[bk][s2], pf[s2], O[0][bk]);
      softmax_step(S1, l0[1], l1[1], pf);
#pragma unroll
      for (int bk = 0; bk < 2; ++bk)
#pragma unroll
        for (int s2 = 0; s2 < 2; ++s2) O[1][bk] = MFMA(vf[bk][s2], pf[s2], O[1][bk]);
    }
    if (kt + 2 < nt) asm volatile("s_waitcnt vmcnt(2)" ::: "memory"); else asm volatile("s_waitcnt vmcnt(0)" ::: "memory");
    asm volatile("s_waitcnt lgkmcnt(0)" ::: "memory");
    __builtin_amdgcn_s_barrier();
    bo = bo == 2 * ABUFD ? 0 : bo + ABUFD;
  }
#undef G2_ISSUE
  lsum[0] = l0[0] + l1[0]; lsum[1] = l0[1] + l1[1];
}

DI void gqa_unit2(const Params& p, int l, int b, int qh, int qrow0, char* smem) {
  const int tid = get_tid(), lane = tid & 63, w = tid >> 6, r = lane & 31, h = lane >> 5;
  const int kvh = qh >> 2;
  f32x16 O[2][2]; float ls[2]; bf16x8 qf[2][4];
#pragma unroll
  for (int qb = 0; qb < 2; ++qb) load_q(qf[qb], p.Pm + (size_t)(qrow0 + 64 * w + 32 * qb + r) * PMW + C_GQ + qh * 64, h);
  attn_pass_g2(O, ls, qf, p.GK + (size_t)b * NKEY * 128 + kvh * 64, p.GVt + ((size_t)b * 128 + kvh * 64) * NKEY, NKEY, smem);
#pragma unroll
  for (int qb = 0; qb < 2; ++qb) {
    float lsq = ls[qb]; lsq += __shfl_xor(lsq, 32);
    const float inv = 1.f / lsq;
    bf16_t* zrow = p.Pm + (size_t)(qrow0 + 64 * w + 32 * qb + r) * PMW + C_ZG + qh * 64;
#pragma unroll
    for (int bk = 0; bk < 2; ++bk)
#pragma unroll
      for (int g4 = 0; g4 < 4; ++g4) {
        const int dv0 = 32 * bk + 8 * g4 + 4 * h;
        const u32x2 z = *(const u32x2*)(zrow + dv0);
        const float o0 = O[qb][bk][4 * g4] * inv * bflo(z[0]), o1 = O[qb][bk][4 * g4 + 1] * inv * bfhi(z[0]);
        const float o2 = O[qb][bk][4 * g4 + 2] * inv * bflo(z[1]), o3 = O[qb][bk][4 * g4 + 3] * inv * bfhi(z[1]);
        u32x2 pk = {pack2(o0, o1), pack2(o2, o3)};
        *(u32x2*)(zrow + dv0) = pk;
      }
  }
}

DI void pool_unit(const Params& p, int l, int mt, int g, char* smem) {
  const int tid = (get_tid() & 255), lane = tid & 63, w = tid >> 6, wm = w >> 1, wn = w & 1, r = lane & 31, h = lane >> 5;
  const int row0 = mt * 128;
  int seq0, n, t0;
  if (mt < 256) { seq0 = (mt >> 6) * 8192; n = 8192; t0 = (mt & 63) * 128; }
  else { const int c = mt - 256; seq0 = NLAT + (c >> 1) * 256; n = 256; t0 = (c & 1) * 128; }
  const int wnd = 2 << g, left = wnd >> 1, right = wnd - 1 - left;
  char* ut = smem + 2 * TILEB;
  u32x4 wreg[8];
#pragma unroll
  for (int q = 0; q < 8; ++q) {
    const int idx = tid + 256 * q, tok = idx >> 4, ch = idx & 15;
    wreg[q] = *(const u32x4*)(p.WpT + (size_t)(l * 4 + g) * 128 * 128 + (size_t)tok * 128 + ch * 8);
  }
  {
    const bf16_t* up = p.Pm + (size_t)seq0 * PMW + C_U + g * 128;
    u32x4 uv[9];
#pragma unroll
    for (int q = 0; q < 9; ++q) {
      const int idx = tid + 256 * q, urow = idx >> 4, ch = idx & 15, tt = t0 - 8 + urow;
      uv[q] = (u32x4){0u, 0u, 0u, 0u};
      if (tt >= 0 && tt < n) uv[q] = *(const u32x4*)(up + (size_t)tt * PMW + ch * 8);
    }
#pragma unroll
    for (int q = 0; q < 9; ++q) { const int idx = tid + 256 * q; *(u32x4*)(ut + (idx >> 4) * 256 + (idx & 15) * 16) = uv[q]; }
  }
  __syncthreads();
#pragma unroll 2
  for (int q = 0; q < 8; ++q) {
    const int idx = tid + 256 * q, tok = idx >> 4, ch = idx & 15;
    const int t = t0 + tok;
    const int lo = t - left < 0 ? 0 : t - left, hi = t + right + 1 > n ? n : t + right + 1;
    float sm[8] = {0.f, 0.f, 0.f, 0.f, 0.f, 0.f, 0.f, 0.f};
    const char* ub = ut + (tok + 8 - left) * 256 + ch * 16;
#pragma unroll
    for (int d = 0; d < 16; ++d) {
      if (d < wnd) {
        const u32x4 v = *(const u32x4*)(ub + d * 256);
#pragma unroll
        for (int e = 0; e < 4; ++e) { sm[2 * e] += bflo(v[e]); sm[2 * e + 1] += bfhi(v[e]); }
      }
    }
    const u32x4 sv = *(const u32x4*)(ut + (tok + 8) * 256 + ch * 16);
    const float ic = 1.f / (float)(hi - lo);
    u32x4 o;
#pragma unroll
    for (int e = 0; e < 4; ++e) o[e] = pack2(sm[2 * e] * ic - bflo(sv[e]), sm[2 * e + 1] * ic - bfhi(sv[e]));
    *(u32x4*)(smem + (ch >> 3) * TILEB + tok * TROW + (ch & 7) * 16) = o;
  }
  __syncthreads();
#pragma unroll
  for (int q = 0; q < 8; ++q) {
    const int idx = tid + 256 * q, tok = idx >> 4, ch = idx & 15;
    *(u32x4*)(smem + (2 + (ch >> 3)) * TILEB + tok * TROW + (ch & 7) * 16) = wreg[q];
  }
  __syncthreads();
  f32x16 acc[2][2]; zero_acc22(acc);
  const int aoff = (64 * wm + r) * TROW + 16 * h;
  const int boff = 2 * TILEB + (64 * wn + r) * TROW + 16 * h;
#pragma unroll
  for (int kt = 0; kt < 2; ++kt) {
    const char* cur = smem + kt * TILEB;
#pragma unroll
    for (int t = 0; t < 4; ++t) {
      const bf16x8 a0 = *(const bf16x8*)(cur + aoff + 32 * t);
      const bf16x8 a1 = *(const bf16x8*)(cur + aoff + 32 * TROW + 32 * t);
      const bf16x8 b0 = *(const bf16x8*)(cur + boff + 32 * t);
      const bf16x8 b1 = *(const bf16x8*)(cur + boff + 32 * TROW + 32 * t);
      acc[0][0] = MFMA(b0, a0, acc[0][0]); acc[0][1] = MFMA(b1, a0, acc[0][1]);
      acc[1][0] = MFMA(b0, a1, acc[1][0]); acc[1][1] = MFMA(b1, a1, acc[1][1]);
    }
  }
  __syncthreads();
  const float* ps = p.pool_scale + l * 512 + g * 128 + 64 * wn;
#pragma unroll
  for (int i = 0; i < 2; ++i) {
    bf16_t* zrow = p.Pm + (size_t)(row0 + 64 * wm + 32 * i + r) * PMW + C_ZP + g * 128 + 64 * wn;
#pragma unroll
    for (int j = 0; j < 2; ++j)
#pragma unroll
      for (int g4 = 0; g4 < 4; ++g4) {
        const int c0 = 32 * j + 8 * g4 + 4 * h;
        const u32x2 z = *(const u32x2*)(zrow + c0);
        const f32x4 sc = *(const f32x4*)(ps + c0);
        const float o0 = acc[i][j][4 * g4] * sc[0] * bflo(z[0]), o1 = acc[i][j][4 * g4 + 1] * sc[1] * bfhi(z[0]);
        const float o2 = acc[i][j][4 * g4 + 2] * sc[2] * bflo(z[1]), o3 = acc[i][j][4 * g4 + 3] * sc[3] * bfhi(z[1]);
        u32x2 pk = {pack2(o0, o1), pack2(o2, o3)};
        *(u32x2*)(zrow + c0) = pk;
      }
  }
}

DI void phase3(const Params& p, int l, char* smem_all) {
  const int nD = 256, nG = 512, nCD = l == 0 ? 16 : 0, nCG = l == 0 ? 32 : 0;
  const int e1 = nD, e2 = e1 + nG, e3 = e2 + nCD, e4 = e3 + nCG;
  for (int it = 0; ; ++it) {
    int i = blockIdx.x + it * gridDim.x;
    if (i >= e2) { if (i - e2 >= (int)gridDim.x) break; i = e2 + ((int)gridDim.x - 1 - (i - e2)); if (i >= e4) break; }
    if (i < e1) { const int x = i & 7, j = i >> 3, bh = x + 8 * (j >> 4), qb = j & 15; diff_unit2(p, l, bh >> 2, bh & 3, (bh >> 2) * 8192 + qb * 512, smem_all); }
    else if (i < e2) { const int i2 = i - e1, x = i2 & 7, j = i2 >> 3, qb = j & 15, b = x >> 1, qh = (x & 1) * 4 + (j >> 4); gqa_unit2(p, l, b, qh, b * 8192 + qb * 512, smem_all); }
    else if (i < e3) { const int i3 = i - e2, b = i3 >> 2, hh = i3 & 3; diff_unit(p, l, b, hh, NLAT + b * 256, 256, smem_all); }
    else { const int i4 = i - e3, b = i4 >> 3, qh = i4 & 7; gqa_unit(p, l, b, qh, NLAT + b * 256, 256, smem_all); }
  }
  const int grp = get_tid() >> 8;
  char* smem = smem_all + grp * GRP_SMEM;
  const int nPool = (l == 0 ? 264 : 256) * 4;
  for (int k = blockIdx.x; 2 * k < nPool; k += gridDim.x) {
    const int i5 = 2 * k + grp;
    pool_unit(p, l, i5 >> 2, i5 & 3, smem);
  }
}

DI void gemm_kloop4(f32x16 (&acc)[2][2], const bf16_t* __restrict__ A, int lda, const bf16_t* __restrict__ Bt, int ldb, int K, char* smem) {
  const int tid = get_tid() & 255, lane = tid & 63, w = tid >> 6, wm = w >> 1, wn = w & 1, r = lane & 31, h = lane >> 5;
  const int srow = tid >> 3, sch = tid & 7;
  const unsigned ago = (unsigned)(srow * lda + sch * 8) * 2u, bgo = (unsigned)(srow * ldb + sch * 8) * 2u;
  const unsigned astep = (unsigned)lda * 64u, bstep = (unsigned)ldb * 64u;
  const char* Ab = (const char*)A; const char* Bb = (const char*)Bt;
  const int soff = srow * TROW + sch * 16;
  u32x4 ra[4], rb[4];
#pragma unroll
  for (int q = 0; q < 4; ++q) { ra[q] = *(const u32x4*)(Ab + (ago + q * astep)); rb[q] = *(const u32x4*)(Bb + (bgo + q * bstep)); }
#pragma unroll
  for (int q = 0; q < 4; ++q) { *(u32x4*)(smem + soff + q * 32 * TROW) = ra[q]; *(u32x4*)(smem + TILEB + soff + q * 32 * TROW) = rb[q]; }
  __syncthreads();
  const int nk = K >> 6;
  const int aoff = (64 * wm + r) * TROW + 16 * h;
  const int boff = TILEB + (64 * wn + r) * TROW + 16 * h;
#pragma unroll 1
  for (int kt = 0; kt < nk; ++kt) {
    const char* cur = smem + (kt & 1) * (2 * TILEB);
    if (kt + 1 < nk) {
#pragma unroll
      for (int q = 0; q < 4; ++q) {
        ra[q] = *(const u32x4*)(Ab + (ago + q * astep + (unsigned)(kt + 1) * 128u));
        rb[q] = *(const u32x4*)(Bb + (bgo + q * bstep + (unsigned)(kt + 1) * 128u));
      }
    }
#pragma unroll
    for (int t = 0; t < 4; ++t) {
      const bf16x8 a0 = *(const bf16x8*)(cur + aoff + 32 * t);
      const bf16x8 a1 = *(const bf16x8*)(cur + aoff + 32 * TROW + 32 * t);
      const bf16x8 b0 = *(const bf16x8*)(cur + boff + 32 * t);
      const bf16x8 b1 = *(const bf16x8*)(cur + boff + 32 * TROW + 32 * t);
      acc[0][0] = MFMA(b0, a0, acc[0][0]); acc[0][1] = MFMA(b1, a0, acc[0][1]);
      acc[1][0] = MFMA(b0, a1, acc[1][0]); acc[1][1] = MFMA(b1, a1, acc[1][1]);
    }
    if (kt + 1 < nk) {
      char* nxt = smem + ((kt + 1) & 1) * (2 * TILEB);
#pragma unroll
      for (int q = 0; q < 4; ++q) { *(u32x4*)(nxt + soff + q * 32 * TROW) = ra[q]; *(u32x4*)(nxt + TILEB + soff + q * 32 * TROW) = rb[q]; }
    }
    __syncthreads();
  }
}

DI void ctx_p4_tile(const Params& p, int l, int mt, int pn, char* smem) {
  const int tid = get_tid() & 255, lane = tid & 63, w = tid >> 6, wm = w >> 1, wn = w & 1, r = lane & 31, h = lane >> 5;
  const int m0 = NLAT + mt * 128, n0 = pn * 128;
  const bf16_t* W = p.WinT + (size_t)l * 7424 * 1024;
  char* yb = (char*)(p.y + (size_t)m0 * 1024 + n0);
  unsigned lo = (unsigned)((64 * wm + r) * 1024 + 64 * wn + 4 * h) * 2u;
  asm volatile("" : "+v"(lo));
#pragma unroll 1
  for (int i = 0; i < 3; ++i) {
    unsigned gpk[2][2][8];
    {
      f32x16 acc[2][2]; zero_acc22(acc);
      gemm_kloop4(acc, p.h + (size_t)m0 * 1024, 1024, W + (size_t)(4352 + i * 1024 + n0) * 1024, 1024, 1024, smem);
#pragma unroll
      for (int a = 0; a < 2; ++a)
#pragma unroll
        for (int c = 0; c < 2; ++c)
#pragma unroll
          for (int e = 0; e < 8; ++e) gpk[a][c][e] = pack2(fast_sigmoid(acc[a][c][2 * e]), fast_sigmoid(acc[a][c][2 * e + 1]));
    }
    f32x16 acc[2][2]; zero_acc22(acc);
    const int zc = i == 0 ? C_ZP : (i == 1 ? C_ZD : C_ZG);
    gemm_kloop4(acc, p.Pm + (size_t)m0 * PMW + zc, PMW, p.WbT + ((size_t)(l * 3 + i) * 1024 + n0) * 512, 512, 512, smem);
#pragma unroll
    for (int a = 0; a < 2; ++a)
#pragma unroll
      for (int c = 0; c < 2; ++c) {
#pragma unroll
        for (int g4 = 0; g4 < 4; ++g4) {
          const unsigned o = lo + (unsigned)(((32 * a) * 1024 + 32 * c + 8 * g4) * 2);
          u32x2 y = {0u, 0u};
          if (i > 0) y = *(const u32x2*)(yb + o);
          const unsigned g0 = gpk[a][c][2 * g4], g1 = gpk[a][c][2 * g4 + 1];
          u32x2 out = {pack2(bflo(y[0]) + bflo(g0) * acc[a][c][4 * g4], bfhi(y[0]) + bfhi(g0) * acc[a][c][4 * g4 + 1]),
                       pack2(bflo(y[1]) + bflo(g1) * acc[a][c][4 * g4 + 2], bfhi(y[1]) + bfhi(g1) * acc[a][c][4 * g4 + 3])};
          *(u32x2*)(yb + o) = out;
        }
        asm volatile("" ::: "memory");
      }
  }
}

DI void ctx_p5_tile(const Params& p, int l, int mt, int pn, char* smem) {
  const int tid = get_tid() & 255, lane = tid & 63, w = tid >> 6, wm = w >> 1, wn = w & 1, r = lane & 31, h = lane >> 5;
  const int m0 = NLAT + mt * 128, n0 = pn * 128;
  f32x16 acc[2][2]; zero_acc22(acc);
  gemm_kloop4(acc, p.y + (size_t)m0 * 1024, 1024, p.WoT + ((size_t)l * 1024 + n0) * 1024, 1024, 1024, smem);
  const char* srcb = (const char*)(p.ctx + (size_t)(mt * 128) * 1024 + n0);
  char* dstb = (char*)(p.xc1 + (size_t)(mt * 128) * 1024 + n0);
  const float* gate = p.mod + (l * 5 + 4) * 3072 + 2048 + n0 + 64 * wn + 4 * h;
  unsigned lo = (unsigned)((64 * wm + r) * 1024 + 64 * wn + 4 * h) * 4u;
  asm volatile("" : "+v"(lo));
#pragma unroll
  for (int a = 0; a < 2; ++a)
#pragma unroll
    for (int c = 0; c < 2; ++c) {
#pragma unroll
      for (int g4 = 0; g4 < 4; ++g4) {
        const unsigned o = lo + (unsigned)(((32 * a) * 1024 + 32 * c + 8 * g4) * 4);
        const f32x4 xv = *(const f32x4*)(srcb + o);
        const f32x4 gt = *(const f32x4*)(gate + 32 * c + 8 * g4);
        const f32x4 av = {acc[a][c][4 * g4], acc[a][c][4 * g4 + 1], acc[a][c][4 * g4 + 2], acc[a][c][4 * g4 + 3]};
        *(f32x4*)(dstb + o) = xv + gt * av;
      }
      asm volatile("" ::: "memory");
    }
}

DI void ctx_small_phase(const Params& p, int l, char* smem_all, bool is5) {
  const int grp = get_tid() >> 8;
  char* smem = smem_all + grp * GRP_SMEM;
  for (int k = blockIdx.x; 2 * k < 64; k += gridDim.x) {
    const int t = 2 * k + grp;
    if (is5) ctx_p5_tile(p, l, t >> 3, t & 7, smem); else ctx_p4_tile(p, l, t >> 3, t & 7, smem);
  }
}

struct Sched4 {
  TileWalk tw; const char* h; const char* W; const char* Pm; const char* Wb;
  DI bool next(int i, g8::Unit& u) const {
    const int ti = i / 6, s = i - 6 * ti, i3 = s >> 1;
    int mt, pn2;
    if (!tw.at(ti, mt, pn2)) return false;
    if ((s & 1) == 0) {
      u.A = h + (size_t)mt * 256 * 2048; u.lda2 = 2048; u.B = W + (size_t)(4352 + i3 * 1024 + pn2 * 256) * 2048; u.ldb2 = 2048; u.nt = 16; u.kind = 0;
    } else {
      const int zc = i3 == 0 ? C_ZP : (i3 == 1 ? C_ZD : C_ZG);
      u.A = Pm + ((size_t)mt * 256 * PMW + zc) * 2; u.lda2 = PMW * 2; u.B = Wb + (size_t)(i3 * 1024 + pn2 * 256) * 1024; u.ldb2 = 1024; u.nt = 8; u.kind = 1;
    }
    u.i0 = mt; u.i1 = pn2; u.i2 = i3;
    return true;
  }
};
struct Epi4 {
  const Params& p; char* gbase; unsigned goff;
  DI void operator()(const f32x4 (&acc)[2][2][4][2], const g8::Unit& u, int wr, int wc, int fr, int fq) const {
    unsigned go = goff; asm volatile("" : "+v"(go));
    if (u.kind == 0) {
#pragma unroll
      for (int ai = 0; ai < 2; ++ai)
#pragma unroll
        for (int bj = 0; bj < 2; ++bj) {
#pragma unroll
          for (int m = 0; m < 4; ++m) {
            const f32x4 a0 = acc[ai][bj][m][0], a1 = acc[ai][bj][m][1];
            u32x4 g = {pack2(fast_sigmoid(a0[0]), fast_sigmoid(a0[1])), pack2(fast_sigmoid(a0[2]), fast_sigmoid(a0[3])),
                       pack2(fast_sigmoid(a1[0]), fast_sigmoid(a1[1])), pack2(fast_sigmoid(a1[2]), fast_sigmoid(a1[3]))};
            *(u32x4*)(gbase + (go + (unsigned)((((ai * 2 + bj) * 4 + m) * 4) * 4))) = g;
          }
          asm volatile("" ::: "memory"); __builtin_amdgcn_sched_barrier(0);
        }
    } else {
      const int i3 = u.i2;
      bf16_t* dst = p.y + (size_t)(u.i0 * 256 + 64 * wr + fr) * 1024 + u.i1 * 256 + 32 * wc + 4 * fq;
#pragma unroll
      for (int ai = 0; ai < 2; ++ai) {
        u32x4 g[2][4], y[2][4];
#pragma unroll
        for (int bj = 0; bj < 2; ++bj)
#pragma unroll
          for (int m = 0; m < 4; ++m) {
            g[bj][m] = *(const u32x4*)(gbase + (go + (unsigned)((((ai * 2 + bj) * 4 + m) * 4) * 4)));
            y[bj][m] = (u32x4){0u, 0u, 0u, 0u};
            if (i3 > 0) y[bj][m] = *(const u32x4*)(gbase + (go + (unsigned)((64 + ((ai * 2 + bj) * 4 + m) * 4) * 4)));
          }
#pragma unroll
        for (int bj = 0; bj < 2; ++bj)
#pragma unroll
          for (int m = 0; m < 4; ++m) {
            const f32x4 a0 = acc[ai][bj][m][0], a1 = acc[ai][bj][m][1];
            const u32x4 gg = g[bj][m], yy = y[bj][m];
            u32x4 o = {pack2(bflo(yy[0]) + bflo(gg[0]) * a0[0], bfhi(yy[0]) + bfhi(gg[0]) * a0[1]), pack2(bflo(yy[1]) + bflo(gg[1]) * a0[2], bfhi(yy[1]) + bfhi(gg[1]) * a0[3]),
                       pack2(bflo(yy[2]) + bflo(gg[2]) * a1[0], bfhi(yy[2]) + bfhi(gg[2]) * a1[1]), pack2(bflo(yy[3]) + bflo(gg[3]) * a1[2], bfhi(yy[3]) + bfhi(gg[3]) * a1[3])};
            if (i3 < 2) *(u32x4*)(gbase + (go + (unsigned)((64 + ((ai * 2 + bj) * 4 + m) * 4) * 4))) = o;
            else {
              bf16_t* d = dst + (size_t)(128 * ai + 16 * m) * 1024 + 128 * bj;
              u32x2 o0 = {o[0], o[1]}, o1 = {o[2], o[3]};
              *(u32x2*)(d) = o0; *(u32x2*)(d + 16) = o1;
            }
          }
        asm volatile("" ::: "memory"); __builtin_amdgcn_sched_barrier(0);
      }
    }
  }
};

DI void phase4(const Params& p, int l, char* smem) {
  Sched4 S; S.tw.init(128, 4); S.h = (const char*)p.h; S.W = (const char*)(p.WinT + (size_t)l * 7424 * 1024);
  S.Pm = (const char*)p.Pm; S.Wb = (const char*)(p.WbT + (size_t)l * 3 * 1024 * 512);
  Epi4 E{p, (char*)(p.gsc + (size_t)blockIdx.x * 512 * 128), (unsigned)get_tid() * 512u};
  g8::gemm_phase<false>(smem, S, E);
}

struct Sched5 {
  TileWalk tw; const char* y; const char* Wo;
  DI bool next(int i, g8::Unit& u) const {
    int mt, pn2;
    if (!tw.at(i, mt, pn2)) return false;
    u.A = y + (size_t)mt * 256 * 2048; u.lda2 = 2048; u.B = Wo + (size_t)pn2 * 256 * 2048; u.ldb2 = 2048; u.nt = 16;
    u.kind = 0; u.i0 = mt; u.i1 = pn2; u.i2 = 0;
    return true;
  }
};
struct Epi5 {
  const Params& p; int l;
  DI void operator()(const f32x4 (&acc)[2][2][4][2], const g8::Unit& u, int wr, int wc, int fr, int fq) const {
    const int mt = u.i0, row0 = mt * 256, col0 = u.i1 * 256 + 32 * wc + 4 * fq;
    const bool isctx = mt >= 128;
    const float* xlat = l == 0 ? p.x : p.out;
    const float* src = (isctx ? p.ctx + (size_t)(row0 - NLAT) * 1024 : xlat + (size_t)row0 * 1024) + (size_t)(64 * wr + fr) * 1024 + col0;
    float* dst = (isctx ? p.xc1 + (size_t)(row0 - NLAT) * 1024 : p.out + (size_t)row0 * 1024) + (size_t)(64 * wr + fr) * 1024 + col0;
    const float* gate = p.mod + (l * 5 + (isctx ? 4 : (mt >> 5))) * 3072 + 2048 + col0;
    f32x4 gt[2][2];
#pragma unroll
    for (int bj = 0; bj < 2; ++bj)
#pragma unroll
      for (int n = 0; n < 2; ++n) gt[bj][n] = *(const f32x4*)(gate + 128 * bj + 16 * n);
#pragma unroll
    for (int ai = 0; ai < 2; ++ai) {
      f32x4 xv[4][2][2];
#pragma unroll
      for (int m = 0; m < 4; ++m)
#pragma unroll
        for (int bj = 0; bj < 2; ++bj)
#pragma unroll
          for (int n = 0; n < 2; ++n) xv[m][bj][n] = *(const f32x4*)(src + (size_t)(128 * ai + 16 * m) * 1024 + 128 * bj + 16 * n);
#pragma unroll
      for (int m = 0; m < 4; ++m)
#pragma unroll
        for (int bj = 0; bj < 2; ++bj)
#pragma unroll
          for (int n = 0; n < 2; ++n) *(f32x4*)(dst + (size_t)(128 * ai + 16 * m) * 1024 + 128 * bj + 16 * n) = xv[m][bj][n] + gt[bj][n] * acc[ai][bj][m][n];
      asm volatile("" ::: "memory"); __builtin_amdgcn_sched_barrier(0);
    }
  }
};

DI void grid_barrier(unsigned* ctr, unsigned k);
DI void phase5(const Params& p, int l, char* smem, unsigned& kbar) {
  Sched5 S; S.tw.init(128, 4); S.y = (const char*)p.y; S.Wo = (const char*)(p.WoT + (size_t)l * 1024 * 1024);
  const int bid = get_bid();
  if (l == 0) { S.tw.lb = (bid - 32) >> 3; S.tw.nbx = ((int)gridDim.x - 32) >> 3; }
  Epi5 E{p, l};
  if (l != 0 || bid >= 32) g8::gemm_phase<false>(smem, S, E);
  if (l == 0) {
    if (bid < 32) ctx_small_phase(p, l, smem, false);
    grid_barrier(p.bar, ++kbar);
    ctx_small_phase(p, l, smem, true);
  }
}

DI void grid_barrier(unsigned* ctr, unsigned k) {
  __syncthreads();
  if (threadIdx.x == 0) {
    __builtin_amdgcn_fence(__ATOMIC_RELEASE, "agent");
    asm volatile("s_waitcnt vmcnt(0)" ::: "memory");
    const unsigned members = gridDim.x >> 3;
    const unsigned old = __hip_atomic_fetch_add(ctr + 32 * (1 + (blockIdx.x & 7)), 1u, __ATOMIC_RELAXED, __HIP_MEMORY_SCOPE_AGENT);
    if (old == k * members - 1u) __hip_atomic_fetch_add(ctr, 1u, __ATOMIC_RELAXED, __HIP_MEMORY_SCOPE_AGENT);
    while (__hip_atomic_load(ctr, __ATOMIC_RELAXED, __HIP_MEMORY_SCOPE_AGENT) < 8u * k) __builtin_amdgcn_s_sleep(1);
    __builtin_amdgcn_fence(__ATOMIC_ACQUIRE, "agent");
    asm volatile("s_waitcnt vmcnt(0)" ::: "memory");
  }
  __syncthreads();
}

#ifndef PROBE_SEL
#define PROBE_SEL -1
#endif
__global__ void __launch_bounds__(512, 2) fwd_kernel(Params p, int ph0, int ph1) {
  __shared__ __attribute__((aligned(16))) char smem[SMEM_BYTES];
  cg::grid_group grid = cg::this_grid();
  unsigned kbar = 0;
  unsigned long long t_prev = PROBE_SEL >= 0 ? __builtin_amdgcn_s_memrealtime() : 0ull, t_sel = 0;
  for (int ph = ph0; ph < ph1; ++ph) {
    if (ph == 0) phase0(p, smem);
    else {
      const int l = (ph - 1) / 5, s = (ph - 1) % 5;
      if (s == 0) phase1(p, l);
      else if (s == 1) phase2(p, l, smem);
      else if (s == 2) phase3(p, l, smem);
      else if (s == 3) phase4(p, l, smem);
      else phase5(p, l, smem, kbar);
    }
    if (ph + 1 < ph1) {
      if (ph1 > 64) grid.sync();
      else grid_barrier(p.bar, ++kbar);
    }
    if (PROBE_SEL >= 0) {
      const unsigned long long t_now = __builtin_amdgcn_s_memrealtime();
      const int slot = ph == 0 ? 0 : 1 + (ph - 1) % 5;
      if (slot == PROBE_SEL) t_sel += t_now - t_prev;
      t_prev = t_now;
    }
  }
  if (PROBE_SEL >= 0 && blockIdx.x == 0 && threadIdx.x == 0) {
    const unsigned long long t0 = __builtin_amdgcn_s_memrealtime();
    while (__builtin_amdgcn_s_memrealtime() - t0 < t_sel) __builtin_amdgcn_s_sleep(8);
  }
}

extern "C" void kernel_launch(void* const* d_in, const int* in_sizes, int n_in, void* d_out, int out_size,
                              void* d_ws, size_t ws_size, hipStream_t stream) {
  static int grid_blocks = 0;
  if (!grid_blocks) {
    int dev = 0, cus = 0, per_cu = 0;
    (void)hipGetDevice(&dev);
    (void)hipDeviceGetAttribute(&cus, hipDeviceAttributeMultiprocessorCount, dev);
    (void)hipOccupancyMaxActiveBlocksPerMultiprocessor(&per_cu, fwd_kernel, 512, 0);
    if (per_cu > 1) per_cu = 1;
    if (per_cu < 1) per_cu = 1;
    grid_blocks = (cus * per_cu) & ~7;
  }
  Params p{};
  p.x = (const float*)d_in[0]; p.c = (const float*)d_in[1]; p.ctx = (const float*)d_in[2]; p.c_ctx = (const float*)d_in[3];
  p.ada_w = (const float*)d_in[4]; p.ada_b = (const float*)d_in[5]; p.norm_g = (const float*)d_in[6]; p.w_in = (const float*)d_in[7];
  p.pool_w = (const float*)d_in[8]; p.pool_scale = (const float*)d_in[9]; p.dqn = (const float*)d_in[10]; p.dkn = (const float*)d_in[11];
  p.dlam = (const float*)d_in[12]; p.dsub = (const float*)d_in[13]; p.gqn = (const float*)d_in[14]; p.gkn = (const float*)d_in[15];
  p.w_branch = (const float*)d_in[16]; p.w_out = (const float*)d_in[17];
  p.out = (float*)d_out;
  char* ws = (char*)d_ws; size_t off = 0;
  auto take = [&](size_t bytes) { char* q = ws + off; off += (bytes + 255) & ~(size_t)255; return q; };
  p.mod = (float*)take(2 * 5 * 3072 * 4);
  p.consts = (float*)take(256);
  p.bar = (unsigned*)take(2048);
  p.WinT = (bf16_t*)take((size_t)2 * 7424 * 1024 * 2);
  p.WbT = (bf16_t*)take((size_t)2 * 3 * 1024 * 512 * 2);
  p.WoT = (bf16_t*)take((size_t)2 * 1024 * 1024 * 2);
  p.WpT = (bf16_t*)take((size_t)2 * 4 * 128 * 128 * 2);
  p.h = (bf16_t*)take((size_t)NTOK * 1024 * 2);
  p.y = (bf16_t*)take((size_t)NTOK * 1024 * 2);
  p.Pm = (bf16_t*)take((size_t)NTOK * PMW * 2);
  p.DK = (bf16_t*)take((size_t)4 * NKEY * 512 * 2);
  p.DVt = (bf16_t*)take((size_t)4 * NKEY * 512 * 2);
  p.GK = (bf16_t*)take((size_t)4 * NKEY * 128 * 2);
  p.GVt = (bf16_t*)take((size_t)4 * NKEY * 128 * 2);
  p.xc1 = (float*)take((size_t)1024 * 1024 * 4);
  p.gsc = (unsigned*)p.DK;
  p.stash = (float*)p.y;
  if (off > ws_size) { fprintf(stderr, "workspace too small: need %zu have %zu\n", off, ws_size); return; }
#if MULTI_LAUNCH
  for (int ph = 0; ph < 11; ++ph) hipLaunchKernelGGL(fwd_kernel, dim3(grid_blocks), dim3(512), 0, stream, p, ph, ph + 1);
#else
  (void)hipMemsetAsync(p.bar, 0, 2048, stream);
  int ph0 = 0, ph1 = 11;
  void* args[] = {&p, &ph0, &ph1};
  hipError_t e = hipLaunchCooperativeKernel((void*)fwd_kernel, dim3(grid_blocks), dim3(512), args, 0, stream);
  if (e != hipSuccess) fprintf(stderr, "cooperative launch failed: %s (grid %d)\n", hipGetErrorString(e), grid_blocks);
#endif
}
```
